# Optimizing an MI355X kernel written in HIP

```python
import math
import jax, jax.numpy as jnp
from jax import lax
import numpy as np

D_MODEL = 1024
BATCH = 16
SEQ = 4096
DEPTH = 4

N_A_LAYERS = DEPTH // 2
N_B_LAYERS = DEPTH - N_A_LAYERS
D_FF = 2816
SSM_WIDTH = D_MODEL
SSM_GROUP = 16
SSM_GROUPS = SSM_WIDTH // SSM_GROUP
SSM_STATE = 64
DT_MIN = 1e-3
DT_MAX = 1e-1
SB_HEADS = 16
SB_HEAD_DIM = D_MODEL // SB_HEADS
SB_WIDTH = SB_HEADS * SB_HEAD_DIM
Q_BLOCK = 128
NORM_EPS = 1e-6
N_NORMS = 6

kernel_name = "s5_yoco_stickbreaking_macaron_trunk"


def rms_norm(x, g):
    xf = x.astype(jnp.float32)
    y = xf * lax.rsqrt(jnp.mean(xf * xf, axis=-1, keepdims=True) + NORM_EPS)
    return (y * g.astype(jnp.float32)).astype(x.dtype)


def swiglu(h, w_gate, w_up, w_down):
    return (jax.nn.silu(h @ w_gate) * (h @ w_up)) @ w_down


def _cmul(ar, ai, br, bi):
    return ar * br - ai * bi, ar * bi + ai * br


def _scan_combine(e_prev, e_next):
    a1r, a1i, b1r, b1i = e_prev
    a2r, a2i, b2r, b2i = e_next
    ar, ai = _cmul(a2r, a2i, a1r, a1i)
    br, bi = _cmul(a2r, a2i, b1r, b1i)
    return ar, ai, br + b2r, bi + b2i


def s5_mixer(h, w_in, lam_re, lam_im, log_dt, b_re, b_im, c_re, c_im, d_skip, w_glu, w_out):
    f32 = jnp.float32
    bsz, L, _ = h.shape
    u = (h @ w_in).astype(f32).reshape(bsz, L, SSM_GROUPS, SSM_GROUP)
    dt = jnp.exp(log_dt.astype(f32))[:, None]
    lr, li = lam_re.astype(f32), lam_im.astype(f32)
    mag = jnp.exp(lr * dt)
    ab_re, ab_im = mag * jnp.cos(li * dt), mag * jnp.sin(li * dt)
    den = lr * lr + li * li
    nr, ni = ab_re - 1.0, ab_im
    f_re = (nr * lr + ni * li) / den
    f_im = (ni * lr - nr * li) / den
    bb_re, bb_im = _cmul(f_re[..., None], f_im[..., None], b_re.astype(f32), b_im.astype(f32))
    cr, ci = c_re.astype(f32), c_im.astype(f32)
    a_re_seq = jnp.broadcast_to(ab_re, (L, SSM_GROUPS, SSM_STATE))
    a_im_seq = jnp.broadcast_to(ab_im, (L, SSM_GROUPS, SSM_STATE))

    def one_sequence(u_seq):
        bu_re = jnp.einsum('lgc,gnc->lgn', u_seq, bb_re)
        bu_im = jnp.einsum('lgc,gnc->lgn', u_seq, bb_im)
        _, _, s_re, s_im = lax.associative_scan(
            _scan_combine, (a_re_seq, a_im_seq, bu_re, bu_im), axis=0)
        return jnp.einsum('lgn,gcn->lgc', s_re, cr) - jnp.einsum('lgn,gcn->lgc', s_im, ci)

    y = lax.map(one_sequence, u)
    y = y + d_skip.astype(f32) * u
    y = jax.nn.gelu(y.reshape(bsz, L, SSM_WIDTH)).astype(h.dtype)
    z = y * jax.nn.sigmoid(y @ w_glu)
    return z @ w_out


def stick_breaking_attention(q, k, v):
    f32 = jnp.float32
    L = q.shape[2]
    scale = 1.0 / math.sqrt(SB_HEAD_DIM)
    outs = []
    for blk in range(L // Q_BLOCK):
        q0 = blk * Q_BLOCK
        kl = q0 + Q_BLOCK
        qb = q[:, :, q0:kl].astype(f32)
        kb = k[:, :, :kl].astype(f32)
        vb = v[:, :, :kl].astype(f32)
        z = jnp.einsum('bhtd,bhsd->bhts', qb, kb) * scale
        t_idx = q0 + jnp.arange(Q_BLOCK)[:, None]
        s_idx = jnp.arange(kl)[None, :]
        causal = s_idx < t_idx
        log_keep = jnp.where(causal, jax.nn.log_sigmoid(-z), 0.0)
        after = lax.cumsum(log_keep, axis=3, reverse=True) - log_keep
        w = jnp.where(causal, jnp.exp(jax.nn.log_sigmoid(z) + after), 0.0)
        outs.append(jnp.einsum('bhts,bhsd->bhtd', w, vb))
    return jnp.concatenate(outs, axis=2).astype(q.dtype)


def _split_heads(t):
    bsz, L, _ = t.shape
    return t.reshape(bsz, L, SB_HEADS, SB_HEAD_DIM).transpose(0, 2, 1, 3)


def _merge_heads(t):
    bsz, H, L, Dh = t.shape
    return t.transpose(0, 2, 1, 3).reshape(bsz, L, H * Dh)


def setup_inputs(seed: int = 0) -> dict:
    key = jax.random.key(seed)
    ks = iter(jax.random.split(key, 32))
    f32 = jnp.float32

    def nrm(shape, std):
        return jax.random.normal(next(ks), shape, f32) * std

    NA, NB, G, N, C = N_A_LAYERS, N_B_LAYERS, SSM_GROUPS, SSM_STATE, SSM_GROUP
    x = nrm((BATCH, SEQ, D_MODEL), 1.0)
    norm_g = 1.0 + nrm((DEPTH, N_NORMS, D_MODEL), 0.02)
    ffn_w_gate = nrm((DEPTH, 2, D_MODEL, D_FF), D_MODEL ** -0.5)
    ffn_w_up = nrm((DEPTH, 2, D_MODEL, D_FF), D_MODEL ** -0.5)
    ffn_w_down = nrm((DEPTH, 2, D_FF, D_MODEL), D_FF ** -0.5)
    ssm_w_in = nrm((NA, D_MODEL, SSM_WIDTH), D_MODEL ** -0.5)
    ssm_lam_re = -0.5 + nrm((NA, G, N), 0.01)
    ssm_lam_im = math.pi * jnp.arange(N, dtype=f32)[None, None, :] + nrm((NA, G, N), 0.01)
    ssm_log_dt = jax.random.uniform(next(ks), (NA, G), f32, math.log(DT_MIN), math.log(DT_MAX))
    ssm_b_re = nrm((NA, G, N, C), (2.0 * C) ** -0.5)
    ssm_b_im = nrm((NA, G, N, C), (2.0 * C) ** -0.5)
    ssm_c_re = nrm((NA, G, C, N), (2.0 * N) ** -0.5)
    ssm_c_im = nrm((NA, G, C, N), (2.0 * N) ** -0.5)
    ssm_d = nrm((NA, G, C), 1.0)
    ssm_w_glu = nrm((NA, SSM_WIDTH, SSM_WIDTH), SSM_WIDTH ** -0.5)
    ssm_w_out = nrm((NA, SSM_WIDTH, D_MODEL), SSM_WIDTH ** -0.5)
    kv_norm_g = 1.0 + nrm((D_MODEL,), 0.02)
    w_k = nrm((D_MODEL, SB_WIDTH), D_MODEL ** -0.5)
    w_v = nrm((D_MODEL, SB_WIDTH), D_MODEL ** -0.5)
    sb_w_q = nrm((NB, D_MODEL, SB_WIDTH), D_MODEL ** -0.5)
    sb_w_o = nrm((NB, SB_WIDTH, D_MODEL), SB_WIDTH ** -0.5)
    return {"x": x, "norm_g": norm_g, "ffn_w_gate": ffn_w_gate, "ffn_w_up": ffn_w_up,
            "ffn_w_down": ffn_w_down, "ssm_w_in": ssm_w_in, "ssm_lam_re": ssm_lam_re,
            "ssm_lam_im": ssm_lam_im, "ssm_log_dt": ssm_log_dt, "ssm_b_re": ssm_b_re,
            "ssm_b_im": ssm_b_im, "ssm_c_re": ssm_c_re, "ssm_c_im": ssm_c_im, "ssm_d": ssm_d,
            "ssm_w_glu": ssm_w_glu, "ssm_w_out": ssm_w_out, "kv_norm_g": kv_norm_g,
            "w_k": w_k, "w_v": w_v, "sb_w_q": sb_w_q, "sb_w_o": sb_w_o}


def reference(x, norm_g, ffn_w_gate, ffn_w_up, ffn_w_down, ssm_w_in, ssm_lam_re, ssm_lam_im,
              ssm_log_dt, ssm_b_re, ssm_b_im, ssm_c_re, ssm_c_im, ssm_d, ssm_w_glu, ssm_w_out,
              kv_norm_g, w_k, w_v, sb_w_q, sb_w_o):
    k_shared = None
    v_shared = None
    for layer in range(DEPTH):
        g = norm_g[layer]
        h = swiglu(rms_norm(x, g[0]), ffn_w_gate[layer, 0], ffn_w_up[layer, 0], ffn_w_down[layer, 0])
        x = x + 0.5 * rms_norm(h, g[1])
        hn = rms_norm(x, g[2])
        if layer < N_A_LAYERS:
            a = layer
            mix = s5_mixer(hn, ssm_w_in[a], ssm_lam_re[a], ssm_lam_im[a], ssm_log_dt[a],
                           ssm_b_re[a], ssm_b_im[a], ssm_c_re[a], ssm_c_im[a], ssm_d[a],
                           ssm_w_glu[a], ssm_w_out[a])
        else:
            if k_shared is None:
                kv_in = rms_norm(x, kv_norm_g)
                k_shared = _split_heads(kv_in @ w_k)
                v_shared = _split_heads(kv_in @ w_v)
            b = layer - N_A_LAYERS
            q = _split_heads(hn @ sb_w_q[b])
            mix = _merge_heads(stick_breaking_attention(q, k_shared, v_shared)) @ sb_w_o[b]
        x = x + rms_norm(mix.astype(x.dtype), g[3])
        h = swiglu(rms_norm(x, g[4]), ffn_w_gate[layer, 1], ffn_w_up[layer, 1], ffn_w_down[layer, 1])
        x = x + 0.5 * rms_norm(h, g[5])
    return x
```

```cpp
#include <hip/hip_runtime.h>
#include <hip/hip_cooperative_groups.h>
#include <cstdio>
#include <cstdint>
namespace cg = cooperative_groups;
#ifndef MK_MULTI
#define MK_MULTI 1
#endif
#ifndef NO_SSM
#define SSM_CALL do { int lane_l = lane, wave_l = wave; asm volatile("" : "+v"(lane_l)); asm volatile("" : "+s"(wave_l)); ssm_naive_phase(ws, layer, lds, wave_l, lane_l); } while (0)
#else
#define SSM_CALL
#endif
#ifndef NO_ATTN
#define ATTN_CALL attn_naive_phase(Qb, Kb, Vb, Ob)
#else
#define ATTN_CALL
#endif
namespace pg8 {
#define PG8_LAS __attribute__((address_space(3)))
typedef unsigned short bf16_t;
typedef short bf16x8 __attribute__((ext_vector_type(8)));
typedef float f32x4 __attribute__((ext_vector_type(4)));
typedef unsigned u32x4 __attribute__((ext_vector_type(4)));
constexpr int BM = 256, BK = 64, HALF = 128, HTB = HALF * BK * 2  , STAGE_BYTES = 8 * HTB, NXCD = 8, WGM = 8;

__host__ __device__ __forceinline__ int lds_byte(int r, int c) { const int st = (r >> 4) * 2 + (c >> 5), rr = r & 15, cc = c & 31, ob = rr * 64 + cc * 2; return st * 1024 + (ob ^ (((ob >> 9) & 1) << 5)); }
__host__ __device__ __forceinline__ void stage_rc(int b, int& R, int& C) { const int st = b / 1024, sb = b % 1024, swz = sb ^ (((sb >> 9) & 1) << 5); R = (st >> 1) * 16 + swz / 64; C = (st & 1) * 32 + (swz % 64) / 2; }
__host__ __device__ __forceinline__ int perm32(int rho) { const int n = rho >> 4, i = rho & 15; return 8 * (i >> 2) + 4 * n + (i & 3); }

struct Unit { int pm, pn; };
struct Gemm { const bf16_t* A; const bf16_t* Bt; int M, N, K; };

struct StaticOrder {
    int nM, nN, nwg, G, c;
    __host__ __device__ void init(int M, int N, int G_, int c_) { nM = M / BM; nN = N / BM; nwg = nM * nN; G = G_; c = c_; }
    __host__ __device__ bool next(int i, Unit& u) const {
        const long L = (long)i * G + c; if (L >= nwg) return false;
        int wgid = (int)L; { const int q = nwg / NXCD, r = nwg % NXCD, xcd = wgid % NXCD, off = wgid / NXCD; wgid = (xcd < r ? xcd * (q + 1) : r * (q + 1) + (xcd - r) * q) + off; }
        const int nig = WGM * nN, gid = wgid / nig, fm = gid * WGM, gsz = (nM - fm) < WGM ? (nM - fm) : WGM;
        u.pm = fm + ((wgid % nig) % gsz); u.pn = (wgid % nig) / gsz; return true;
    }
    __device__ __forceinline__ void a_ready(const Unit&) const {}
    __device__ __forceinline__ void done(const Unit&) const {}
};

__device__ __forceinline__ unsigned cvt_pk_bf16(float lo, float hi) { unsigned r; asm volatile("v_cvt_pk_bf16_f32 %0, %1, %2" : "=v"(r) : "v"(lo), "v"(hi)); return r; }
typedef float f32x2 __attribute__((ext_vector_type(2)));
template <class Epi, class Sched, bool ALIGN_EPI = false, bool SP2 = false>
__device__ __forceinline__ void gemm_phase(PG8_LAS unsigned char* lds, const Gemm g, const Sched& S, const Epi& E) {
    int tid_l = threadIdx.x; asm volatile("" : "+v"(tid_l)); const int tid = tid_l, wid = __builtin_amdgcn_readfirstlane(tid >> 6), lane = tid & 63, wr = wid >> 2, wc = wid & 3, fr = lane & 15, fq = lane >> 4;
    const int K = g.K, nt = K / BK;
    unsigned voffA[2], voffB[2];
#pragma unroll
    for (int i = 0; i < 2; ++i) { int R, C; stage_rc(tid * 16 + i * 8192, R, C); const int Rb = Epi::PERM ? ((R & ~31) + perm32(R & 31)) : R;
        voffA[i] = (unsigned)(R * K + C) * 2u; voffB[i] = (unsigned)(Rb * K + C) * 2u; }
    const size_t kstep = (size_t)(BK * 2);
    const size_t hstep = (size_t)HALF * K * 2;
    const size_t tstep = 2 * hstep;
    const unsigned ldsw = (unsigned)wid * 1024u;
    const int aoff = lds_byte(wr * 64 + fr, fq * 8), boff = lds_byte(wc * 32 + fr, fq * 8);
#define PG8_SA(b, h) (((b) * 2 + (h)) * HTB)
#define PG8_SB(b, h) ((4 + (b) * 2 + (h)) * HTB)
#define PG8_STAGE(bufoff, gbase, voff) do { _Pragma("unroll") for (int _i = 0; _i < 2; ++_i) \
        __builtin_amdgcn_global_load_lds((const unsigned*)((const char*)(gbase) + (voff)[_i]), (PG8_LAS unsigned*)(lds + (bufoff) + ldsw + _i * 8192), 16, 0, 0); } while (0)
#define PG8_LDA(dst, b, h) do { _Pragma("unroll") for (int m = 0; m < 4; ++m) _Pragma("unroll") for (int k = 0; k < 2; ++k) dst[m][k] = *(const PG8_LAS bf16x8*)(lds + PG8_SA(b, h) + aoff + m * 2048 + k * 1024); } while (0)
#define PG8_LDB(dst, b, h) do { _Pragma("unroll") for (int n = 0; n < 2; ++n) _Pragma("unroll") for (int k = 0; k < 2; ++k) dst[n][k] = *(const PG8_LAS bf16x8*)(lds + PG8_SB(b, h) + boff + n * 2048 + k * 1024); } while (0)
#define PG8_MMA(ai, bj, At, Bt) do { __builtin_amdgcn_s_setprio(1); _Pragma("unroll") for (int m = 0; m < 4; ++m) _Pragma("unroll") for (int n = 0; n < 2; ++n) _Pragma("unroll") for (int k = 0; k < 2; ++k) \
        acc[ai][bj][m][n] = __builtin_amdgcn_mfma_f32_16x16x32_bf16(Bt[n][k], At[m][k], acc[ai][bj][m][n], 0, 0, 0); __builtin_amdgcn_s_setprio(0); } while (0)
#define PG8_WAIT_V(n) asm volatile("s_waitcnt vmcnt(" #n ")" ::: "memory")
#define PG8_WAIT_L(n) asm volatile("s_waitcnt lgkmcnt(" #n ")" ::: "memory")
#define PG8_BAR __builtin_amdgcn_s_barrier()
#define PG8_SCHED __builtin_amdgcn_sched_barrier(0)
    Unit cur, nxt; int ui = 0;
    if (!S.next(0, cur)) return;
    f32x4 acc[2][2][4][2];
#pragma unroll
    for (int a = 0; a < 2; ++a)
#pragma unroll
        for (int b = 0; b < 2; ++b)
#pragma unroll
            for (int m = 0; m < 4; ++m)
#pragma unroll
                for (int n = 0; n < 2; ++n) acc[a][b][m][n] = (f32x4){0.f, 0.f, 0.f, 0.f};
    bf16x8 At[4][2], B0[2][2], B1[2][2];
    const char* cA = (const char*)g.A + (size_t)cur.pm * tstep; const char* cB = (const char*)g.Bt + (size_t)cur.pn * tstep;
    S.a_ready(cur);
    if constexpr (SP2) {
        PG8_STAGE(PG8_SB(0, 0), cB, voffB); PG8_STAGE(PG8_SB(0, 1), cB + hstep, voffB); PG8_STAGE(PG8_SA(0, 0), cA, voffA); PG8_STAGE(PG8_SA(0, 1), cA + hstep, voffA);
        if (wr == 1) PG8_BAR;
        PG8_WAIT_V(2); PG8_BAR;
        PG8_STAGE(PG8_SB(1, 0), cB + kstep, voffB); PG8_STAGE(PG8_SA(1, 0), cA + kstep, voffA); PG8_STAGE(PG8_SB(1, 1), cB + hstep + kstep, voffB);
        PG8_WAIT_V(6); PG8_BAR;
    } else {
        PG8_STAGE(PG8_SB(0, 0), cB, voffB); PG8_STAGE(PG8_SA(0, 0), cA, voffA); PG8_STAGE(PG8_SB(0, 1), cB + hstep, voffB); PG8_STAGE(PG8_SA(0, 1), cA + hstep, voffA);
        if (wr == 1) PG8_BAR;
        PG8_WAIT_V(4); PG8_BAR;
        PG8_STAGE(PG8_SB(1, 0), cB + kstep, voffB); PG8_STAGE(PG8_SA(1, 0), cA + kstep, voffA); PG8_STAGE(PG8_SB(1, 1), cB + hstep + kstep, voffB);
        PG8_WAIT_V(6); PG8_BAR;
    }
    for (;;) {
        const bool has_next = S.next(ui + 1, nxt);
        const char* nA = has_next ? (const char*)g.A + (size_t)nxt.pm * tstep : cA; const char* nB = has_next ? (const char*)g.Bt + (size_t)nxt.pn * tstep : cB;
        for (int t = 0; t < nt; t += 2) {
            const bool last = (t == nt - 2);
            const char* a1 = cA + (size_t)(t + 1) * kstep;
            const char* a2 = last ? nA : cA + (size_t)(t + 2) * kstep; const char* b2 = last ? nB : cB + (size_t)(t + 2) * kstep;
            const char* a3 = a2 + kstep; const char* b3 = b2 + kstep;
            if (last && has_next) S.a_ready(nxt);
            if constexpr (SP2) {
            PG8_LDB(B0, 0, 0); PG8_LDB(B1, 0, 1); PG8_SCHED; PG8_LDA(At, 0, 0); PG8_STAGE(PG8_SA(1, 1), a1 + hstep, voffA);
            PG8_WAIT_V(8); PG8_WAIT_L(0); PG8_BAR; PG8_MMA(0, 0, At, B0); PG8_MMA(0, 1, At, B1); PG8_BAR; PG8_SCHED;
            PG8_LDA(At, 0, 1); PG8_STAGE(PG8_SB(0, 0), b2, voffB); PG8_STAGE(PG8_SB(0, 1), b2 + hstep, voffB); PG8_STAGE(PG8_SA(0, 0), a2, voffA);
            PG8_WAIT_V(8); PG8_WAIT_L(0); PG8_BAR; PG8_MMA(1, 0, At, B0); PG8_MMA(1, 1, At, B1); PG8_BAR; PG8_SCHED;
            PG8_LDB(B0, 1, 0); PG8_LDB(B1, 1, 1); PG8_SCHED; PG8_LDA(At, 1, 0); PG8_STAGE(PG8_SA(0, 1), a2 + hstep, voffA);
            PG8_WAIT_V(8); PG8_WAIT_L(0); PG8_BAR; PG8_MMA(0, 0, At, B0); PG8_MMA(0, 1, At, B1); PG8_BAR; PG8_SCHED;
            PG8_LDA(At, 1, 1); PG8_STAGE(PG8_SB(1, 0), b3, voffB); PG8_STAGE(PG8_SB(1, 1), b3 + hstep, voffB); PG8_STAGE(PG8_SA(1, 0), a3, voffA);
            PG8_WAIT_V(8); PG8_WAIT_L(0); PG8_BAR; PG8_MMA(1, 0, At, B0); PG8_MMA(1, 1, At, B1); PG8_BAR; PG8_SCHED;
            } else {
            PG8_LDB(B0, 0, 0); PG8_SCHED; PG8_LDA(At, 0, 0); PG8_STAGE(PG8_SA(1, 1), a1 + hstep, voffA);
            PG8_WAIT_L(8); PG8_BAR; PG8_WAIT_L(0); PG8_MMA(0, 0, At, B0); PG8_BAR; PG8_SCHED;
            PG8_LDB(B1, 0, 1); PG8_STAGE(PG8_SB(0, 0), b2, voffB);
            PG8_BAR; PG8_WAIT_L(0); PG8_MMA(0, 1, At, B1); PG8_BAR;
            PG8_LDA(At, 0, 1); PG8_STAGE(PG8_SA(0, 0), a2, voffA);
            PG8_BAR; PG8_WAIT_L(0); PG8_MMA(1, 0, At, B0); PG8_BAR; PG8_SCHED;
            PG8_STAGE(PG8_SB(0, 1), b2 + hstep, voffB);
            PG8_WAIT_V(6); PG8_BAR; PG8_MMA(1, 1, At, B1); PG8_BAR;
            PG8_LDB(B0, 1, 0); PG8_SCHED; PG8_LDA(At, 1, 0); PG8_STAGE(PG8_SA(0, 1), a2 + hstep, voffA);
            PG8_WAIT_L(8); PG8_BAR; PG8_WAIT_L(0); PG8_MMA(0, 0, At, B0); PG8_BAR; PG8_SCHED;
            PG8_LDB(B1, 1, 1); PG8_STAGE(PG8_SB(1, 0), b3, voffB);
            PG8_BAR; PG8_WAIT_L(0); PG8_MMA(0, 1, At, B1); PG8_BAR;
            PG8_LDA(At, 1, 1); PG8_STAGE(PG8_SA(1, 0), a3, voffA);
            PG8_BAR; PG8_WAIT_L(0); PG8_MMA(1, 0, At, B0); PG8_BAR; PG8_SCHED;
            PG8_STAGE(PG8_SB(1, 1), b3 + hstep, voffB);
            PG8_WAIT_V(6); PG8_BAR; PG8_MMA(1, 1, At, B1); PG8_BAR;
            }
        }
        if constexpr (ALIGN_EPI) { if (wr == 0) PG8_BAR; }
        if constexpr (!Epi::AFTER_DRAIN) { E(acc, cur, wr, wc, fr, fq); S.done(cur); }
        if (!has_next) break;
#pragma unroll
        for (int a = 0; a < 2; ++a)
#pragma unroll
            for (int b = 0; b < 2; ++b)
#pragma unroll
                for (int m = 0; m < 4; ++m)
#pragma unroll
                    for (int n = 0; n < 2; ++n) acc[a][b][m][n] = (f32x4){0.f, 0.f, 0.f, 0.f};
        cur = nxt; cA = nA; cB = nB; ++ui;
        if constexpr (ALIGN_EPI) { if (wr == 1) PG8_BAR; }
    }
    PG8_WAIT_V(0);
    if constexpr (!ALIGN_EPI) { if (wr == 0) PG8_BAR; }
    PG8_BAR;
    if constexpr (Epi::AFTER_DRAIN) { E.fused(acc, cur, wr, wc, fr, fq, lds, wid, lane); S.done(cur); }
#undef PG8_SA
#undef PG8_SB
#undef PG8_STAGE
#undef PG8_LDA
#undef PG8_LDB
#undef PG8_MMA
#undef PG8_WAIT_V
#undef PG8_WAIT_L
#undef PG8_BAR
#undef PG8_SCHED
}
}
typedef unsigned short bf16_t;
typedef float f32x4 __attribute__((ext_vector_type(4)));
typedef unsigned u32x4 __attribute__((ext_vector_type(4)));
typedef unsigned u32x2 __attribute__((ext_vector_type(2)));
constexpr int DM = 1024, NB = 16, SEQ = 4096, MTOK = NB * SEQ, DFF = 2816, NHEAD = 16, HDIM = 64;
constexpr int SG = 64, SC = 16, SN = 64;
constexpr float NORM_EPS = 1e-6f;
constexpr int UA_LD = 1152;
constexpr size_t UA_G = (size_t)1024 * UA_LD;
constexpr size_t MiB = 1u << 20;
constexpr size_t WS_RS = 1 * MiB;
constexpr size_t WS_W = 2 * MiB;
constexpr size_t W_GU = (size_t)2 * DFF * DM;
constexpr size_t W_DN = (size_t)DM * DFF;
constexpr size_t W_FFN = W_GU + W_DN;
constexpr size_t W_SQ = (size_t)DM * DM;
constexpr size_t WO_FFN = 0, WO_SSM = 8 * W_FFN, WO_QKV = WO_SSM + 6 * W_SQ, WO_Q1 = WO_QKV + 3 * W_SQ, WO_O = WO_Q1 + W_SQ, WO_END = WO_O + 2 * W_SQ;
static_assert(WS_W + WO_END * 2 <= 160 * MiB, "weights fit");
constexpr size_t WS_XB = 160 * MiB;
constexpr size_t WS_HID = 288 * MiB;
constexpr size_t WS_UA = WS_HID, WS_Y = WS_HID + 144 * MiB, WS_Z = WS_HID;
constexpr size_t WS_Q = WS_HID, WS_O = WS_HID + 128 * MiB;
constexpr size_t WS_K = 640 * MiB, WS_V = 768 * MiB, WS_SP = 896 * MiB, WS_END = 900 * MiB;
constexpr int SP_NG = 0, SP_LRE = 24576, SP_LIM = SP_LRE + 8192, SP_LDT = SP_LIM + 8192, SP_BRE = SP_LDT + 128, SP_BIM = SP_BRE + 131072, SP_CRE = SP_BIM + 131072, SP_CIM = SP_CRE + 131072, SP_SD = SP_CIM + 131072, SP_AR = SP_SD + 2048, SP_AI = SP_AR + 8192, SP_BBR = SP_AI + 8192, SP_BBI = SP_BBR + 131072, SP_END = SP_BBI + 131072;
static_assert((size_t)SP_END * 4 <= 4 * MiB, "SP fits");
static_assert(WS_HID + (size_t)MTOK * DFF * 2 <= WS_K, "hid fits");

__device__ __forceinline__ float bf_lo(unsigned w) { return __uint_as_float(w << 16); }
__device__ __forceinline__ float bf_hi(unsigned w) { return __uint_as_float(w & 0xffff0000u); }
__device__ __forceinline__ float wave_sum(float v) {
#pragma unroll
    for (int o = 1; o < 64; o <<= 1) v += __shfl_xor(v, o);
    return v;
}
__device__ __forceinline__ float sigmoidf_(float v) { return __builtin_amdgcn_rcpf(1.0f + __expf(-v)); }
using pg8::Unit; using pg8::cvt_pk_bf16;

template <class Op> struct EpiGen {
    static constexpr bool PERM = true, AFTER_DRAIN = false;
    Op op;
    __device__ __forceinline__ void operator()(const f32x4 (&acc)[2][2][4][2], const Unit& u, int wr, int wc, int fr, int fq) const {
        const int row0 = u.pm * 256 + wr * 64 + fr, cin = wc * 32 + 8 * fq;
#pragma unroll
        for (int ai = 0; ai < 2; ++ai)
#pragma unroll
            for (int m = 0; m < 4; ++m) { op(u, row0 + ai * 128 + m * 16, cin, acc[ai][0][m][0], acc[ai][0][m][1], acc[ai][1][m][0], acc[ai][1][m][1]); asm volatile("" ::: "memory"); }
    }
};
__device__ __forceinline__ u32x4 pack8(f32x4 a, f32x4 b) { u32x4 w; w.x = cvt_pk_bf16(a[0], a[1]); w.y = cvt_pk_bf16(a[2], a[3]); w.z = cvt_pk_bf16(b[0], b[1]); w.w = cvt_pk_bf16(b[2], b[3]); return w; }
struct OpSwiglu { const float* rs; bf16_t* H;
    __device__ __forceinline__ void operator()(const Unit& u, int row, int cin, f32x4 g0, f32x4 g1, f32x4 u0, f32x4 u1) const {
        const float r = rs[row]; f32x4 h0, h1;
#pragma unroll
        for (int i = 0; i < 4; ++i) { const float a = g0[i] * r, b = g1[i] * r; h0[i] = a * sigmoidf_(a) * (u0[i] * r); h1[i] = b * sigmoidf_(b) * (u1[i] * r); }
        *(u32x4*)(H + (size_t)row * DFF + u.pn * 128 + cin) = pack8(h0, h1);
    } };
struct OpStore { bf16_t* O; int ldc; const float* rs; float sc;
    __device__ __forceinline__ void operator()(const Unit& u, int row, int cin, f32x4 a0, f32x4 a1, f32x4 b0, f32x4 b1) const {
        const float r = rs ? rs[row] * sc : sc; bf16_t* p = O + (size_t)row * ldc + u.pn * 256 + cin;
        *(u32x4*)p = pack8(a0 * r, a1 * r); *(u32x4*)(p + 128) = pack8(b0 * r, b1 * r);
    } };
struct OpQKV { unsigned char* ws; const float* rs;
    __device__ __forceinline__ void operator()(const Unit& u, int row, int cin, f32x4 a0, f32x4 a1, f32x4 b0, f32x4 b1) const {
        const int t = u.pn >> 2; bf16_t* base = (bf16_t*)(ws + ((t == 0) ? WS_Q : (WS_K + (size_t)(t - 1) * (128 * MiB)))); const float r = rs[row] * (t == 0 ? 0.125f : 1.0f);
        bf16_t* p = base + (size_t)row * DM + (u.pn & 3) * 256 + cin;
        *(u32x4*)p = pack8(a0 * r, a1 * r); *(u32x4*)(p + 128) = pack8(b0 * r, b1 * r);
    } };
struct OpUA { bf16_t* UA; const float* rs;
    __device__ __forceinline__ void operator()(const Unit& u, int row, int cin, f32x4 a0, f32x4 a1, f32x4 b0, f32x4 b1) const {
        const float r = rs[row]; const int col = u.pn * 256 + cin; const size_t ro = (size_t)(row >> 6) * UA_LD + 128 + (row & 63) * 16 + (col & 15);
        *(u32x4*)(UA + (size_t)(col >> 4) * UA_G + ro) = pack8(a0 * r, a1 * r);
        *(u32x4*)(UA + (size_t)((col + 128) >> 4) * UA_G + ro) = pack8(b0 * r, b1 * r);
    } };
struct OpGLU { const bf16_t* Y; bf16_t* Z;
    __device__ __forceinline__ void operator()(const Unit& u, int row, int cin, f32x4 a0, f32x4 a1, f32x4 b0, f32x4 b1) const {
        const size_t off = (size_t)row * DM + u.pn * 256 + cin;
#pragma unroll
        for (int hb = 0; hb < 2; ++hb) { const u32x4 y = *(const u32x4*)(Y + off + hb * 128); const f32x4 c0 = hb ? b0 : a0, c1 = hb ? b1 : a1; f32x4 z0, z1;
            z0[0] = bf_lo(y.x) * sigmoidf_(c0[0]); z0[1] = bf_hi(y.x) * sigmoidf_(c0[1]); z0[2] = bf_lo(y.y) * sigmoidf_(c0[2]); z0[3] = bf_hi(y.y) * sigmoidf_(c0[3]);
            z1[0] = bf_lo(y.z) * sigmoidf_(c1[0]); z1[1] = bf_hi(y.z) * sigmoidf_(c1[1]); z1[2] = bf_lo(y.w) * sigmoidf_(c1[2]); z1[3] = bf_hi(y.w) * sigmoidf_(c1[3]);
            *(u32x4*)(Z + off + hb * 128) = pack8(z0, z1); }
    } };

#define LAS __attribute__((address_space(3)))
constexpr int NWAVES = 8, LDS_BYTES = 147456, RING_BYTES = 131072;
struct Args { const float* in[21]; float* out; unsigned char* ws; int ph_lo, ph_hi; };
enum { I_X = 0, I_NG, I_WG, I_WU, I_WD, I_SWIN, I_LRE, I_LIM, I_LDT, I_BRE, I_BIM, I_CRE, I_CIM, I_SD, I_SWGLU, I_SWOUT, I_KVG, I_WK, I_WV, I_WQ, I_WO };

__device__ __forceinline__ unsigned f2bf(float f) { unsigned u = __builtin_bit_cast(unsigned, f); return (u + 0x7fffu + ((u >> 16) & 1u)) >> 16; }
__device__ __forceinline__ unsigned pk2(float lo, float hi) { return f2bf(lo) | (f2bf(hi) << 16); }
__device__ __forceinline__ void transpose_item(const float* W, int K, int N, const float* gain, int mode, bf16_t* WT, int row_off, LAS float* scr, int item, int lane) {
    const int nblk = N / 32, kb = item / nblk, nb = item % nblk, k0 = 64 * kb, n0 = 32 * nb;
#pragma unroll 8
    for (int i = 0; i < 32; ++i) { const int kk = 2 * i + (lane >> 5); float v = W[(size_t)(k0 + kk) * N + n0 + (lane & 31)]; if (gain) v *= gain[k0 + kk]; scr[kk * 33 + (lane & 31)] = v; }
    asm volatile("s_waitcnt lgkmcnt(0)" ::: "memory");
    const int c = lane & 7; const int r0 = mode == 0 ? row_off + n0 : (256 * (n0 >> 7) + (n0 & 127) + (mode == 2 ? 128 : 0));
#pragma unroll
    for (int j = 0; j < 4; ++j) { const int n = (lane >> 3) + 8 * j; const LAS float* s = scr + (8 * c) * 33 + n;
        u32x4 o; o.x = pk2(s[0 * 33], s[1 * 33]); o.y = pk2(s[2 * 33], s[3 * 33]); o.z = pk2(s[4 * 33], s[5 * 33]); o.w = pk2(s[6 * 33], s[7 * 33]);
        *(u32x4*)(WT + (size_t)(r0 + n) * K + k0 + 8 * c) = o; }
    asm volatile("s_waitcnt lgkmcnt(0)" ::: "memory");
}
#define CONV(Wp, K_, N_, gain_, mode_, dst_, roff_) do { const int n_items_ = ((K_) / 64) * ((N_) / 32); int it_ = cstart; \
    for (; it_ < n_items_; it_ += NGW) transpose_item((Wp), (K_), (N_), (gain_), (mode_), (dst_), (roff_), scr, it_, lane); cstart = it_ - n_items_; } while (0)

template <int MODE> __device__ __forceinline__ void row_update(const float* xsrc, float* xout, bf16_t* xb, float* rs, const float* g, float alpha, int gw, int NGW, int lane) {
    for (int row = gw; row < MTOK; row += NGW) {
        const float* xr = xsrc + (size_t)row * DM; bf16_t* br = xb + (size_t)row * DM;
        f32x4 xv[4]; float tv[16];
#pragma unroll
        for (int h = 0; h < 2; ++h) { xv[2 * h] = *(const f32x4*)(xr + h * 512 + lane * 8); xv[2 * h + 1] = *(const f32x4*)(xr + h * 512 + lane * 8 + 4); }
        if (MODE == 1) {
            float ss = 0.f;
#pragma unroll
            for (int h = 0; h < 2; ++h) { const u32x4 t = *(const u32x4*)(br + h * 512 + lane * 8);
                tv[8 * h + 0] = bf_lo(t.x); tv[8 * h + 1] = bf_hi(t.x); tv[8 * h + 2] = bf_lo(t.y); tv[8 * h + 3] = bf_hi(t.y); tv[8 * h + 4] = bf_lo(t.z); tv[8 * h + 5] = bf_hi(t.z); tv[8 * h + 6] = bf_lo(t.w); tv[8 * h + 7] = bf_hi(t.w); }
#pragma unroll
            for (int i = 0; i < 16; ++i) ss += tv[i] * tv[i];
            const float r = alpha * rsqrtf(wave_sum(ss) * (1.0f / DM) + NORM_EPS);
#pragma unroll
            for (int h = 0; h < 2; ++h) { const f32x4 g0 = *(const f32x4*)(g + h * 512 + lane * 8), g1 = *(const f32x4*)(g + h * 512 + lane * 8 + 4);
#pragma unroll
                for (int i = 0; i < 4; ++i) { xv[2 * h][i] += tv[8 * h + i] * r * g0[i]; xv[2 * h + 1][i] += tv[8 * h + 4 + i] * r * g1[i]; } }
        }
        float s2 = 0.f;
#pragma unroll
        for (int j = 0; j < 4; ++j) s2 += (xv[j][0] * xv[j][0] + xv[j][1] * xv[j][1]) + (xv[j][2] * xv[j][2] + xv[j][3] * xv[j][3]);
        s2 = wave_sum(s2);
        if (lane == 0) rs[row] = rsqrtf(s2 * (1.0f / DM) + NORM_EPS);
        float* xo = xout + (size_t)row * DM;
#pragma unroll
        for (int h = 0; h < 2; ++h) { *(f32x4*)(xo + h * 512 + lane * 8) = xv[2 * h]; *(f32x4*)(xo + h * 512 + lane * 8 + 4) = xv[2 * h + 1];
            *(u32x4*)(br + h * 512 + lane * 8) = pack8(xv[2 * h], xv[2 * h + 1]); }
    }
}

__device__ __forceinline__ void sincos2pi(double r, double& s, double& c) {
    const double x = r * 6.283185307179586476925, x2 = x * x;
    double ts = 1.0 / 121645100408832000.0 * -1.0;
    double ps = -1.0 / 25852016738884976640000.0;
    ps = ps * x2 + 1.0 / 51090942171709440000.0;
    ps = ps * x2 - 1.0 / 121645100408832000.0;
    ps = ps * x2 + 1.0 / 355687428096000.0;
    ps = ps * x2 - 1.0 / 1307674368000.0;
    ps = ps * x2 + 1.0 / 6227020800.0;
    ps = ps * x2 - 1.0 / 39916800.0;
    ps = ps * x2 + 1.0 / 362880.0;
    ps = ps * x2 - 1.0 / 5040.0;
    ps = ps * x2 + 1.0 / 120.0;
    ps = ps * x2 - 1.0 / 6.0;
    ps = ps * x2 + 1.0;
    s = ps * x; (void)ts;
    double pc = 1.0 / 620448401733239439360000.0;
    pc = pc * x2 - 1.0 / 1124000727777607680000.0;
    pc = pc * x2 + 1.0 / 2432902008176640000.0;
    pc = pc * x2 - 1.0 / 6402373705728000.0;
    pc = pc * x2 + 1.0 / 20922789888000.0;
    pc = pc * x2 - 1.0 / 87178291200.0;
    pc = pc * x2 + 1.0 / 479001600.0;
    pc = pc * x2 - 1.0 / 3628800.0;
    pc = pc * x2 + 1.0 / 40320.0;
    pc = pc * x2 - 1.0 / 720.0;
    pc = pc * x2 + 1.0 / 24.0;
    pc = pc * x2 - 0.5;
    c = pc * x2 + 1.0;
}
__device__ __forceinline__ double exp_small(double v) {
    double p = 1.0 / 87178291200.0;
    p = p * v + 1.0 / 6227020800.0; p = p * v + 1.0 / 479001600.0; p = p * v + 1.0 / 39916800.0; p = p * v + 1.0 / 3628800.0; p = p * v + 1.0 / 362880.0; p = p * v + 1.0 / 40320.0;
    p = p * v + 1.0 / 5040.0; p = p * v + 1.0 / 720.0; p = p * v + 1.0 / 120.0; p = p * v + 1.0 / 24.0; p = p * v + 1.0 / 6.0; p = p * v + 0.5; p = p * v + 1.0; p = p * v + 1.0; return p;
}
__device__ __forceinline__ double exp_neg(double v) { double e = exp_small(v * 0.0625); e *= e; e *= e; e *= e; e *= e; return e; }
__device__ __forceinline__ void cpow_lam(double lrdt, double lidt, int d, double& re, double& im) {
    double m = (double)d * lrdt;
    double mag = 1.0;
    while (m < -8.0) { mag *= 3.3546262790251185e-4; m += 8.0; }
    while (m > 0.5) { mag *= 1.6487212707001282; m -= 0.5; }
    mag *= (m <= 0.0) ? exp_neg(m) : exp_small(m);
    double rev = (double)d * lidt * 0.15915494309189533577; rev -= __builtin_rint(rev);
    double s, c; sincos2pi(rev, s, c); re = mag * c; im = mag * s;
}
__device__ __forceinline__ float gelu_tanh(float x) { const float v = 1.5957691216057308f * (x + 0.044715f * x * x * x); return x * sigmoidf_(v); }

__device__ __forceinline__ void ssm_naive_phase(unsigned char* ws, int a, LAS unsigned char* lds, int wave, int lane) {
    if (wave >= 4) return;
    const float* sp = (const float*)(ws + WS_SP);
    const bf16_t* UA = (const bf16_t*)(ws + WS_UA); bf16_t* Y = (bf16_t*)(ws + WS_Y);
    LAS float* ul = (LAS float*)(lds + wave * 8192); LAS float* yl = ul + 1024;
    for (int task = blockIdx.x * 4 + wave; task < NB * SG; task += gridDim.x * 4) {
        const int b = task >> 6, g = task & 63, n = lane;
        float bbr[16], bbi[16], cr[16], ci[16];
        const int agn = (a * SG + g) * SN + n;
#pragma unroll
        for (int c4 = 0; c4 < 4; ++c4) { const f32x4 r4 = *(const f32x4*)(sp + SP_BBR + agn * SC + c4 * 4), i4 = *(const f32x4*)(sp + SP_BBI + agn * SC + c4 * 4);
#pragma unroll
            for (int e = 0; e < 4; ++e) { bbr[c4 * 4 + e] = r4[e]; bbi[c4 * 4 + e] = i4[e]; } }
#pragma unroll
        for (int c = 0; c < 16; ++c) { cr[c] = sp[SP_CRE + ((a * SG + g) * SC + c) * SN + n]; ci[c] = sp[SP_CIM + ((a * SG + g) * SC + c) * SN + n]; }
        const float ar = sp[SP_AR + agn], ai = sp[SP_AI + agn];
        const int cl = (lane >> 2) & 15; const float dl = sp[SP_SD + (a * SG + g) * SC + cl];
        float sr = 0.f, si = 0.f;
        for (int k = 0; k < 64; ++k) {
            { const bf16_t* src = UA + (size_t)g * UA_G + (size_t)(b * 64 + k) * UA_LD + 128 + lane * 16;
              const u32x4 p0 = *(const u32x4*)src, p1 = *(const u32x4*)(src + 8);
              LAS f32x4* d = (LAS f32x4*)(ul + lane * 16);
              d[0] = (f32x4){bf_lo(p0.x), bf_hi(p0.x), bf_lo(p0.y), bf_hi(p0.y)}; d[1] = (f32x4){bf_lo(p0.z), bf_hi(p0.z), bf_lo(p0.w), bf_hi(p0.w)};
              d[2] = (f32x4){bf_lo(p1.x), bf_hi(p1.x), bf_lo(p1.y), bf_hi(p1.y)}; d[3] = (f32x4){bf_lo(p1.z), bf_hi(p1.z), bf_lo(p1.w), bf_hi(p1.w)}; }
            asm volatile("s_waitcnt lgkmcnt(0)" ::: "memory");
#pragma unroll 2
            for (int j = 0; j < 64; ++j) {
                const LAS f32x4* up = (const LAS f32x4*)(ul + j * 16); const f32x4 u0 = up[0], u1 = up[1], u2 = up[2], u3 = up[3];
                const float uu[16] = {u0[0], u0[1], u0[2], u0[3], u1[0], u1[1], u1[2], u1[3], u2[0], u2[1], u2[2], u2[3], u3[0], u3[1], u3[2], u3[3]};
                float bur = 0.f, bui = 0.f;
#pragma unroll
                for (int c = 0; c < 16; ++c) { bur += bbr[c] * uu[c]; bui += bbi[c] * uu[c]; }
                const float nsr = ar * sr - ai * si + bur, nsi = ar * si + ai * sr + bui; sr = nsr; si = nsi;
                float v[16];
#pragma unroll
                for (int c = 0; c < 16; ++c) v[c] = sr * cr[c] - si * ci[c];
                float w8[8], w4[4], w2[2], w1;
                { const bool h = (lane & 32) != 0;
#pragma unroll
                  for (int i = 0; i < 8; ++i) { const float send = h ? v[i] : v[i + 8], keep = h ? v[i + 8] : v[i]; w8[i] = keep + __shfl_xor(send, 32); } }
                { const bool h = (lane & 16) != 0;
#pragma unroll
                  for (int i = 0; i < 4; ++i) { const float send = h ? w8[i] : w8[i + 4], keep = h ? w8[i + 4] : w8[i]; w4[i] = keep + __shfl_xor(send, 16); } }
                { const bool h = (lane & 8) != 0;
#pragma unroll
                  for (int i = 0; i < 2; ++i) { const float send = h ? w4[i] : w4[i + 2], keep = h ? w4[i + 2] : w4[i]; w2[i] = keep + __shfl_xor(send, 8); } }
                { const bool h = (lane & 4) != 0; const float send = h ? w2[0] : w2[1], keep = h ? w2[1] : w2[0]; w1 = keep + __shfl_xor(send, 4); }
                w1 += __shfl_xor(w1, 2); w1 += __shfl_xor(w1, 1);
                const float yv = gelu_tanh(w1 + dl * ul[j * 16 + cl]);
                if ((lane & 3) == 0) yl[j * 16 + cl] = yv;
            }
            asm volatile("s_waitcnt lgkmcnt(0)" ::: "memory");
            { const LAS f32x4* yp = (const LAS f32x4*)(yl + lane * 16); const f32x4 y0 = yp[0], y1 = yp[1], y2 = yp[2], y3 = yp[3];
              bf16_t* dst = Y + (size_t)(b * SEQ + k * 64 + lane) * DM + g * 16;
              *(u32x4*)dst = pack8(y0, y1); *(u32x4*)(dst + 8) = pack8(y2, y3); }
            asm volatile("s_waitcnt lgkmcnt(0)" ::: "memory");
        }
    }
}

__device__ __forceinline__ void attn_naive_phase(const bf16_t* Q, const bf16_t* K, const bf16_t* V, bf16_t* O) {
    for (int unit = blockIdx.x; unit < NB * NHEAD * (SEQ / 512); unit += gridDim.x) {
        const int bh = unit >> 3, tc = unit & 7, b = bh >> 4, h = bh & 15, t = tc * 512 + (int)threadIdx.x;
        const size_t row = (size_t)b * SEQ + t;
        float q[64], o[64];
        { const u32x4* qp = (const u32x4*)(Q + row * DM + h * 64);
#pragma unroll
          for (int i = 0; i < 8; ++i) { const u32x4 w = qp[i]; q[8 * i] = bf_lo(w.x); q[8 * i + 1] = bf_hi(w.x); q[8 * i + 2] = bf_lo(w.y); q[8 * i + 3] = bf_hi(w.y); q[8 * i + 4] = bf_lo(w.z); q[8 * i + 5] = bf_hi(w.z); q[8 * i + 6] = bf_lo(w.w); q[8 * i + 7] = bf_hi(w.w); } }
#pragma unroll
        for (int i = 0; i < 64; ++i) o[i] = 0.f;
        float R = 0.f;
        for (int s = t - 1; s >= 0; --s) {
            const u32x4* kp = (const u32x4*)(K + ((size_t)b * SEQ + s) * DM + h * 64);
            float z = 0.f;
#pragma unroll
            for (int i = 0; i < 8; ++i) { const u32x4 w = kp[i]; z += q[8 * i] * bf_lo(w.x) + q[8 * i + 1] * bf_hi(w.x) + q[8 * i + 2] * bf_lo(w.y) + q[8 * i + 3] * bf_hi(w.y) + q[8 * i + 4] * bf_lo(w.z) + q[8 * i + 5] * bf_hi(w.z) + q[8 * i + 6] * bf_lo(w.w) + q[8 * i + 7] * bf_hi(w.w); }
            const float sp = fmaxf(z, 0.f) + __logf(1.0f + __expf(-fabsf(z)));
            R -= sp;
            const float w = __expf(z + R);
            const u32x4* vp = (const u32x4*)(V + ((size_t)b * SEQ + s) * DM + h * 64);
#pragma unroll
            for (int i = 0; i < 8; ++i) { const u32x4 x = vp[i]; o[8 * i] += w * bf_lo(x.x); o[8 * i + 1] += w * bf_hi(x.x); o[8 * i + 2] += w * bf_lo(x.y); o[8 * i + 3] += w * bf_hi(x.y); o[8 * i + 4] += w * bf_lo(x.z); o[8 * i + 5] += w * bf_hi(x.z); o[8 * i + 6] += w * bf_lo(x.w); o[8 * i + 7] += w * bf_hi(x.w); }
            if (R < -40.f) break;
        }
        u32x4* op = (u32x4*)(O + row * DM + h * 64);
#pragma unroll
        for (int i = 0; i < 8; ++i) { u32x4 w; w.x = cvt_pk_bf16(o[8 * i], o[8 * i + 1]); w.y = cvt_pk_bf16(o[8 * i + 2], o[8 * i + 3]); w.z = cvt_pk_bf16(o[8 * i + 4], o[8 * i + 5]); w.w = cvt_pk_bf16(o[8 * i + 6], o[8 * i + 7]); op[i] = w; }
    }
}

constexpr int NPH = 1 + 2 * 11 + 2 * 10;
template <class Op> __device__ __forceinline__ void run_gemm(LAS unsigned char* lds, const bf16_t* A, const bf16_t* Bt, int M, int N, int K, const Op& op) {
    pg8::Gemm g{A, Bt, M, N, K}; pg8::StaticOrder S; S.init(M, N, (int)gridDim.x, (int)blockIdx.x); EpiGen<Op> E{op};
    pg8::gemm_phase<EpiGen<Op>, pg8::StaticOrder, true, true>(lds, g, S, E);
}
__global__ void __launch_bounds__(NWAVES * 64, 2) mk_fwd(Args A) {
    extern __shared__ __attribute__((aligned(16))) unsigned char lds_raw[];
    LAS unsigned char* lds = (LAS unsigned char*)lds_raw;
    const int tid = threadIdx.x, lane = tid & 63, wave = __builtin_amdgcn_readfirstlane(tid >> 6);
    const int gw = blockIdx.x * NWAVES + wave, NGW = gridDim.x * NWAVES;
    unsigned char* ws = A.ws;
    float* RS = (float*)(ws + WS_RS); bf16_t* Wb = (bf16_t*)(ws + WS_W); bf16_t* XB = (bf16_t*)(ws + WS_XB); bf16_t* HID = (bf16_t*)(ws + WS_HID);
    bf16_t* UA = (bf16_t*)(ws + WS_UA); bf16_t* Yb = (bf16_t*)(ws + WS_Y); bf16_t* Zb = (bf16_t*)(ws + WS_Z);
    bf16_t* Qb = (bf16_t*)(ws + WS_Q); bf16_t* Ob = (bf16_t*)(ws + WS_O); bf16_t* Kb = (bf16_t*)(ws + WS_K); bf16_t* Vb = (bf16_t*)(ws + WS_V);
    float* X = A.out; const float* SP = (const float*)(ws + WS_SP); const float* NG = SP + SP_NG;
    int p0 = A.ph_lo;
    if (p0 == 0) {
        {
            LAS float* scr = (LAS float*)(lds + wave * 16384); int cstart = gw;
            const float* NGi = A.in[I_NG];
            for (int l = 0; l < 4; ++l) for (int j = 0; j < 2; ++j) { const int lj = l * 2 + j; bf16_t* wgu = Wb + WO_FFN + (size_t)lj * W_FFN; const float* gn = NGi + (l * 6 + (j ? 4 : 0)) * DM;
                CONV(A.in[I_WG] + (size_t)lj * DM * DFF, DM, DFF, gn, 1, wgu, 0); CONV(A.in[I_WU] + (size_t)lj * DM * DFF, DM, DFF, gn, 2, wgu, 0);
                CONV(A.in[I_WD] + (size_t)lj * DFF * DM, DFF, DM, (const float*)nullptr, 0, wgu + W_GU, 0); }
            for (int a = 0; a < 2; ++a) { bf16_t* w = Wb + WO_SSM + (size_t)a * 3 * W_SQ;
                CONV(A.in[I_SWIN] + (size_t)a * W_SQ, DM, DM, NGi + (a * 6 + 2) * DM, 0, w, 0); CONV(A.in[I_SWGLU] + (size_t)a * W_SQ, DM, DM, (const float*)nullptr, 0, w + W_SQ, 0);
                CONV(A.in[I_SWOUT] + (size_t)a * W_SQ, DM, DM, (const float*)nullptr, 0, w + 2 * W_SQ, 0); }
            CONV(A.in[I_WQ], DM, DM, NGi + (2 * 6 + 2) * DM, 0, Wb + WO_QKV, 0); CONV(A.in[I_WK], DM, DM, A.in[I_KVG], 0, Wb + WO_QKV, DM); CONV(A.in[I_WV], DM, DM, A.in[I_KVG], 0, Wb + WO_QKV, 2 * DM);
            CONV(A.in[I_WQ] + W_SQ, DM, DM, NGi + (3 * 6 + 2) * DM, 0, Wb + WO_Q1, 0);
            CONV(A.in[I_WO], DM, DM, (const float*)nullptr, 0, Wb + WO_O, 0); CONV(A.in[I_WO] + W_SQ, DM, DM, (const float*)nullptr, 0, Wb + WO_O + W_SQ, 0);
            float* spw = (float*)(ws + WS_SP); const int gt = blockIdx.x * (NWAVES * 64) + tid, NGT = gridDim.x * NWAVES * 64;
#define COPYP(idx, off, n) for (int i_ = gt; i_ < (n); i_ += NGT) spw[(off) + i_] = A.in[idx][i_]
            COPYP(I_NG, SP_NG, 24576); COPYP(I_LRE, SP_LRE, 8192); COPYP(I_LIM, SP_LIM, 8192); COPYP(I_LDT, SP_LDT, 128); COPYP(I_BRE, SP_BRE, 131072); COPYP(I_BIM, SP_BIM, 131072);
            COPYP(I_CRE, SP_CRE, 131072); COPYP(I_CIM, SP_CIM, 131072); COPYP(I_SD, SP_SD, 2048);
            for (int i = gt; i < 2 * SG * SN; i += NGT) {
                const int ag = i >> 6;
                const double dt = (double)expf(A.in[I_LDT][ag]);
                const double lr = A.in[I_LRE][i], li = A.in[I_LIM][i];
                double are, aim; cpow_lam(lr * dt, li * dt, 1, are, aim);
                const double den = lr * lr + li * li, nr = are - 1.0, ni = aim;
                const double fre = (nr * lr + ni * li) / den, fim = (ni * lr - nr * li) / den;
                spw[SP_AR + i] = (float)are; spw[SP_AI + i] = (float)aim;
                for (int c = 0; c < 16; ++c) { const double br = A.in[I_BRE][(size_t)i * SC + c], bi = A.in[I_BIM][(size_t)i * SC + c];
                    spw[SP_BBR + i * SC + c] = (float)(fre * br - fim * bi); spw[SP_BBI + i * SC + c] = (float)(fre * bi + fim * br); }
            }
            row_update<0>(A.in[I_X], X, XB, RS, nullptr, 0.f, gw, NGW, lane);
        }
        p0 = 1;
        if (A.ph_hi > 1) { __threadfence(); cg::this_grid().sync(); }
    }
    for (int p = p0; p < A.ph_hi; ++p) {
        {
            const int q = p - 1, layer = q < 22 ? q / 11 : 2 + (q - 22) / 10, s = q < 22 ? q % 11 : (q - 22) % 10;
            const int nmix = layer < 2 ? 5 : 4;
            if (s < 3 || s >= 3 + nmix) {
                const int j = s < 3 ? 0 : 1, st = s < 3 ? s : s - 3 - nmix; const bf16_t* wgu = Wb + WO_FFN + (size_t)(layer * 2 + j) * W_FFN;
                if (st == 0) run_gemm(lds, XB, wgu, MTOK, 2 * DFF, DM, OpSwiglu{RS, HID});
                else if (st == 1) run_gemm(lds, HID, wgu + W_GU, MTOK, DM, DFF, OpStore{XB, DM, nullptr, 1.0f});
                else row_update<1>(X, X, XB, RS, NG + (layer * 6 + (j ? 5 : 1)) * DM, 0.5f, gw, NGW, lane);
            } else if (s == 3 + nmix - 1) {
                row_update<1>(X, X, XB, RS, NG + (layer * 6 + 3) * DM, 1.0f, gw, NGW, lane);
            } else if (layer < 2) {
                const bf16_t* w = Wb + WO_SSM + (size_t)layer * 3 * W_SQ; const int st = s - 3;
                if (st == 0) run_gemm(lds, XB, w, MTOK, DM, DM, OpUA{UA, RS});
                else if (st == 1) { SSM_CALL; }
                else if (st == 2) run_gemm(lds, Yb, w + W_SQ, MTOK, DM, DM, OpGLU{Yb, Zb});
                else run_gemm(lds, Zb, w + 2 * W_SQ, MTOK, DM, DM, OpStore{XB, DM, nullptr, 1.0f});
            } else {
                const int bl = layer - 2, st = s - 3;
                if (st == 0) { if (bl == 0) run_gemm(lds, XB, Wb + WO_QKV, MTOK, 3 * DM, DM, OpQKV{ws, RS}); else run_gemm(lds, XB, Wb + WO_Q1, MTOK, DM, DM, OpQKV{ws, RS}); }
                else if (st == 1) { ATTN_CALL; }
                else run_gemm(lds, Ob, Wb + WO_O + (size_t)bl * W_SQ, MTOK, DM, DM, OpStore{XB, DM, nullptr, 1.0f});
            }
        }
        if (p + 1 < A.ph_hi) { __threadfence(); cg::this_grid().sync(); }
    }
}

extern "C" void kernel_launch(void* const* d_in, const int* in_sizes, int n_in, void* d_out, int out_size, void* d_ws, size_t ws_size, hipStream_t stream) {
    static int grid = 0;
    if (grid == 0) {
        if (n_in != 21 || out_size != MTOK * DM || ws_size < WS_END) { fprintf(stderr, "kernel_launch: unexpected shapes (n_in %d out %d ws %zu)\n", n_in, out_size, ws_size); grid = -1; return; }
        int dev = 0, cus = 0, per_cu = 0;
        hipGetDevice(&dev); hipDeviceGetAttribute(&cus, hipDeviceAttributeMultiprocessorCount, dev);
        if (hipFuncSetAttribute((const void*)mk_fwd, hipFuncAttributeMaxDynamicSharedMemorySize, LDS_BYTES) != hipSuccess) { fprintf(stderr, "kernel_launch: hipFuncSetAttribute failed\n"); grid = -1; return; }
        hipOccupancyMaxActiveBlocksPerMultiprocessor(&per_cu, (const void*)mk_fwd, NWAVES * 64, LDS_BYTES);
        (void)hipGetLastError();
        if (per_cu < 1) per_cu = 1;
        grid = cus * 1;
        if (grid <= 0) grid = 256;
    }
    if (grid < 0) return;
    Args a{};
    for (int i = 0; i < 21; ++i) a.in[i] = (const float*)d_in[i];
    a.out = (float*)d_out; a.ws = (unsigned char*)d_ws;
#if MK_MULTI
    for (int p = 0; p < NPH; ++p) { a.ph_lo = p; a.ph_hi = p + 1; hipLaunchKernelGGL(mk_fwd, dim3(grid), dim3(NWAVES * 64), LDS_BYTES, stream, a); }
#else
    a.ph_lo = 0; a.ph_hi = NPH;
    void* args[] = {&a};
    hipError_t e = hipLaunchCooperativeKernel((const void*)mk_fwd, dim3(grid), dim3(NWAVES * 64), args, LDS_BYTES, stream);
    if (e != hipSuccess) fprintf(stderr, "cooperative launch failed: %s (grid %d)\n", hipGetErrorString(e), grid);
#endif
}
```

```cpp
#include <hip/hip_runtime.h>
#include <hip/hip_cooperative_groups.h>
#include <cstdio>
#include <cstdint>
namespace cg = cooperative_groups;
#ifndef MK_MULTI
#define MK_MULTI 0
#endif
#ifndef NO_SSM
#define SSM_CALL do { int lane_l = lane, wave_l = wave; asm volatile("" : "+v"(lane_l)); asm volatile("" : "+s"(wave_l)); ssm_naive_phase(ws, layer, lds, wave_l, lane_l); PROBE_SSM2 } while (0)
#else
#define SSM_CALL
#endif
#ifndef NO_ATTN
#ifdef ATTN_NAIVE
#define ATTN_CALL do { attn_naive_phase(Qb, Kb, Vb, Ob); PROBE_ATTN2 } while (0)
#else
#define ATTN_CALL do { int lane_l = lane; asm volatile("" : "+v"(lane_l)); attn_mfma_phase(Qb, Kb, Vb, Ob, lds, gw, NGW, wave, lane_l); } while (0)
#endif
#else
#define ATTN_CALL
#endif
#ifdef PROBE_SSM
#define PROBE_SSM2 asm volatile("" : "+v"(lane_l)); ssm_naive_phase(ws, layer, lds, wave_l, lane_l);
#else
#define PROBE_SSM2
#endif
#ifdef PROBE_ATTN
#define PROBE_ATTN2 asm volatile("" ::: "memory"); attn_naive_phase(Qb, Kb, Vb, Ob);
#else
#define PROBE_ATTN2
#endif
#ifdef PROBE_F1
#define PROBE_F1_X asm volatile("" ::: "memory"); run_gemm(lds, XB, wgu, MTOK, 2 * DFF, DM, OpSwiglu{RS, HID});
#else
#define PROBE_F1_X
#endif
#ifdef PROBE_F2
#define PROBE_F2_X asm volatile("" ::: "memory"); run_gemm(lds, HID, wgu + W_GU, MTOK, DM, DFF, OpStore{XB, DM, nullptr, 1.0f});
#else
#define PROBE_F2_X
#endif
#ifdef PROBE_RU
#define PROBE_RU_X asm volatile("" ::: "memory"); for (int rep_ = 0; rep_ < 4; ++rep_) { asm volatile("" ::: "memory"); row_update<0, 4>(A.in[I_X], X, XB, RS, nullptr, 0.f, gw, NGW, lane); }
#else
#define PROBE_RU_X
#endif
namespace pg8 {
#define PG8_LAS __attribute__((address_space(3)))
typedef unsigned short bf16_t;
typedef short bf16x8 __attribute__((ext_vector_type(8)));
typedef float f32x4 __attribute__((ext_vector_type(4)));
typedef unsigned u32x4 __attribute__((ext_vector_type(4)));
constexpr int BM = 256, BK = 64, HALF = 128, HTB = HALF * BK * 2  , STAGE_BYTES = 8 * HTB, NXCD = 8, WGM = 8;

__host__ __device__ __forceinline__ int lds_byte(int r, int c) { const int st = (r >> 4) * 2 + (c >> 5), rr = r & 15, cc = c & 31, ob = rr * 64 + cc * 2; return st * 1024 + (ob ^ (((ob >> 9) & 1) << 5)); }
__host__ __device__ __forceinline__ void stage_rc(int b, int& R, int& C) { const int st = b / 1024, sb = b % 1024, swz = sb ^ (((sb >> 9) & 1) << 5); R = (st >> 1) * 16 + swz / 64; C = (st & 1) * 32 + (swz % 64) / 2; }
__host__ __device__ __forceinline__ int perm32(int rho) { const int n = rho >> 4, i = rho & 15; return 8 * (i >> 2) + 4 * n + (i & 3); }

struct Unit { int pm, pn, z; };
struct Gemm { const bf16_t* A; const bf16_t* Bt; int M, N, K; int lda, ldb; size_t sAz, sBz; };

struct StaticOrder {
    int nM, nN, nwg, G, c;
    __host__ __device__ void init(int M, int N, int G_, int c_) { nM = M / BM; nN = N / BM; nwg = nM * nN; G = G_; c = c_; }
    __host__ __device__ bool next(int i, Unit& u) const {
        const long L = (long)i * G + c; if (L >= nwg) return false;
        int wgid = (int)L; { const int q = nwg / NXCD, r = nwg % NXCD, xcd = wgid % NXCD, off = wgid / NXCD; wgid = (xcd < r ? xcd * (q + 1) : r * (q + 1) + (xcd - r) * q) + off; }
        const int nig = WGM * nN, gid = wgid / nig, fm = gid * WGM, gsz = (nM - fm) < WGM ? (nM - fm) : WGM;
        u.pm = fm + ((wgid % nig) % gsz); u.pn = (wgid % nig) / gsz; u.z = 0; return true;
    }
    __device__ __forceinline__ void a_ready(const Unit&) const {}
    __device__ __forceinline__ void done(const Unit&) const {}
    __device__ __forceinline__ int unit_nt(const Unit&, int ntd) const { return ntd; }
};

struct PanelOrder {
    int nM, nN, G, c;
    __host__ __device__ void init(int M, int N, int G_, int c_) { nM = M / BM; nN = N / BM; G = G_; c = c_; }
    __host__ __device__ bool next(int i, Unit& u) const { const int k = i / nN; const long pm = (long)k * G + c; if (pm >= nM) return false; u.pm = (int)pm; u.pn = i - k * nN; u.z = 0; return true; }
    __device__ __forceinline__ void a_ready(const Unit&) const {}
    __device__ __forceinline__ void done(const Unit&) const {}
    __device__ __forceinline__ int unit_nt(const Unit&, int ntd) const { return ntd; }
};
struct PanelOrderN {
    int nM, nN, G, c;
    __host__ __device__ void init(int M, int N, int G_, int c_) { nM = M / BM; nN = N / BM; G = G_; c = c_; }
    __host__ __device__ bool next(int i, Unit& u) const { const int k = i / nM; const long pn = (long)k * G + c; if (pn >= nN) return false; u.pn = (int)pn; u.pm = i - k * nM; u.z = 0; return true; }
    __device__ __forceinline__ void a_ready(const Unit&) const {}
    __device__ __forceinline__ void done(const Unit&) const {}
    __device__ __forceinline__ int unit_nt(const Unit&, int ntd) const { return ntd; }
};
struct BatchOrder {
    int nM, nN, nwg, G, c, tri;
    __host__ __device__ void init(int M, int N, int nz, int G_, int c_, int tri_) { nM = M / BM; nN = N / BM; nwg = nz * nM * nN; G = G_; c = c_; tri = tri_; }
    __host__ __device__ bool next(int i, Unit& u) const { const long L = (long)i * G + c; if (L >= nwg) return false; const int per = nM * nN, l = (int)L; u.z = l / per; const int rem = l % per; u.pm = rem / nN; u.pn = tri ? (rem + i) % nN : rem % nN; return true; }
    __device__ __forceinline__ void a_ready(const Unit&) const {}
    __device__ __forceinline__ void done(const Unit&) const {}
    __device__ __forceinline__ int unit_nt(const Unit& u, int ntd) const { return tri ? 4 * u.pn + 6 : ntd; }
};
typedef float f32x2_c __attribute__((ext_vector_type(2))); typedef _Float16 h16x2_c __attribute__((ext_vector_type(2))); typedef _Float16 h16x8 __attribute__((ext_vector_type(8)));
__device__ __forceinline__ unsigned cvt_pk_bf16(float lo, float hi) { f32x2_c v = {lo, hi}; h16x2_c b = __builtin_convertvector(v, h16x2_c); return __builtin_bit_cast(unsigned, b); }
typedef float f32x2 __attribute__((ext_vector_type(2)));
template <class Epi, class Sched, bool ALIGN_EPI = false, bool SP2 = false>
__device__ __forceinline__ void gemm_phase(PG8_LAS unsigned char* lds, const Gemm g, const Sched& S, const Epi& E) {
    int tid_l = threadIdx.x; asm volatile("" : "+v"(tid_l)); const int tid = tid_l, wid = __builtin_amdgcn_readfirstlane(tid >> 6), lane = tid & 63, wr = wid >> 2, wc = wid & 3, fr = lane & 15, fq = lane >> 4;
    const int K = g.K, ntd = K / BK;
    unsigned voffA[2], voffB[2];
#pragma unroll
    for (int i = 0; i < 2; ++i) { int R, C; stage_rc(tid * 16 + i * 8192, R, C); const int Rb = Epi::PERM ? ((R & ~31) + perm32(R & 31)) : R;
        voffA[i] = (unsigned)(R * g.lda + C) * 2u; voffB[i] = (unsigned)(Rb * g.ldb + C) * 2u; }
    const size_t kstep = (size_t)(BK * 2);
    const size_t hstepA = (size_t)HALF * g.lda * 2, hstepB = (size_t)HALF * g.ldb * 2;
    const size_t tstepA = 2 * hstepA, tstepB = 2 * hstepB;
    const unsigned ldsw = (unsigned)wid * 1024u;
    const int aoff = lds_byte(wr * 64 + fr, fq * 8), boff = lds_byte(wc * 32 + fr, fq * 8);
#define PG8_SA(b, h) (((b) * 2 + (h)) * HTB)
#define PG8_SB(b, h) ((4 + (b) * 2 + (h)) * HTB)
#define PG8_STAGE(bufoff, gbase, voff) do { _Pragma("unroll") for (int _i = 0; _i < 2; ++_i) \
        __builtin_amdgcn_global_load_lds((const unsigned*)((const char*)(gbase) + (voff)[_i]), (PG8_LAS unsigned*)(lds + (bufoff) + ldsw + _i * 8192), 16, 0, 0); } while (0)
#define PG8_LDA(dst, b, h) do { _Pragma("unroll") for (int m = 0; m < 4; ++m) _Pragma("unroll") for (int k = 0; k < 2; ++k) dst[m][k] = *(const PG8_LAS bf16x8*)(lds + PG8_SA(b, h) + aoff + m * 2048 + k * 1024); } while (0)
#define PG8_LDB(dst, b, h) do { _Pragma("unroll") for (int n = 0; n < 2; ++n) _Pragma("unroll") for (int k = 0; k < 2; ++k) dst[n][k] = *(const PG8_LAS bf16x8*)(lds + PG8_SB(b, h) + boff + n * 2048 + k * 1024); } while (0)
#define PG8_MMA(ai, bj, At, Bt) do { __builtin_amdgcn_s_setprio(1); _Pragma("unroll") for (int m = 0; m < 4; ++m) _Pragma("unroll") for (int n = 0; n < 2; ++n) _Pragma("unroll") for (int k = 0; k < 2; ++k) \
        acc[ai][bj][m][n] = __builtin_amdgcn_mfma_f32_16x16x32_f16(__builtin_bit_cast(h16x8, Bt[n][k]), __builtin_bit_cast(h16x8, At[m][k]), acc[ai][bj][m][n], 0, 0, 0); __builtin_amdgcn_s_setprio(0); } while (0)
#define PG8_WAIT_V(n) asm volatile("s_waitcnt vmcnt(" #n ")" ::: "memory")
#define PG8_WAIT_L(n) asm volatile("s_waitcnt lgkmcnt(" #n ")" ::: "memory")
#define PG8_BAR __builtin_amdgcn_s_barrier()
#define PG8_SCHED __builtin_amdgcn_sched_barrier(0)
    Unit cur, nxt; int ui = 0;
    if (!S.next(0, cur)) return;
    int nt = S.unit_nt(cur, ntd);
    f32x4 acc[2][2][4][2];
#pragma unroll
    for (int a = 0; a < 2; ++a)
#pragma unroll
        for (int b = 0; b < 2; ++b)
#pragma unroll
            for (int m = 0; m < 4; ++m)
#pragma unroll
                for (int n = 0; n < 2; ++n) acc[a][b][m][n] = (f32x4){0.f, 0.f, 0.f, 0.f};
    bf16x8 At[4][2], B0[2][2], B1[2][2];
    const char* cA = (const char*)g.A + (size_t)cur.z * g.sAz * 2 + (size_t)cur.pm * tstepA; const char* cB = (const char*)g.Bt + (size_t)cur.z * g.sBz * 2 + (size_t)cur.pn * tstepB;
    S.a_ready(cur);
    if constexpr (SP2) {
        PG8_STAGE(PG8_SB(0, 0), cB, voffB); PG8_STAGE(PG8_SB(0, 1), cB + hstepB, voffB); PG8_STAGE(PG8_SA(0, 0), cA, voffA); PG8_STAGE(PG8_SA(0, 1), cA + hstepA, voffA);
        if (wr == 1) PG8_BAR;
        PG8_WAIT_V(2); PG8_BAR;
        PG8_STAGE(PG8_SB(1, 0), cB + kstep, voffB); PG8_STAGE(PG8_SA(1, 0), cA + kstep, voffA); PG8_STAGE(PG8_SB(1, 1), cB + hstepB + kstep, voffB);
        PG8_WAIT_V(6); PG8_BAR;
    } else {
        PG8_STAGE(PG8_SB(0, 0), cB, voffB); PG8_STAGE(PG8_SA(0, 0), cA, voffA); PG8_STAGE(PG8_SB(0, 1), cB + hstepB, voffB); PG8_STAGE(PG8_SA(0, 1), cA + hstepA, voffA);
        if (wr == 1) PG8_BAR;
        PG8_WAIT_V(4); PG8_BAR;
        PG8_STAGE(PG8_SB(1, 0), cB + kstep, voffB); PG8_STAGE(PG8_SA(1, 0), cA + kstep, voffA); PG8_STAGE(PG8_SB(1, 1), cB + hstepB + kstep, voffB);
        PG8_WAIT_V(6); PG8_BAR;
    }
    for (;;) {
        const bool has_next = S.next(ui + 1, nxt);
        const char* nA = has_next ? (const char*)g.A + (size_t)nxt.z * g.sAz * 2 + (size_t)nxt.pm * tstepA : cA; const char* nB = has_next ? (const char*)g.Bt + (size_t)nxt.z * g.sBz * 2 + (size_t)nxt.pn * tstepB : cB;
        for (int t = 0; t < nt; t += 2) {
            const bool last = (t == nt - 2);
            const char* a1 = cA + (size_t)(t + 1) * kstep;
            const char* a2 = last ? nA : cA + (size_t)(t + 2) * kstep; const char* b2 = last ? nB : cB + (size_t)(t + 2) * kstep;
            const char* a3 = a2 + kstep; const char* b3 = b2 + kstep;
            if (last && has_next) S.a_ready(nxt);
            if constexpr (SP2) {
            PG8_LDB(B0, 0, 0); PG8_LDB(B1, 0, 1); PG8_SCHED; PG8_LDA(At, 0, 0); PG8_STAGE(PG8_SA(1, 1), a1 + hstepA, voffA);
            PG8_WAIT_V(8); PG8_WAIT_L(0); PG8_BAR; PG8_MMA(0, 0, At, B0); PG8_MMA(0, 1, At, B1); PG8_BAR; PG8_SCHED;
            PG8_LDA(At, 0, 1); PG8_STAGE(PG8_SB(0, 0), b2, voffB); PG8_STAGE(PG8_SB(0, 1), b2 + hstepB, voffB); PG8_STAGE(PG8_SA(0, 0), a2, voffA);
            PG8_WAIT_V(8); PG8_WAIT_L(0); PG8_BAR; PG8_MMA(1, 0, At, B0); PG8_MMA(1, 1, At, B1); PG8_BAR; PG8_SCHED;
            PG8_LDB(B0, 1, 0); PG8_LDB(B1, 1, 1); PG8_SCHED; PG8_LDA(At, 1, 0); PG8_STAGE(PG8_SA(0, 1), a2 + hstepA, voffA);
            PG8_WAIT_V(8); PG8_WAIT_L(0); PG8_BAR; PG8_MMA(0, 0, At, B0); PG8_MMA(0, 1, At, B1); PG8_BAR; PG8_SCHED;
            PG8_LDA(At, 1, 1); PG8_STAGE(PG8_SB(1, 0), b3, voffB); PG8_STAGE(PG8_SB(1, 1), b3 + hstepB, voffB); PG8_STAGE(PG8_SA(1, 0), a3, voffA);
            PG8_WAIT_V(8); PG8_WAIT_L(0); PG8_BAR; PG8_MMA(1, 0, At, B0); PG8_MMA(1, 1, At, B1); PG8_BAR; PG8_SCHED;
            } else {
            PG8_LDB(B0, 0, 0); PG8_SCHED; PG8_LDA(At, 0, 0); PG8_STAGE(PG8_SA(1, 1), a1 + hstepA, voffA);
            PG8_WAIT_L(8); PG8_BAR; PG8_WAIT_L(0); PG8_MMA(0, 0, At, B0); PG8_BAR; PG8_SCHED;
            PG8_LDB(B1, 0, 1); PG8_STAGE(PG8_SB(0, 0), b2, voffB);
            PG8_BAR; PG8_WAIT_L(0); PG8_MMA(0, 1, At, B1); PG8_BAR;
            PG8_LDA(At, 0, 1); PG8_STAGE(PG8_SA(0, 0), a2, voffA);
            PG8_BAR; PG8_WAIT_L(0); PG8_MMA(1, 0, At, B0); PG8_BAR; PG8_SCHED;
            PG8_STAGE(PG8_SB(0, 1), b2 + hstepB, voffB);
            PG8_WAIT_V(6); PG8_BAR; PG8_MMA(1, 1, At, B1); PG8_BAR;
            PG8_LDB(B0, 1, 0); PG8_SCHED; PG8_LDA(At, 1, 0); PG8_STAGE(PG8_SA(0, 1), a2 + hstepA, voffA);
            PG8_WAIT_L(8); PG8_BAR; PG8_WAIT_L(0); PG8_MMA(0, 0, At, B0); PG8_BAR; PG8_SCHED;
            PG8_LDB(B1, 1, 1); PG8_STAGE(PG8_SB(1, 0), b3, voffB);
            PG8_BAR; PG8_WAIT_L(0); PG8_MMA(0, 1, At, B1); PG8_BAR;
            PG8_LDA(At, 1, 1); PG8_STAGE(PG8_SA(1, 0), a3, voffA);
            PG8_BAR; PG8_WAIT_L(0); PG8_MMA(1, 0, At, B0); PG8_BAR; PG8_SCHED;
            PG8_STAGE(PG8_SB(1, 1), b3 + hstepB, voffB);
            PG8_WAIT_V(6); PG8_BAR; PG8_MMA(1, 1, At, B1); PG8_BAR;
            }
        }
        if constexpr (ALIGN_EPI) { if (wr == 0) PG8_BAR; }
        if constexpr (!Epi::AFTER_DRAIN) { E(acc, cur, wr, wc, fr, fq); S.done(cur); }
        if (!has_next) break;
#pragma unroll
        for (int a = 0; a < 2; ++a)
#pragma unroll
            for (int b = 0; b < 2; ++b)
#pragma unroll
                for (int m = 0; m < 4; ++m)
#pragma unroll
                    for (int n = 0; n < 2; ++n) acc[a][b][m][n] = (f32x4){0.f, 0.f, 0.f, 0.f};
        cur = nxt; cA = nA; cB = nB; ++ui; nt = S.unit_nt(cur, ntd);
        if constexpr (ALIGN_EPI) { if (wr == 1) PG8_BAR; }
    }
    PG8_WAIT_V(0);
    if constexpr (!ALIGN_EPI) { if (wr == 0) PG8_BAR; }
    PG8_BAR;
    if constexpr (Epi::AFTER_DRAIN) { E.fused(acc, cur, wr, wc, fr, fq, lds, wid, lane); S.done(cur); }
#undef PG8_SA
#undef PG8_SB
#undef PG8_STAGE
#undef PG8_LDA
#undef PG8_LDB
#undef PG8_MMA
#undef PG8_WAIT_V
#undef PG8_WAIT_L
#undef PG8_BAR
#undef PG8_SCHED
}
}
typedef unsigned short bf16_t;
typedef float f32x4 __attribute__((ext_vector_type(4)));
typedef unsigned u32x4 __attribute__((ext_vector_type(4)));
typedef unsigned u32x2 __attribute__((ext_vector_type(2)));
constexpr int DM = 1024, NB = 16, SEQ = 4096, MTOK = NB * SEQ, DFF = 2816, NHEAD = 16, HDIM = 64;
constexpr int SG = 64, SC = 16, SN = 64;
constexpr float NORM_EPS = 1e-6f;
constexpr int UA_LD = 1152;
constexpr size_t UA_G = (size_t)1024 * UA_LD;
constexpr size_t MiB = 1u << 20;
constexpr size_t WS_RS = 1 * MiB;
constexpr size_t WS_XS1 = 158 * MiB;
constexpr int CW_PCNT = 16384;
constexpr size_t WS_W = 2 * MiB;
constexpr size_t W_GU = (size_t)2 * DFF * DM;
constexpr size_t W_DN = (size_t)DM * DFF;
constexpr size_t W_FFN = W_GU + W_DN;
constexpr size_t W_SQ = (size_t)DM * DM;
constexpr size_t WO_FFN = 0, WO_SSM = 8 * W_FFN, WO_QKV = WO_SSM + 6 * W_SQ, WO_Q1 = WO_QKV + 3 * W_SQ, WO_O = WO_Q1 + W_SQ, WO_END = WO_O + 2 * W_SQ;
static_assert(WS_W + WO_END * 2 <= 160 * MiB, "weights fit");
constexpr size_t WS_XB = 160 * MiB;
constexpr size_t WS_HID = 288 * MiB;
constexpr size_t WS_Y = WS_HID, WS_Z = WS_HID + 128 * MiB, WS_O = WS_HID + 128 * MiB;
constexpr size_t WS_K = 640 * MiB, WS_V = 768 * MiB;
constexpr size_t WS_UA = 832 * MiB;
constexpr size_t WS_SP = 976 * MiB, WS_TAB = 980 * MiB, WS_END = 996 * MiB;
constexpr int SP_NG = 0, SP_LRE = 24576, SP_LIM = SP_LRE + 8192, SP_LDT = SP_LIM + 8192, SP_BRE = SP_LDT + 128, SP_BIM = SP_BRE + 131072, SP_CRE = SP_BIM + 131072, SP_CIM = SP_CRE + 131072, SP_SD = SP_CIM + 131072, SP_AR = SP_SD + 2048, SP_AI = SP_AR + 8192, SP_BBR = SP_AI + 8192, SP_BBI = SP_BBR + 131072, SP_END = SP_BBI + 131072;
static_assert((size_t)SP_END * 4 <= 4 * MiB, "SP fits");
constexpr size_t WS_KQT = WS_K, WS_PT = WS_K + 144 * MiB, WS_SLOC = WS_K + 160 * MiB;
constexpr size_t WS_PW = WS_TAB, WS_KD = WS_TAB + 5 * MiB;
static_assert((size_t)2 * 64 * 65 * 64 * 8 <= 5 * MiB && WS_SLOC + (size_t)64 * 1024 * 128 * 4 <= WS_UA && WS_UA + UA_G * 64 * 2 <= WS_SP, "tables fit");
static_assert(WS_HID + (size_t)MTOK * DFF * 2 <= WS_K, "hid fits");

typedef _Float16 h16x2 __attribute__((ext_vector_type(2)));
__device__ __forceinline__ float bf_lo(unsigned w) { return (float)__builtin_bit_cast(h16x2, w)[0]; }
__device__ __forceinline__ float bf_hi(unsigned w) { return (float)__builtin_bit_cast(h16x2, w)[1]; }
__device__ __forceinline__ float wave_sum(float v) {
#pragma unroll
    for (int o = 1; o < 64; o <<= 1) v += __shfl_xor(v, o);
    return v;
}
__device__ __forceinline__ float sigmoidf_(float v) { return __builtin_amdgcn_rcpf(1.0f + __expf(-v)); }
__device__ __forceinline__ float gelu_tanh(float x) { const float v = 1.5957691216057308f * (x + 0.044715f * x * x * x); return x * sigmoidf_(v); }
using pg8::Unit; using pg8::cvt_pk_bf16;
__device__ __forceinline__ float rs4(const float* ssq, int row) { const f32x4 q = *(const f32x4*)(ssq + (size_t)row * 4); return rsqrtf(((q[0] + q[1]) + (q[2] + q[3])) * (1.0f / DM) + NORM_EPS); }

#define LAS __attribute__((address_space(3)))
template <class Op> struct EpiGen {
    static constexpr bool PERM = true, AFTER_DRAIN = false;
    Op op; LAS float* rsl; mutable int cpm;
    __device__ __forceinline__ void operator()(const f32x4 (&acc)[2][2][4][2], const Unit& u, int wr, int wc, int fr, int fq) const {
        const int row0 = u.pm * 256 + wr * 64 + fr, cin = wc * 32 + 8 * fq;
        if constexpr (Op::ROW_RS) {
            if (u.pm != cpm) {
                const int t = (wr * 4 + wc) * 64 + fq * 16 + fr;
                __builtin_amdgcn_s_barrier();
                if (t < 256) rsl[t] = rs4(op.rs, u.pm * 256 + t);
                asm volatile("s_waitcnt lgkmcnt(0)" ::: "memory"); __builtin_amdgcn_s_barrier(); asm volatile("" ::: "memory");
                cpm = u.pm;
            }
        }
        if constexpr (Op::HAS_UNIT) op.unit_init(u, cin);
#pragma unroll
        for (int ai = 0; ai < 2; ++ai) {
            float rsc[4];
#pragma unroll
            for (int m = 0; m < 4; ++m) { if constexpr (Op::ROW_RS) rsc[m] = rsl[wr * 64 + fr + ai * 128 + m * 16] * op.factor(u); else rsc[m] = op.scale(u, row0 + ai * 128 + m * 16); }
            if constexpr (Op::HAS_PRE) {
                u32x4 pa[4], pb[4];
#pragma unroll
                for (int m = 0; m < 4; ++m) op.pre(u, row0 + ai * 128 + m * 16, cin, pa[m], pb[m]);
#pragma unroll
                for (int m = 0; m < 4; ++m) { op.run(u, row0 + ai * 128 + m * 16, cin, rsc[m], acc[ai][0][m][0], acc[ai][0][m][1], acc[ai][1][m][0], acc[ai][1][m][1], pa[m], pb[m]); asm volatile("" ::: "memory"); }
            } else {
#pragma unroll
                for (int m = 0; m < 4; ++m) { op(u, row0 + ai * 128 + m * 16, cin, rsc[m], acc[ai][0][m][0], acc[ai][0][m][1], acc[ai][1][m][0], acc[ai][1][m][1]); asm volatile("" ::: "memory"); }
            }
        }
    }
};
#ifndef ST_WT
#define ST_WT 0
#endif
#ifndef ST_NT
#define ST_NT 0
#endif
__device__ __forceinline__ void st16(void* p, u32x4 v) {
#if ST_WT
    asm volatile("global_store_dwordx4 %0, %1, off sc1\n\ts_nop 1" :: "v"(p), "v"(v) : "memory");
#elif ST_NT
    __builtin_nontemporal_store(v, (u32x4*)p);
#else
    *(u32x4*)p = v;
#endif
}
__device__ __forceinline__ u32x4 pack8(f32x4 a, f32x4 b) { u32x4 w; w.x = cvt_pk_bf16(a[0], a[1]); w.y = cvt_pk_bf16(a[2], a[3]); w.z = cvt_pk_bf16(b[0], b[1]); w.w = cvt_pk_bf16(b[2], b[3]); return w; }
struct OpSwiglu { const float* rs; bf16_t* H;
    static constexpr bool ROW_RS = true, HAS_PRE = false, HAS_UNIT = false;
    __device__ __forceinline__ float factor(const Unit& u) const { return 1.0f; }
    __device__ __forceinline__ float scale(const Unit&, int row) const { return rs4(rs, row); }
    __device__ __forceinline__ void operator()(const Unit& u, int row, int cin, float r, f32x4 g0, f32x4 g1, f32x4 u0, f32x4 u1) const {
        f32x4 h0, h1; const float r2 = r * r, rn = r * -1.4426950408889634f;
#pragma unroll
        for (int i = 0; i < 4; ++i) {
            const float ea = __builtin_amdgcn_exp2f(g0[i] * rn), eb = __builtin_amdgcn_exp2f(g1[i] * rn);
            h0[i] = (g0[i] * u0[i]) * (r2 * __builtin_amdgcn_rcpf(1.0f + ea)); h1[i] = (g1[i] * u1[i]) * (r2 * __builtin_amdgcn_rcpf(1.0f + eb)); }
        st16((H + (size_t)row * DFF + u.pn * 128 + cin), pack8(h0, h1));
    } };
struct OpStore { bf16_t* O; int ldc; const float* rs; float sc;
    static constexpr bool ROW_RS = false, HAS_PRE = false, HAS_UNIT = false;
    __device__ __forceinline__ float scale(const Unit&, int row) const { return rs ? rs4(rs, row) * sc : sc; }
    __device__ __forceinline__ void operator()(const Unit& u, int row, int cin, float r, f32x4 a0, f32x4 a1, f32x4 b0, f32x4 b1) const {
        bf16_t* p = O + (size_t)row * ldc + u.pn * 256 + cin;
        st16(p, pack8(a0 * r, a1 * r)); st16((p + 128), pack8(b0 * r, b1 * r));
    } };
struct OpQKV { bf16_t* Q; unsigned char* ws; const float* rs;
    static constexpr bool ROW_RS = true, HAS_PRE = false, HAS_UNIT = false;
    __device__ __forceinline__ float factor(const Unit& u) const { return ((u.pn >> 2) == 0 ? 0.18033688011112042f : 1.0f); }
    __device__ __forceinline__ float scale(const Unit& u, int row) const { return rs4(rs, row) * ((u.pn >> 2) == 0 ? 0.18033688011112042f : 1.0f); }
    __device__ __forceinline__ void operator()(const Unit& u, int row, int cin, float r, f32x4 a0, f32x4 a1, f32x4 b0, f32x4 b1) const {
        const int t = u.pn >> 2; bf16_t* base = (t == 0) ? Q : (bf16_t*)(ws + WS_K);
        bf16_t* p = base + (size_t)row * DM + (u.pn & 3) * 256 + cin;
        st16(p, pack8(a0 * r, a1 * r)); st16((p + 128), pack8(b0 * r, b1 * r));
    } };
struct OpUA { bf16_t* UA; const float* rs;
    static constexpr bool ROW_RS = true, HAS_PRE = false, HAS_UNIT = false;
    __device__ __forceinline__ float factor(const Unit& u) const { return 1.0f; }
    __device__ __forceinline__ float scale(const Unit&, int row) const { return rs4(rs, row); }
    __device__ __forceinline__ void operator()(const Unit& u, int row, int cin, float r, f32x4 a0, f32x4 a1, f32x4 b0, f32x4 b1) const {
        const int col = u.pn * 256 + cin; const size_t ro = (size_t)(row >> 6) * UA_LD + 128 + (row & 63) * 16 + (col & 15);
        st16((UA + (size_t)(col >> 4) * UA_G + ro), pack8(a0 * r, a1 * r));
        st16((UA + (size_t)((col + 128) >> 4) * UA_G + ro), pack8(b0 * r, b1 * r));
    } };
struct OpGLU { const bf16_t* Y; bf16_t* Z;
    static constexpr bool ROW_RS = false, HAS_PRE = true, HAS_UNIT = false;
    __device__ __forceinline__ float scale(const Unit&, int) const { return 1.0f; }
    __device__ __forceinline__ void pre(const Unit& u, int row, int cin, u32x4& pa, u32x4& pb) const { const size_t off = (size_t)row * DM + u.pn * 256 + cin; pa = *(const u32x4*)(Y + off); pb = *(const u32x4*)(Y + off + 128); }
    __device__ __forceinline__ void run(const Unit& u, int row, int cin, float, f32x4 a0, f32x4 a1, f32x4 b0, f32x4 b1, u32x4 pa, u32x4 pb) const {
        const size_t off = (size_t)row * DM + u.pn * 256 + cin;
#pragma unroll
        for (int hb = 0; hb < 2; ++hb) { const u32x4 y = hb ? pb : pa; const f32x4 c0 = hb ? b0 : a0, c1 = hb ? b1 : a1; f32x4 z0, z1;
            z0[0] = bf_lo(y.x) * sigmoidf_(c0[0]); z0[1] = bf_hi(y.x) * sigmoidf_(c0[1]); z0[2] = bf_lo(y.y) * sigmoidf_(c0[2]); z0[3] = bf_hi(y.y) * sigmoidf_(c0[3]);
            z1[0] = bf_lo(y.z) * sigmoidf_(c1[0]); z1[1] = bf_hi(y.z) * sigmoidf_(c1[1]); z1[2] = bf_lo(y.w) * sigmoidf_(c1[2]); z1[3] = bf_hi(y.w) * sigmoidf_(c1[3]);
            st16((Z + off + hb * 128), pack8(z0, z1)); }
    } };
struct OpVT { bf16_t* VT; const float* rs; mutable f32x4 r0, r1, r2, r3;
    static constexpr bool ROW_RS = false, HAS_PRE = false, HAS_UNIT = true;
    __device__ __forceinline__ float scale(const Unit&, int) const { return 1.0f; }
    __device__ __forceinline__ void unit_init(const Unit& u, int cin) const { const int col = u.pn * 256 + cin;
#pragma unroll
        for (int e = 0; e < 4; ++e) { r0[e] = rs4(rs, col + e); r1[e] = rs4(rs, col + 4 + e); r2[e] = rs4(rs, col + 128 + e); r3[e] = rs4(rs, col + 132 + e); } }
    __device__ __forceinline__ void operator()(const Unit& u, int row, int cin, float, f32x4 a0, f32x4 a1, f32x4 b0, f32x4 b1) const {
        const int col = u.pn * 256 + cin; bf16_t* p = VT + (size_t)row * MTOK + col;
        st16(p, pack8(a0 * r0, a1 * r1)); st16((p + 128), pack8(b0 * r2, b1 * r3));
    } };
struct OpSloc { float* SL;
    static constexpr bool ROW_RS = false, HAS_PRE = false, HAS_UNIT = false;
    __device__ __forceinline__ float scale(const Unit&, int) const { return 1.0f; }
    __device__ __forceinline__ void operator()(const Unit& u, int row, int cin, float, f32x4 a0, f32x4 a1, f32x4 b0, f32x4 b1) const {
        float* p = SL + ((size_t)u.z * 1024 + row) * 128 + cin; *(f32x4*)p = a0; *(f32x4*)(p + 4) = a1; (void)b0; (void)b1;
    } };
struct OpY { const bf16_t* UA; bf16_t* Y; const float* dsk; mutable f32x4 da0, da1, db0, db1;
    static constexpr bool ROW_RS = false, HAS_PRE = true, HAS_UNIT = true;
    __device__ __forceinline__ float scale(const Unit&, int) const { return 1.0f; }
    __device__ __forceinline__ void unit_init(const Unit& u, int cin) const { const int c0 = cin & 15; const float* d = dsk + u.z * 16 + c0; da0 = *(const f32x4*)d; da1 = *(const f32x4*)(d + 4); db0 = da0; db1 = da1; }
    __device__ __forceinline__ void pre(const Unit& u, int row, int cin, u32x4& pa, u32x4& pb) const { const bf16_t* p = UA + (size_t)u.z * UA_G + (size_t)row * UA_LD + 128 + u.pn * 256 + cin; pa = *(const u32x4*)p; pb = *(const u32x4*)(p + 128); }
    __device__ __forceinline__ void run(const Unit& u, int row, int cin, float, f32x4 a0, f32x4 a1, f32x4 b0, f32x4 b1, u32x4 pa, u32x4 pb) const {
#pragma unroll
        for (int hb = 0; hb < 2; ++hb) { const int n = u.pn * 256 + hb * 128 + cin, l = n >> 4, c0 = n & 15; const f32x4 v0 = hb ? b0 : a0, v1 = hb ? b1 : a1; const u32x4 uu = hb ? pb : pa;
            const f32x4 d0 = hb ? db0 : da0, d1 = hb ? db1 : da1; f32x4 y0, y1;
            y0[0] = gelu_tanh(v0[0] + d0[0] * bf_lo(uu.x)); y0[1] = gelu_tanh(v0[1] + d0[1] * bf_hi(uu.x)); y0[2] = gelu_tanh(v0[2] + d0[2] * bf_lo(uu.y)); y0[3] = gelu_tanh(v0[3] + d0[3] * bf_hi(uu.y));
            y1[0] = gelu_tanh(v1[0] + d1[0] * bf_lo(uu.z)); y1[1] = gelu_tanh(v1[1] + d1[1] * bf_hi(uu.z)); y1[2] = gelu_tanh(v1[2] + d1[2] * bf_lo(uu.w)); y1[3] = gelu_tanh(v1[3] + d1[3] * bf_hi(uu.w));
            st16((Y + ((size_t)row * 64 + l) * DM + u.z * 16 + c0), pack8(y0, y1)); }
    } };
struct EpiFused {
    static constexpr bool PERM = true, AFTER_DRAIN = false;
    bf16_t* x16; const float* g; float alpha; float* outf; float* xs1; float* ssq2; unsigned* cnt; unsigned want; LAS unsigned char* xl;
    mutable int cpn;
    __device__ __forceinline__ void operator()(const f32x4 (&acc)[2][2][4][2], const Unit& u, int wr, int wc, int fr, int fq) const {
        LAS float* P = (LAS float*)xl; LAS float* S = P + 1024;
        const int wid = wr * 4 + wc, lane = fq * 16 + fr, prow0 = u.pm * 256;
        const int col0 = u.pn * 256 + wc * 32 + 8 * fq;
        u32x4 xpa[4], xpb[4];
#pragma unroll
        for (int i = 0; i < 4; ++i) { const size_t off = (size_t)(prow0 + wr * 64 + i * 16 + fr) * DM + col0; xpa[i] = *(const u32x4*)(x16 + off); xpb[i] = *(const u32x4*)(x16 + off + 128); }
#pragma unroll
        for (int ai = 0; ai < 2; ++ai)
#pragma unroll
            for (int m = 0; m < 4; ++m) { float sq = 0.f;
#pragma unroll
                for (int bj = 0; bj < 2; ++bj)
#pragma unroll
                    for (int n = 0; n < 2; ++n) { const f32x4 v = acc[ai][bj][m][n]; sq += (v[0] * v[0] + v[1] * v[1]) + (v[2] * v[2] + v[3] * v[3]); }
                sq += __shfl_xor(sq, 16); sq += __shfl_xor(sq, 32);
                if (fq == 0) P[(ai * 128 + wr * 64 + m * 16 + fr) * 4 + wc] = sq; }
        asm volatile("s_waitcnt lgkmcnt(0)" ::: "memory"); __builtin_amdgcn_s_barrier(); asm volatile("" ::: "memory");
        const int row = wid * 32 + (lane & 31);
        unsigned long long* sl64 = (unsigned long long*)xs1 + (size_t)(prow0 + row) * 4;
        if (lane < 32) { const float t = (P[row * 4 + 0] + P[row * 4 + 1]) + (P[row * 4 + 2] + P[row * 4 + 3]);
            __hip_atomic_store(sl64 + u.pn, ((unsigned long long)want << 32) | (unsigned long long)__float_as_uint(t), __ATOMIC_RELAXED, __HIP_MEMORY_SCOPE_AGENT); }
        { unsigned sp = 0u; unsigned long long v0, v1, v2, v3;
            for (;;) {
                v0 = __hip_atomic_load(sl64 + 0, __ATOMIC_RELAXED, __HIP_MEMORY_SCOPE_AGENT); v1 = __hip_atomic_load(sl64 + 1, __ATOMIC_RELAXED, __HIP_MEMORY_SCOPE_AGENT);
                v2 = __hip_atomic_load(sl64 + 2, __ATOMIC_RELAXED, __HIP_MEMORY_SCOPE_AGENT); v3 = __hip_atomic_load(sl64 + 3, __ATOMIC_RELAXED, __HIP_MEMORY_SCOPE_AGENT);
                const bool ok = ((unsigned)(v0 >> 32) == want) && ((unsigned)(v1 >> 32) == want) && ((unsigned)(v2 >> 32) == want) && ((unsigned)(v3 >> 32) == want);
                if (__all(ok) || ++sp > (1u << 20)) break;
                __builtin_amdgcn_s_sleep(1);
            }
            if (lane < 32) { const float t0 = __uint_as_float((unsigned)v0), t1 = __uint_as_float((unsigned)v1), t2 = __uint_as_float((unsigned)v2), t3 = __uint_as_float((unsigned)v3);
                S[row] = alpha * rsqrtf(((t0 + t1) + (t2 + t3)) * (1.0f / DM) + NORM_EPS); } }
        asm volatile("s_waitcnt vmcnt(0) lgkmcnt(0)" ::: "memory"); __builtin_amdgcn_s_barrier(); asm volatile("" ::: "memory");
        LAS float* gl = (LAS float*)(xl + 5632);
        if (u.pn != cpn) { const int t_ = wid * 64 + lane; __builtin_amdgcn_s_barrier(); if (t_ < 256) gl[t_] = g[u.pn * 256 + t_]; asm volatile("s_waitcnt vmcnt(0) lgkmcnt(0)" ::: "memory"); __builtin_amdgcn_s_barrier(); asm volatile("" ::: "memory"); cpn = u.pn; }
        const f32x4 ga0 = *(const LAS f32x4*)(gl + wc * 32 + 8 * fq), ga1 = *(const LAS f32x4*)(gl + wc * 32 + 8 * fq + 4), gb0 = *(const LAS f32x4*)(gl + 128 + wc * 32 + 8 * fq), gb1 = *(const LAS f32x4*)(gl + 128 + wc * 32 + 8 * fq + 4);
#pragma unroll
        for (int ai = 0; ai < 2; ++ai) {
            if (ai == 1) {
#pragma unroll
                for (int i = 0; i < 4; ++i) { const size_t off = (size_t)(prow0 + 128 + wr * 64 + i * 16 + fr) * DM + col0; xpa[i] = *(const u32x4*)(x16 + off); xpb[i] = *(const u32x4*)(x16 + off + 128); }
            }
#pragma unroll
            for (int m = 0; m < 4; ++m) { const int rl = ai * 128 + wr * 64 + m * 16 + fr; const float r = S[rl]; const size_t off = (size_t)(prow0 + rl) * DM + col0;
                const u32x4 xa = xpa[m], xb = xpb[m];
                f32x4 a0 = {bf_lo(xa.x), bf_hi(xa.x), bf_lo(xa.y), bf_hi(xa.y)}, a1 = {bf_lo(xa.z), bf_hi(xa.z), bf_lo(xa.w), bf_hi(xa.w)}, b0 = {bf_lo(xb.x), bf_hi(xb.x), bf_lo(xb.y), bf_hi(xb.y)}, b1 = {bf_lo(xb.z), bf_hi(xb.z), bf_lo(xb.w), bf_hi(xb.w)};
                a0 += acc[ai][0][m][0] * r * ga0; a1 += acc[ai][0][m][1] * r * ga1; b0 += acc[ai][1][m][0] * r * gb0; b1 += acc[ai][1][m][1] * r * gb1;
                float sq = ((a0[0] * a0[0] + a0[1] * a0[1]) + (a0[2] * a0[2] + a0[3] * a0[3])) + ((a1[0] * a1[0] + a1[1] * a1[1]) + (a1[2] * a1[2] + a1[3] * a1[3]));
                sq += ((b0[0] * b0[0] + b0[1] * b0[1]) + (b0[2] * b0[2] + b0[3] * b0[3])) + ((b1[0] * b1[0] + b1[1] * b1[1]) + (b1[2] * b1[2] + b1[3] * b1[3]));
                if (outf) { float* o = outf + off; *(f32x4*)o = a0; *(f32x4*)(o + 4) = a1; *(f32x4*)(o + 128) = b0; *(f32x4*)(o + 132) = b1; }
                else { st16(x16 + off, pack8(a0, a1)); st16(x16 + off + 128, pack8(b0, b1)); }
                sq += __shfl_xor(sq, 16); sq += __shfl_xor(sq, 32);
                if (fq == 0) P[rl * 4 + wc] = sq;
                asm volatile("" ::: "memory"); }
        }
        asm volatile("s_waitcnt lgkmcnt(0)" ::: "memory"); __builtin_amdgcn_s_barrier(); asm volatile("" ::: "memory");
        if (lane < 32) ssq2[(size_t)(prow0 + row) * 4 + u.pn] = (P[row * 4 + 0] + P[row * 4 + 1]) + (P[row * 4 + 2] + P[row * 4 + 3]);
        asm volatile("s_waitcnt lgkmcnt(0)" ::: "memory"); __builtin_amdgcn_s_barrier(); asm volatile("" ::: "memory");
    }
};
constexpr int NWAVES = 8, LDS_BYTES = 147456, RING_BYTES = 131072;
struct Args { const float* in[21]; float* out; unsigned char* ws; int ph_lo, ph_hi; };
enum { I_X = 0, I_NG, I_WG, I_WU, I_WD, I_SWIN, I_LRE, I_LIM, I_LDT, I_BRE, I_BIM, I_CRE, I_CIM, I_SD, I_SWGLU, I_SWOUT, I_KVG, I_WK, I_WV, I_WQ, I_WO };

__device__ __forceinline__ unsigned pk2(float lo, float hi) { return cvt_pk_bf16(lo, hi); }
#define TR_LOAD(V, G, ITEM) do { const int kb_ = (ITEM) / nblk_, nb_ = (ITEM) % nblk_; \
    _Pragma("unroll") for (int i = 0; i < 8; ++i) { const int kk = 8 * i + (lane >> 3); V[i] = *(const f32x4*)(W + (size_t)(64 * kb_ + kk) * N + 32 * nb_ + (lane & 7) * 4); G[i] = gain ? gain[64 * kb_ + kk] : 1.0f; } } while (0)
#define TR_STORE(V, G, ITEM) do { const int kb_ = (ITEM) / nblk_, nb_ = (ITEM) % nblk_, k0 = 64 * kb_, n0 = 32 * nb_; \
    _Pragma("unroll") for (int i = 0; i < 8; ++i) { const int kk = 8 * i + (lane >> 3), nn = (lane & 7) * 4; const f32x4 v = V[i] * G[i]; \
        scr[kk * 33 + nn] = v[0]; scr[kk * 33 + nn + 1] = v[1]; scr[kk * 33 + nn + 2] = v[2]; scr[kk * 33 + nn + 3] = v[3]; } \
    asm volatile("s_waitcnt lgkmcnt(0)" ::: "memory"); \
    const int c = lane & 7; const int r0 = mode == 0 ? row_off + n0 : (256 * (n0 >> 7) + (n0 & 127) + (mode == 2 ? 128 : 0)); \
    _Pragma("unroll") for (int j = 0; j < 4; ++j) { const int n = (lane >> 3) + 8 * j; const LAS float* s = scr + (8 * c) * 33 + n; \
        u32x4 o; o.x = pk2(s[0 * 33], s[1 * 33]); o.y = pk2(s[2 * 33], s[3 * 33]); o.z = pk2(s[4 * 33], s[5 * 33]); o.w = pk2(s[6 * 33], s[7 * 33]); \
        *(u32x4*)(WT + (size_t)(r0 + n) * K + k0 + 8 * c) = o; } \
    asm volatile("s_waitcnt lgkmcnt(0)" ::: "memory"); } while (0)
__device__ __forceinline__ int conv_matrix(const float* W, int K, int N, const float* gain, int mode, bf16_t* WT, int row_off, LAS float* scr, int cstart, int NGW, int lane) {
    const int n_items = (K / 64) * (N / 32), nblk_ = N / 32; int it = cstart;
    f32x4 va[8], vb[8]; float ga[8], gb[8];
    if (it < n_items) TR_LOAD(va, ga, it);
    while (it < n_items) {
        if (it + NGW < n_items) TR_LOAD(vb, gb, it + NGW);
        TR_STORE(va, ga, it); it += NGW;
        if (it >= n_items) break;
        if (it + NGW < n_items) TR_LOAD(va, ga, it + NGW);
        TR_STORE(vb, gb, it); it += NGW;
    }
    return it - n_items;
}
#undef TR_LOAD
#undef TR_STORE
#define CONV(Wp, K_, N_, gain_, mode_, dst_, roff_) cstart = conv_matrix((Wp), (K_), (N_), (gain_), (mode_), (dst_), (roff_), scr, cstart, NGW, lane)

template <int MODE, int RR> __device__ __forceinline__ void row_update(const float* xin, bf16_t* x16, const bf16_t* T, float* rs, const float* g, float alpha, float* outf, int gw, int NGW, int lane) {
    f32x4 gv[4];
    if (MODE == 1) {
#pragma unroll
        for (int h = 0; h < 2; ++h) { gv[2 * h] = *(const f32x4*)(g + h * 512 + lane * 8); gv[2 * h + 1] = *(const f32x4*)(g + h * 512 + lane * 8 + 4); }
    }
    const int nblk_ = NGW / NWAVES, blk_ = gw / NWAVES; const bool g256_ = (nblk_ == 256);
    for (int it = 0; it < (MTOK / 256 + nblk_ - 1) / nblk_ * (32 / RR); ++it) {
        const int k_ = it / (32 / RR); const int pmi = g256_ ? ((blk_ & 7) * 32 + (blk_ >> 3)) : (blk_ + k_ * nblk_); if (pmi >= MTOK / 256) break;
        const int base = pmi * 256 + (gw % NWAVES) * 32 + (it % (32 / RR)) * RR;
        f32x4 xv[RR][4]; u32x4 tw[RR][2]; float red[RR];
#pragma unroll
        for (int rr = 0; rr < RR; ++rr) { const bf16_t* br = x16 + (size_t)(base + rr) * DM;
#pragma unroll
            for (int h = 0; h < 2; ++h) {
                if (MODE == 0) { const float* xr = xin + (size_t)(base + rr) * DM; xv[rr][2 * h] = *(const f32x4*)(xr + h * 512 + lane * 8); xv[rr][2 * h + 1] = *(const f32x4*)(xr + h * 512 + lane * 8 + 4); }
                else { const u32x4 xw = *(const u32x4*)(br + h * 512 + lane * 8); tw[rr][h] = *(const u32x4*)(T + (size_t)(base + rr) * DM + h * 512 + lane * 8);
                    xv[rr][2 * h] = (f32x4){bf_lo(xw.x), bf_hi(xw.x), bf_lo(xw.y), bf_hi(xw.y)}; xv[rr][2 * h + 1] = (f32x4){bf_lo(xw.z), bf_hi(xw.z), bf_lo(xw.w), bf_hi(xw.w)}; } } }
        if (MODE == 1) {
            float tv[RR][16];
#pragma unroll
            for (int rr = 0; rr < RR; ++rr) { float ss = 0.f;
#pragma unroll
                for (int h = 0; h < 2; ++h) { const u32x4 t = tw[rr][h];
                    tv[rr][8 * h + 0] = bf_lo(t.x); tv[rr][8 * h + 1] = bf_hi(t.x); tv[rr][8 * h + 2] = bf_lo(t.y); tv[rr][8 * h + 3] = bf_hi(t.y); tv[rr][8 * h + 4] = bf_lo(t.z); tv[rr][8 * h + 5] = bf_hi(t.z); tv[rr][8 * h + 6] = bf_lo(t.w); tv[rr][8 * h + 7] = bf_hi(t.w); }
#pragma unroll
                for (int i = 0; i < 16; ++i) ss += tv[rr][i] * tv[rr][i];
                red[rr] = ss; }
#pragma unroll
            for (int o = 1; o < 64; o <<= 1) {
#pragma unroll
                for (int rr = 0; rr < RR; ++rr) red[rr] += __shfl_xor(red[rr], o); }
#pragma unroll
            for (int rr = 0; rr < RR; ++rr) { const float r = alpha * rsqrtf(red[rr] * (1.0f / DM) + NORM_EPS);
#pragma unroll
                for (int h = 0; h < 2; ++h)
#pragma unroll
                    for (int i = 0; i < 4; ++i) { xv[rr][2 * h][i] += tv[rr][8 * h + i] * r * gv[2 * h][i]; xv[rr][2 * h + 1][i] += tv[rr][8 * h + 4 + i] * r * gv[2 * h + 1][i]; } }
        }
        if (MODE == 1 && outf != nullptr) {
#pragma unroll
            for (int rr = 0; rr < RR; ++rr) { float* xo = outf + (size_t)(base + rr) * DM;
#pragma unroll
                for (int h = 0; h < 2; ++h) { *(f32x4*)(xo + h * 512 + lane * 8) = xv[rr][2 * h]; *(f32x4*)(xo + h * 512 + lane * 8 + 4) = xv[rr][2 * h + 1]; } }
            continue;
        }
#pragma unroll
        for (int rr = 0; rr < RR; ++rr) { float s2 = 0.f;
#pragma unroll
            for (int j = 0; j < 4; ++j) s2 += (xv[rr][j][0] * xv[rr][j][0] + xv[rr][j][1] * xv[rr][j][1]) + (xv[rr][j][2] * xv[rr][j][2] + xv[rr][j][3] * xv[rr][j][3]);
            red[rr] = s2; }
#pragma unroll
        for (int o = 1; o < 64; o <<= 1) {
#pragma unroll
            for (int rr = 0; rr < RR; ++rr) red[rr] += __shfl_xor(red[rr], o); }
#pragma unroll
        for (int rr = 0; rr < RR; ++rr) {
            if (lane == 0) { if (MODE == 0) *(f32x4*)(rs + (size_t)(base + rr) * 4) = (f32x4){red[rr], 0.f, 0.f, 0.f}; else rs[base + rr] = rsqrtf(red[rr] * (1.0f / DM) + NORM_EPS); }
            bf16_t* br = x16 + (size_t)(base + rr) * DM;
#pragma unroll
            for (int h = 0; h < 2; ++h) st16((br + h * 512 + lane * 8), pack8(xv[rr][2 * h], xv[rr][2 * h + 1]));
        }
    }
}

__device__ __forceinline__ void sincos2pi(double r, double& s, double& c) {
    const double x = r * 6.283185307179586476925, x2 = x * x;
    double ts = 1.0 / 121645100408832000.0 * -1.0;
    double ps = -1.0 / 25852016738884976640000.0;
    ps = ps * x2 + 1.0 / 51090942171709440000.0;
    ps = ps * x2 - 1.0 / 121645100408832000.0;
    ps = ps * x2 + 1.0 / 355687428096000.0;
    ps = ps * x2 - 1.0 / 1307674368000.0;
    ps = ps * x2 + 1.0 / 6227020800.0;
    ps = ps * x2 - 1.0 / 39916800.0;
    ps = ps * x2 + 1.0 / 362880.0;
    ps = ps * x2 - 1.0 / 5040.0;
    ps = ps * x2 + 1.0 / 120.0;
    ps = ps * x2 - 1.0 / 6.0;
    ps = ps * x2 + 1.0;
    s = ps * x; (void)ts;
    double pc = 1.0 / 620448401733239439360000.0;
    pc = pc * x2 - 1.0 / 1124000727777607680000.0;
    pc = pc * x2 + 1.0 / 2432902008176640000.0;
    pc = pc * x2 - 1.0 / 6402373705728000.0;
    pc = pc * x2 + 1.0 / 20922789888000.0;
    pc = pc * x2 - 1.0 / 87178291200.0;
    pc = pc * x2 + 1.0 / 479001600.0;
    pc = pc * x2 - 1.0 / 3628800.0;
    pc = pc * x2 + 1.0 / 40320.0;
    pc = pc * x2 - 1.0 / 720.0;
    pc = pc * x2 + 1.0 / 24.0;
    pc = pc * x2 - 0.5;
    c = pc * x2 + 1.0;
}
__device__ __forceinline__ double exp_small(double v) {
    double p = 1.0 / 87178291200.0;
    p = p * v + 1.0 / 6227020800.0; p = p * v + 1.0 / 479001600.0; p = p * v + 1.0 / 39916800.0; p = p * v + 1.0 / 3628800.0; p = p * v + 1.0 / 362880.0; p = p * v + 1.0 / 40320.0;
    p = p * v + 1.0 / 5040.0; p = p * v + 1.0 / 720.0; p = p * v + 1.0 / 120.0; p = p * v + 1.0 / 24.0; p = p * v + 1.0 / 6.0; p = p * v + 0.5; p = p * v + 1.0; p = p * v + 1.0; return p;
}
__device__ __forceinline__ double exp_neg(double v) { double e = exp_small(v * 0.0625); e *= e; e *= e; e *= e; e *= e; return e; }
__device__ __forceinline__ void cpow_lam(double lrdt, double lidt, int d, double& re, double& im) {
    double m = (double)d * lrdt;
    double mag = 1.0;
    while (m < -8.0) { mag *= 3.3546262790251185e-4; m += 8.0; }
    while (m > 0.5) { mag *= 1.6487212707001282; m -= 0.5; }
    mag *= (m <= 0.0) ? exp_neg(m) : exp_small(m);
    double rev = (double)d * lidt * 0.15915494309189533577; rev -= __builtin_rint(rev);
    double s, c; sincos2pi(rev, s, c); re = mag * c; im = mag * s;
}

__device__ __forceinline__ void ssm_naive_phase(unsigned char* ws, int a, LAS unsigned char* lds, int wave, int lane) {
    if (wave >= 4) return;
    const float* sp = (const float*)(ws + WS_SP);
    const bf16_t* UA = (const bf16_t*)(ws + WS_UA); bf16_t* Y = (bf16_t*)(ws + WS_Y);
    LAS float* ul = (LAS float*)(lds + wave * 8192); LAS float* yl = ul + 1024;
    for (int task = blockIdx.x * 4 + wave; task < NB * SG; task += gridDim.x * 4) {
        const int b = task >> 6, g = task & 63, n = lane;
        float bbr[16], bbi[16], cr[16], ci[16];
        const int agn = (a * SG + g) * SN + n;
#pragma unroll
        for (int c4 = 0; c4 < 4; ++c4) { const f32x4 r4 = *(const f32x4*)(sp + SP_BBR + agn * SC + c4 * 4), i4 = *(const f32x4*)(sp + SP_BBI + agn * SC + c4 * 4);
#pragma unroll
            for (int e = 0; e < 4; ++e) { bbr[c4 * 4 + e] = r4[e]; bbi[c4 * 4 + e] = i4[e]; } }
#pragma unroll
        for (int c = 0; c < 16; ++c) { cr[c] = sp[SP_CRE + ((a * SG + g) * SC + c) * SN + n]; ci[c] = sp[SP_CIM + ((a * SG + g) * SC + c) * SN + n]; }
        const float ar = sp[SP_AR + agn], ai = sp[SP_AI + agn];
        const int cl = (lane >> 2) & 15; const float dl = sp[SP_SD + (a * SG + g) * SC + cl];
        float sr = 0.f, si = 0.f;
        for (int k = 0; k < 64; ++k) {
            { const bf16_t* src = UA + (size_t)g * UA_G + (size_t)(b * 64 + k) * UA_LD + 128 + lane * 16;
              const u32x4 p0 = *(const u32x4*)src, p1 = *(const u32x4*)(src + 8);
              LAS f32x4* d = (LAS f32x4*)(ul + lane * 16);
              d[0] = (f32x4){bf_lo(p0.x), bf_hi(p0.x), bf_lo(p0.y), bf_hi(p0.y)}; d[1] = (f32x4){bf_lo(p0.z), bf_hi(p0.z), bf_lo(p0.w), bf_hi(p0.w)};
              d[2] = (f32x4){bf_lo(p1.x), bf_hi(p1.x), bf_lo(p1.y), bf_hi(p1.y)}; d[3] = (f32x4){bf_lo(p1.z), bf_hi(p1.z), bf_lo(p1.w), bf_hi(p1.w)}; }
            asm volatile("s_waitcnt lgkmcnt(0)" ::: "memory");
#pragma unroll 2
            for (int j = 0; j < 64; ++j) {
                const LAS f32x4* up = (const LAS f32x4*)(ul + j * 16); const f32x4 u0 = up[0], u1 = up[1], u2 = up[2], u3 = up[3];
                const float uu[16] = {u0[0], u0[1], u0[2], u0[3], u1[0], u1[1], u1[2], u1[3], u2[0], u2[1], u2[2], u2[3], u3[0], u3[1], u3[2], u3[3]};
                float bur = 0.f, bui = 0.f;
#pragma unroll
                for (int c = 0; c < 16; ++c) { bur += bbr[c] * uu[c]; bui += bbi[c] * uu[c]; }
                const float nsr = ar * sr - ai * si + bur, nsi = ar * si + ai * sr + bui; sr = nsr; si = nsi;
                float v[16];
#pragma unroll
                for (int c = 0; c < 16; ++c) v[c] = sr * cr[c] - si * ci[c];
                float w8[8], w4[4], w2[2], w1;
                { const bool h = (lane & 32) != 0;
#pragma unroll
                  for (int i = 0; i < 8; ++i) { const float send = h ? v[i] : v[i + 8], keep = h ? v[i + 8] : v[i]; w8[i] = keep + __shfl_xor(send, 32); } }
                { const bool h = (lane & 16) != 0;
#pragma unroll
                  for (int i = 0; i < 4; ++i) { const float send = h ? w8[i] : w8[i + 4], keep = h ? w8[i + 4] : w8[i]; w4[i] = keep + __shfl_xor(send, 16); } }
                { const bool h = (lane & 8) != 0;
#pragma unroll
                  for (int i = 0; i < 2; ++i) { const float send = h ? w4[i] : w4[i + 2], keep = h ? w4[i + 2] : w4[i]; w2[i] = keep + __shfl_xor(send, 8); } }
                { const bool h = (lane & 4) != 0; const float send = h ? w2[0] : w2[1], keep = h ? w2[1] : w2[0]; w1 = keep + __shfl_xor(send, 4); }
                w1 += __shfl_xor(w1, 2); w1 += __shfl_xor(w1, 1);
                const float yv = gelu_tanh(w1 + dl * ul[j * 16 + cl]);
                if ((lane & 3) == 0) yl[j * 16 + cl] = yv;
            }
            asm volatile("s_waitcnt lgkmcnt(0)" ::: "memory");
            { const LAS f32x4* yp = (const LAS f32x4*)(yl + lane * 16); const f32x4 y0 = yp[0], y1 = yp[1], y2 = yp[2], y3 = yp[3];
              bf16_t* dst = Y + (size_t)(b * SEQ + k * 64 + lane) * DM + g * 16;
              st16(dst, pack8(y0, y1)); st16((dst + 8), pack8(y2, y3)); }
            asm volatile("s_waitcnt lgkmcnt(0)" ::: "memory");
        }
    }
}

__device__ __forceinline__ void attn_naive_phase(const bf16_t* Q, const bf16_t* K, const bf16_t* V, bf16_t* O) {
    for (int unit = blockIdx.x; unit < NB * NHEAD * (SEQ / 512); unit += gridDim.x) {
        const int bh = unit >> 3, tc = unit & 7, b = bh >> 4, h = bh & 15, t = tc * 512 + (int)threadIdx.x;
        const size_t row = (size_t)b * SEQ + t;
        float q[64], o[64];
        { const u32x4* qp = (const u32x4*)(Q + row * DM + h * 64);
#pragma unroll
          for (int i = 0; i < 8; ++i) { const u32x4 w = qp[i]; q[8 * i] = bf_lo(w.x); q[8 * i + 1] = bf_hi(w.x); q[8 * i + 2] = bf_lo(w.y); q[8 * i + 3] = bf_hi(w.y); q[8 * i + 4] = bf_lo(w.z); q[8 * i + 5] = bf_hi(w.z); q[8 * i + 6] = bf_lo(w.w); q[8 * i + 7] = bf_hi(w.w); } }
#pragma unroll
        for (int i = 0; i < 64; ++i) o[i] = 0.f;
        float R = 0.f;
        for (int s = t - 1; s >= 0; --s) {
            const u32x4* kp = (const u32x4*)(K + ((size_t)b * SEQ + s) * DM + h * 64);
            float z = 0.f;
#pragma unroll
            for (int i = 0; i < 8; ++i) { const u32x4 w = kp[i]; z += q[8 * i] * bf_lo(w.x) + q[8 * i + 1] * bf_hi(w.x) + q[8 * i + 2] * bf_lo(w.y) + q[8 * i + 3] * bf_hi(w.y) + q[8 * i + 4] * bf_lo(w.z) + q[8 * i + 5] * bf_hi(w.z) + q[8 * i + 6] * bf_lo(w.w) + q[8 * i + 7] * bf_hi(w.w); }
            const float sp = fmaxf(z, 0.f) + __logf(1.0f + __expf(-fabsf(z)));
            R -= sp;
            const float w = __expf(z + R);
            { const bf16_t* vt = V + (size_t)(h * 64) * MTOK + (size_t)b * SEQ + s;
#pragma unroll
              for (int i = 0; i < 64; ++i) o[i] += w * bf_lo((unsigned)vt[(size_t)i * MTOK]); }
            if (R < -40.f) break;
        }
        u32x4* op = (u32x4*)(O + row * DM + h * 64);
#pragma unroll
        for (int i = 0; i < 8; ++i) { u32x4 w; w.x = cvt_pk_bf16(o[8 * i], o[8 * i + 1]); w.y = cvt_pk_bf16(o[8 * i + 2], o[8 * i + 3]); w.z = cvt_pk_bf16(o[8 * i + 4], o[8 * i + 5]); w.w = cvt_pk_bf16(o[8 * i + 6], o[8 * i + 7]); op[i] = w; }
    }
}

typedef short bf16x8 __attribute__((ext_vector_type(8)));
typedef float f32x16 __attribute__((ext_vector_type(16)));
template <bool DIAG> __device__ __forceinline__ void sb_tile(const f32x16& st, float& R, int r32, int hi, u32x4& p0, u32x4& p1) {
    float L[16], gs[4], og[4], w[16];
#pragma unroll
    for (int r = 0; r < 16; ++r) { const float z = st[r]; const float lg = __builtin_amdgcn_logf(1.0f + __builtin_amdgcn_exp2f(-fabsf(z))); const float v = -(fmaxf(z, 0.f) + lg);
        if (DIAG) { const int kap = (r & 3) + 8 * (r >> 2) + 4 * hi; L[r] = (kap >= r32) ? 0.f : v; } else L[r] = v; }
#pragma unroll
    for (int g = 0; g < 4; ++g) { gs[g] = (L[4 * g] + L[4 * g + 1]) + (L[4 * g + 2] + L[4 * g + 3]); og[g] = __shfl_xor(gs[g], 32); }
    float above = 0.f;
#pragma unroll
    for (int g = 3; g >= 0; --g) {
        float run = R + above + (hi == 0 ? og[g] : 0.f);
#pragma unroll
        for (int e = 3; e >= 0; --e) { const int r = 4 * g + e; run += L[r]; const float wv = __builtin_amdgcn_exp2f(st[r] + run);
            if (DIAG) { const int kap = e + 8 * g + 4 * hi; w[r] = (kap >= r32) ? 0.f : wv; } else w[r] = wv; }
        above += gs[g] + og[g];
    }
    R += above;
    p0.x = cvt_pk_bf16(w[0], w[1]); p0.y = cvt_pk_bf16(w[2], w[3]); p0.z = cvt_pk_bf16(w[4], w[5]); p0.w = cvt_pk_bf16(w[6], w[7]);
    p1.x = cvt_pk_bf16(w[8], w[9]); p1.y = cvt_pk_bf16(w[10], w[11]); p1.z = cvt_pk_bf16(w[12], w[13]); p1.w = cvt_pk_bf16(w[14], w[15]);
}
__device__ __forceinline__ void attn_mfma_phase(const bf16_t* Q, const bf16_t* K, const bf16_t* VT, bf16_t* O, LAS unsigned char* lds, int gw, int NGW, int wave, int lane) {
    const int r32 = lane & 31, hi = lane >> 5;
    LAS bf16_t* stg = (LAS bf16_t*)(lds + wave * 16384);
    LAS unsigned char* kst = lds + wave * 16384 + 4096; LAS unsigned char* vst = kst + 32 * 144;
#define ATT_LOAD(KR, VR, RB, HH, S0) do { \
        _Pragma("unroll") for (int i = 0; i < 4; ++i) { KR[i] = *(const u32x4*)(K + ((RB) + (S0) + 8 * i + (lane >> 3)) * DM + (HH) * 64 + (lane & 7) * 8); \
            VR[i] = *(const u32x4*)(VT + (size_t)((HH) * 64 + 16 * i + (lane >> 2)) * MTOK + (RB) + (S0) + (lane & 3) * 8); } } while (0)
#define ATT_LOADQ(QF, RB, HH, T0) do { _Pragma("unroll") for (int d0 = 0; d0 < 4; ++d0) QF[d0] = *(const bf16x8*)(Q + ((RB) + (T0) + r32) * DM + (HH) * 64 + d0 * 16 + hi * 8); } while (0)
    const int NUNIT = NB * NHEAD * (SEQ / 32);
    bf16x8 qn[4]; u32x4 krn[4], vrn[4];
    if (gw < NUNIT) { const int bh_ = gw >> 7, t0_ = (gw & 127) * 32; const size_t rb_ = (size_t)(bh_ >> 4) * SEQ; ATT_LOADQ(qn, rb_, bh_ & 15, t0_); ATT_LOAD(krn, vrn, rb_, bh_ & 15, t0_); }
    for (int unit = gw; unit < NUNIT; unit += NGW) {
        const int qb = unit & 127, bh = unit >> 7, b = bh >> 4, h = bh & 15, t0 = qb * 32;
        const size_t rowb = (size_t)b * SEQ;
        bf16x8 qf[4]; u32x4 kr[4], vr[4];
#pragma unroll
        for (int i = 0; i < 4; ++i) { qf[i] = qn[i]; kr[i] = krn[i]; vr[i] = vrn[i]; }
        f32x16 o0, o1;
#pragma unroll
        for (int r = 0; r < 16; ++r) { o0[r] = 0.f; o1[r] = 0.f; }
        float R = 0.f;
        bool nxt_pending = (unit + NGW < NUNIT);
        for (int s0 = t0; s0 >= 0; s0 -= 32) {
            const bool more = s0 >= 32;
#pragma unroll
            for (int i = 0; i < 4; ++i) { *(LAS u32x4*)(kst + (8 * i + (lane >> 3)) * 144 + (lane & 7) * 16) = kr[i]; *(LAS u32x4*)(vst + (16 * i + (lane >> 2)) * 80 + (lane & 3) * 16) = vr[i]; }
            asm volatile("s_waitcnt lgkmcnt(0)" ::: "memory");
            if (more) ATT_LOAD(kr, vr, rowb, h, s0 - 32);
            if (nxt_pending) { nxt_pending = false; const int un_ = unit + NGW, bh_ = un_ >> 7, t0_ = (un_ & 127) * 32; const size_t rb_ = (size_t)(bh_ >> 4) * SEQ; ATT_LOADQ(qn, rb_, bh_ & 15, t0_); ATT_LOAD(krn, vrn, rb_, bh_ & 15, t0_); }
            bf16x8 kf[4], vf[2][2];
#pragma unroll
            for (int d0 = 0; d0 < 4; ++d0) kf[d0] = *(const LAS bf16x8*)(kst + r32 * 144 + d0 * 32 + hi * 16);
#pragma unroll
            for (int db = 0; db < 2; ++db)
#pragma unroll
                for (int ks = 0; ks < 2; ++ks) { const u32x2 lo_ = *(const LAS u32x2*)(vst + (r32 + 32 * db) * 80 + 32 * ks + 8 * hi), h8_ = *(const LAS u32x2*)(vst + (r32 + 32 * db) * 80 + 32 * ks + 8 * hi + 16);
                    const u32x4 v_ = {lo_.x, lo_.y, h8_.x, h8_.y}; vf[db][ks] = __builtin_bit_cast(bf16x8, v_); }
            asm volatile("s_waitcnt lgkmcnt(0)" ::: "memory");
            f32x16 st;
#pragma unroll
            for (int r = 0; r < 16; ++r) st[r] = 0.f;
#pragma unroll
            for (int d0 = 0; d0 < 4; ++d0) st = __builtin_amdgcn_mfma_f32_32x32x16_f16(__builtin_bit_cast(pg8::h16x8, kf[d0]), __builtin_bit_cast(pg8::h16x8, qf[d0]), st, 0, 0, 0);
            u32x4 p0, p1;
            if (s0 == t0) sb_tile<true>(st, R, r32, hi, p0, p1); else sb_tile<false>(st, R, r32, hi, p0, p1);
            const bf16x8 pa0 = __builtin_bit_cast(bf16x8, p0), pa1 = __builtin_bit_cast(bf16x8, p1);
            o0 = __builtin_amdgcn_mfma_f32_32x32x16_f16(__builtin_bit_cast(pg8::h16x8, pa0), __builtin_bit_cast(pg8::h16x8, vf[0][0]), o0, 0, 0, 0); o0 = __builtin_amdgcn_mfma_f32_32x32x16_f16(__builtin_bit_cast(pg8::h16x8, pa1), __builtin_bit_cast(pg8::h16x8, vf[0][1]), o0, 0, 0, 0);
            o1 = __builtin_amdgcn_mfma_f32_32x32x16_f16(__builtin_bit_cast(pg8::h16x8, pa0), __builtin_bit_cast(pg8::h16x8, vf[1][0]), o1, 0, 0, 0); o1 = __builtin_amdgcn_mfma_f32_32x32x16_f16(__builtin_bit_cast(pg8::h16x8, pa1), __builtin_bit_cast(pg8::h16x8, vf[1][1]), o1, 0, 0, 0);
            if (__all(R < -30.f)) break;
        }
#pragma unroll
        for (int r = 0; r < 16; ++r) { const int q = (r & 3) + 8 * (r >> 2) + 4 * hi; stg[q * 64 + r32] = (bf16_t)(cvt_pk_bf16(o0[r], 0.f) & 0xffffu); stg[q * 64 + 32 + r32] = (bf16_t)(cvt_pk_bf16(o1[r], 0.f) & 0xffffu); }
        asm volatile("s_waitcnt lgkmcnt(0)" ::: "memory");
#pragma unroll
        for (int i = 0; i < 4; ++i) { const int row = i * 8 + (lane >> 3), ch = lane & 7; const u32x4 v = *(const LAS u32x4*)(stg + row * 64 + ch * 8); *(u32x4*)(O + (rowb + t0 + row) * DM + h * 64 + ch * 8) = v; }
        asm volatile("s_waitcnt lgkmcnt(0)" ::: "memory");
    }
#undef ATT_LOAD
#undef ATT_LOADQ
}

__device__ __forceinline__ float bfly16(const float (&v)[16], int lane) {
    float w8[8], w4[4], w2[2], w1;
    { const bool h = (lane & 32) != 0;
#pragma unroll
      for (int i = 0; i < 8; ++i) { const float send = h ? v[i] : v[i + 8], keep = h ? v[i + 8] : v[i]; w8[i] = keep + __shfl_xor(send, 32); } }
    { const bool h = (lane & 16) != 0;
#pragma unroll
      for (int i = 0; i < 4; ++i) { const float send = h ? w8[i] : w8[i + 4], keep = h ? w8[i + 4] : w8[i]; w4[i] = keep + __shfl_xor(send, 16); } }
    { const bool h = (lane & 8) != 0;
#pragma unroll
      for (int i = 0; i < 2; ++i) { const float send = h ? w4[i] : w4[i + 2], keep = h ? w4[i + 2] : w4[i]; w2[i] = keep + __shfl_xor(send, 8); } }
    { const bool h = (lane & 4) != 0; const float send = h ? w2[0] : w2[1], keep = h ? w2[1] : w2[0]; w1 = keep + __shfl_xor(send, 4); }
    w1 += __shfl_xor(w1, 2); w1 += __shfl_xor(w1, 1); return w1;
}
__device__ __forceinline__ void ssm_expand_tables(unsigned char* ws, int a, int gt, int NGT) {
    const float* sp = (const float*)(ws + WS_SP); const float* PW = (const float*)(ws + WS_PW); const float* KD = (const float*)(ws + WS_KD);
    bf16_t* KQT = (bf16_t*)(ws + WS_KQT); bf16_t* PT = (bf16_t*)(ws + WS_PT);
#pragma unroll 4
    for (int idx = gt; idx < SG * 1024 * 128; idx += NGT) {
        const int cj = idx & 127, rowi = idx >> 7, g = rowi >> 10, n = rowi & 1023, l = n >> 4, c = n & 15, j = cj >> 1, c0 = (cj & 1) * 8, d = l - j, dc = d < 0 ? 0 : d;
        const float* kd = KD + ((size_t)((a * SG + g) * 64 + dc) * 16 + c) * 16 + c0; f32x4 v0 = *(const f32x4*)kd, v1 = *(const f32x4*)(kd + 4);
        if (d < 0) { v0 = (f32x4){0.f, 0.f, 0.f, 0.f}; v1 = v0; }
        st16((KQT + (size_t)rowi * UA_LD + 128 + cj * 8), pack8(v0, v1));
    }
#pragma unroll 2
    for (int idx = gt; idx < SG * 1024 * 16; idx += NGT) {
        const int ck = idx & 15, rowi = idx >> 4, g = rowi >> 10, n = rowi & 1023, l = n >> 4, c = n & 15, nb = (ck & 7) * 8; const bool imag = ck >= 8; f32x4 v0, v1;
        const float* cr = sp + SP_CRE + ((a * SG + g) * SC + c) * SN + nb; const float* ci = sp + SP_CIM + ((a * SG + g) * SC + c) * SN + nb; const float* pw = PW + ((size_t)((a * SG + g) * 65 + l + 1) * 64 + nb) * 2;
#pragma unroll
        for (int e = 0; e < 8; ++e) { const float Cr = cr[e], Ci = ci[e], pr = pw[2 * e], pi = pw[2 * e + 1]; const float val = imag ? -(Cr * pi + Ci * pr) : (Cr * pr - Ci * pi); if (e < 4) v0[e] = val; else v1[e - 4] = val; }
        st16((KQT + (size_t)rowi * UA_LD + ck * 8), pack8(v0, v1));
    }
#pragma unroll 2
    for (int idx = gt; idx < SG * 128 * 128; idx += NGT) {
        const int ck = idx & 127, rowi = idx >> 7, g = rowi >> 7, r = rowi & 127, np = r & 63, j = ck >> 1, c0 = (ck & 1) * 8; const bool imag = r >= 64;
        const float* pw = PW + ((size_t)((a * SG + g) * 65 + 63 - j) * 64 + np) * 2; const float pr = pw[0], pi = pw[1];
        const float* br = sp + SP_BBR + ((a * SG + g) * SN + np) * SC + c0; const float* bi = sp + SP_BBI + ((a * SG + g) * SN + np) * SC + c0; f32x4 v0, v1;
#pragma unroll
        for (int e = 0; e < 8; ++e) { const float val = imag ? (pr * bi[e] + pi * br[e]) : (pr * br[e] - pi * bi[e]); if (e < 4) v0[e] = val; else v1[e - 4] = val; }
        st16((PT + (size_t)rowi * 1024 + ck * 8), pack8(v0, v1));
    }
}
__device__ __forceinline__ void ssm_carry(unsigned char* ws, int a, int gt, int NGT) {
    const float* PW = (const float*)(ws + WS_PW); const float* SL = (const float*)(ws + WS_SLOC); bf16_t* UA = (bf16_t*)(ws + WS_UA);
    for (int idx = gt; idx < SG * NB * SN; idx += NGT) {
        const int n = idx & 63, b = (idx >> 6) & 15, g = idx >> 10;
        const float* pw = PW + ((size_t)((a * SG + g) * 65 + 64) * 64 + n) * 2; const float ar = pw[0], ai = pw[1];
        float sr = 0.f, si = 0.f;
#pragma unroll 8
        for (int k = 0; k < 64; ++k) { const int chunk = b * 64 + k; bf16_t* up = UA + (size_t)g * UA_G + (size_t)chunk * UA_LD; const float* sl = SL + ((size_t)g * 1024 + chunk) * 128;
            up[n] = (bf16_t)(cvt_pk_bf16(sr, 0.f) & 0xffffu); up[64 + n] = (bf16_t)(cvt_pk_bf16(si, 0.f) & 0xffffu);
            const float lr = sl[n], li = sl[64 + n]; const float nsr = ar * sr - ai * si + lr, nsi = ar * si + ai * sr + li; sr = nsr; si = nsi; }
    }
}
__device__ __forceinline__ void ssm_carry_unit(unsigned char* ws, int a, int g, int pm4, int t) {
    if (t >= 256) return;
    const float* PW = (const float*)(ws + WS_PW); const float* SL = (const float*)(ws + WS_SLOC); bf16_t* UA = (bf16_t*)(ws + WS_UA);
    const int n = t & 63, b = 4 * pm4 + (t >> 6);
    const float* pw = PW + ((size_t)((a * SG + g) * 65 + 64) * 64 + n) * 2; const float ar = pw[0], ai = pw[1];
    float sr = 0.f, si = 0.f;
#pragma unroll 8
    for (int k = 0; k < 64; ++k) { const int chunk = b * 64 + k; bf16_t* up = UA + (size_t)g * UA_G + (size_t)chunk * UA_LD; const float* sl = SL + ((size_t)g * 1024 + chunk) * 128;
        up[n] = (bf16_t)(cvt_pk_bf16(sr, 0.f) & 0xffffu); up[64 + n] = (bf16_t)(cvt_pk_bf16(si, 0.f) & 0xffffu);
        const float lr = sl[n], li = sl[64 + n]; const float nsr = ar * sr - ai * si + lr, nsi = ar * si + ai * sr + li; sr = nsr; si = nsi; }
}

#define GAS __attribute__((address_space(1)))
#define XB_TMO      128
#define XB_XCNT(j)  (256  + 64 * (j))
#define XB_XSUB(j)  (1280 + 64 * (j))
#define XB_XGEN(j)  (2304 + 64 * (j))
#define XB_TOP      3328
#define XB_TOPGEN   3392
#define XCD_BAR_WORDS 3456
#define XB_SPIN_CAP (1u << 18)

__device__ __forceinline__ unsigned xb_ld(unsigned* p)              { return __hip_atomic_load(p, __ATOMIC_RELAXED, __HIP_MEMORY_SCOPE_AGENT); }
__device__ __forceinline__ unsigned xb_add(unsigned* p, unsigned v) { return __hip_atomic_fetch_add(p, v, __ATOMIC_RELAXED, __HIP_MEMORY_SCOPE_AGENT); }
__device__ __forceinline__ unsigned xb_xcc_id() { return (unsigned)__builtin_amdgcn_s_getreg((3 << 11) | 20) & 0xFu; }
#define XB_SPIN(cond, bar) do { unsigned _sp = 0; while (cond) { __builtin_amdgcn_s_sleep(1); \
    if ((++_sp & 255u) == 0u) { if (xb_ld(&(bar)[XB_TMO])) break; if (_sp > XB_SPIN_CAP) { atomicAdd(&(bar)[XB_TMO], 1u); break; } } } } while (0)

struct XcdBarrier {
    unsigned* bar; unsigned x;
    volatile LAS unsigned* st;
};

__device__ __forceinline__ XcdBarrier xcd_barrier_post(unsigned* bar, volatile LAS unsigned* st) {
    XcdBarrier b; b.bar = bar; b.x = xb_xcc_id(); b.st = st;
    if (threadIdx.x == 0) (void)xb_add(&bar[XB_XCNT(b.x)], 1u);
    return b;
}
__device__ __forceinline__ void xcd_barrier_complete(unsigned* bar, unsigned x, unsigned& nloc, unsigned& nx) {
    const unsigned G = gridDim.x * gridDim.y * gridDim.z;
    unsigned sum, cnt, mine, sp = 0u;
    for (;;) {
        sum = 0u; cnt = 0u; mine = 0u;
#pragma unroll
        for (unsigned j = 0; j < 16; ++j) { const unsigned c = xb_ld(&bar[XB_XCNT(j)]); sum += c; cnt += (c > 0u) ? 1u : 0u; mine = (j == x) ? c : mine; }
        if (sum == G) break;
        __builtin_amdgcn_s_sleep(1);
        if ((++sp & 255u) == 0u) { if (xb_ld(&bar[XB_TMO])) break; if (sp > XB_SPIN_CAP) { atomicAdd(&bar[XB_TMO], 1u); break; } }
    }
    nloc = mine > 0u ? mine : 1u; nx = cnt > 0u ? cnt : 1u;
}

__device__ __forceinline__ void xcd_barrier(const XcdBarrier& b) {
    asm volatile("s_waitcnt vmcnt(0)" ::: "memory");
    __syncthreads();
    if (threadIdx.x == 0) {
        unsigned* bar = b.bar;
        __builtin_amdgcn_s_waitcnt(0);
        unsigned nloc = b.st[0], nx = b.st[1];
        if (nloc == 0u) { xcd_barrier_complete(bar, b.x, nloc, nx); b.st[0] = nloc; b.st[1] = nx; }
        const unsigned old = xb_add(&bar[XB_XSUB(b.x)], 1u);
        const unsigned gen = old / nloc;
        if (old + 1u == (gen + 1u) * nloc) {
            __builtin_amdgcn_fence(__ATOMIC_RELEASE, "agent");
            asm volatile("s_waitcnt vmcnt(0)" ::: "memory");
            const unsigned og = xb_add(&bar[XB_TOP], 1u);
            const unsigned tg = og / nx;
            if (og + 1u == (tg + 1u) * nx) xb_add(&bar[XB_TOPGEN], 1u);
            else XB_SPIN(xb_ld(&bar[XB_TOPGEN]) == tg, bar);
            __builtin_amdgcn_fence(__ATOMIC_ACQUIRE, "agent");
            xb_add(&bar[XB_XGEN(b.x)], 1u);
            asm volatile("s_waitcnt vmcnt(0)" ::: "memory");
        } else {
            XB_SPIN(xb_ld(&bar[XB_XGEN(b.x)]) == gen, bar);
            __builtin_amdgcn_fence(__ATOMIC_ACQUIRE, "agent");
            asm volatile("s_waitcnt vmcnt(0)" ::: "memory");
        }
    }
    __syncthreads();
}

constexpr int CW_GMASK = 4096, CW_GCNT = 4096 + 512;
__device__ __forceinline__ void group_barrier(unsigned* cnt) {
    asm volatile("s_waitcnt vmcnt(0)" ::: "memory");
    __syncthreads();
    if (threadIdx.x == 0) {
        const unsigned old = __hip_atomic_fetch_add(cnt, 1u, __ATOMIC_RELAXED, __HIP_MEMORY_SCOPE_AGENT), target = (old / 32u + 1u) * 32u; unsigned sp = 0u;
        while (__hip_atomic_load(cnt, __ATOMIC_RELAXED, __HIP_MEMORY_SCOPE_AGENT) < target) { __builtin_amdgcn_s_sleep(1); if (++sp > (1u << 22)) break; }
        __builtin_amdgcn_fence(__ATOMIC_ACQUIRE, "agent");
        asm volatile("s_waitcnt vmcnt(0)" ::: "memory");
    }
    __syncthreads();
}

constexpr int NS5 = 9, NMIX5 = 5, NAT = 7;
constexpr int NPH = 1 + 2 * NS5 + 2 * NAT;
template <class Op> __device__ __forceinline__ void run_gemm(LAS unsigned char* lds, const bf16_t* A, const bf16_t* Bt, int M, int N, int K, const Op& op) {
    pg8::Gemm g{A, Bt, M, N, K, K, K, 0, 0}; pg8::StaticOrder S; S.init(M, N, (int)gridDim.x, (int)blockIdx.x); EpiGen<Op> E{op, (LAS float*)(lds + RING_BYTES + 8192), -1};
    pg8::gemm_phase<EpiGen<Op>, pg8::StaticOrder, true, true>(lds, g, S, E);
}
template <class Op> __device__ __forceinline__ void run_gemm_n(LAS unsigned char* lds, const bf16_t* A, const bf16_t* Bt, int M, int N, int K, const Op& op) {
    pg8::Gemm g{A, Bt, M, N, K, K, K, 0, 0}; pg8::StaticOrder S; S.init(M, N, (int)gridDim.x, (int)blockIdx.x); EpiGen<Op> E{op, (LAS float*)(lds + RING_BYTES + 8192), -1};
    pg8::gemm_phase<EpiGen<Op>, pg8::StaticOrder, true, true>(lds, g, S, E);
}
__device__ __forceinline__ void run_gemm_fused(LAS unsigned char* lds, const bf16_t* A, const bf16_t* Bt, int K, const EpiFused& E) {
    pg8::Gemm g{A, Bt, MTOK, DM, K, K, K, 0, 0}; pg8::StaticOrder S; S.init(MTOK, DM, (int)gridDim.x, (int)blockIdx.x);
    pg8::gemm_phase<EpiFused, pg8::StaticOrder, true, true>(lds, g, S, E);
}
template <class Op> __device__ __forceinline__ void run_gemm_b(LAS unsigned char* lds, const bf16_t* A, const bf16_t* Bt, int M, int N, int K, int lda, int ldb, size_t sAz, size_t sBz, int nz, int tri, const Op& op) {
    pg8::Gemm g{A, Bt, M, N, K, lda, ldb, sAz, sBz}; pg8::BatchOrder S; S.init(M, N, nz, (int)gridDim.x, (int)blockIdx.x, tri); EpiGen<Op> E{op, (LAS float*)(lds + RING_BYTES + 8192), -1};
    pg8::gemm_phase<EpiGen<Op>, pg8::BatchOrder, true, true>(lds, g, S, E);
}
__global__ void __launch_bounds__(NWAVES * 64, 2) mk_fwd(Args A) {
    extern __shared__ __attribute__((aligned(16))) unsigned char lds_raw[];
    LAS unsigned char* lds = (LAS unsigned char*)lds_raw;
    const int tid = threadIdx.x, lane = tid & 63, wave = __builtin_amdgcn_readfirstlane(tid >> 6);
    const int gw = blockIdx.x * NWAVES + wave, NGW = gridDim.x * NWAVES;
    unsigned char* ws = A.ws;
    float* RS = (float*)(ws + WS_RS); bf16_t* Wb = (bf16_t*)(ws + WS_W); bf16_t* XB = (bf16_t*)(ws + WS_XB); bf16_t* HID = (bf16_t*)(ws + WS_HID);
    bf16_t* UA = (bf16_t*)(ws + WS_UA); bf16_t* Yb = (bf16_t*)(ws + WS_Y); bf16_t* Zb = (bf16_t*)(ws + WS_Z);
    bf16_t* Qb = (bf16_t*)A.out + (size_t)MTOK * DM; bf16_t* Ob = (bf16_t*)(ws + WS_O); bf16_t* Kb = (bf16_t*)(ws + WS_K); bf16_t* Vb = (bf16_t*)(ws + WS_V);
    float* X = A.out; const float* SP = (const float*)(ws + WS_SP); const float* NG = SP + SP_NG;
    volatile LAS unsigned* misc = (volatile LAS unsigned*)(lds + RING_BYTES + 64);
    if (tid < 4) misc[tid] = 0u;
    __syncthreads();
    if (tid == 0) __hip_atomic_fetch_or((unsigned*)A.ws + CW_GMASK + 64 * (blockIdx.x & 7), 1u << xb_xcc_id(), __ATOMIC_RELAXED, __HIP_MEMORY_SCOPE_AGENT);
    (void)xcd_barrier_post((unsigned*)A.ws, misc);
    int p0 = A.ph_lo;
    if (p0 == 0) {
        {
            LAS float* scr = (LAS float*)(lds + wave * 16384); int cstart = gw;
            const float* NGi = A.in[I_NG];
            for (int l = 0; l < 4; ++l) for (int j = 0; j < 2; ++j) { const int lj = l * 2 + j; bf16_t* wgu = Wb + WO_FFN + (size_t)lj * W_FFN; const float* gn = NGi + (l * 6 + (j ? 4 : 0)) * DM;
                CONV(A.in[I_WG] + (size_t)lj * DM * DFF, DM, DFF, gn, 1, wgu, 0); CONV(A.in[I_WU] + (size_t)lj * DM * DFF, DM, DFF, gn, 2, wgu, 0);
                CONV(A.in[I_WD] + (size_t)lj * DFF * DM, DFF, DM, (const float*)nullptr, 0, wgu + W_GU, 0); }
            for (int a = 0; a < 2; ++a) { bf16_t* w = Wb + WO_SSM + (size_t)a * 3 * W_SQ;
                CONV(A.in[I_SWIN] + (size_t)a * W_SQ, DM, DM, NGi + (a * 6 + 2) * DM, 0, w, 0); CONV(A.in[I_SWGLU] + (size_t)a * W_SQ, DM, DM, (const float*)nullptr, 0, w + W_SQ, 0);
                CONV(A.in[I_SWOUT] + (size_t)a * W_SQ, DM, DM, (const float*)nullptr, 0, w + 2 * W_SQ, 0); }
            CONV(A.in[I_WQ], DM, DM, NGi + (2 * 6 + 2) * DM, 0, Wb + WO_QKV, 0); CONV(A.in[I_WK], DM, DM, A.in[I_KVG], 0, Wb + WO_QKV, DM); CONV(A.in[I_WV], DM, DM, A.in[I_KVG], 0, Wb + WO_QKV, 2 * DM);
            CONV(A.in[I_WQ] + W_SQ, DM, DM, NGi + (3 * 6 + 2) * DM, 0, Wb + WO_Q1, 0);
            CONV(A.in[I_WO], DM, DM, (const float*)nullptr, 0, Wb + WO_O, 0); CONV(A.in[I_WO] + W_SQ, DM, DM, (const float*)nullptr, 0, Wb + WO_O + W_SQ, 0);
            float* spw = (float*)(ws + WS_SP); const int gt = blockIdx.x * (NWAVES * 64) + tid, NGT = gridDim.x * NWAVES * 64;
#define COPYP(idx, off, n) for (int i_ = gt; i_ < (n); i_ += NGT) spw[(off) + i_] = A.in[idx][i_]
            for (int i_ = gt; i_ < (int)((size_t)MTOK * 4 * 8 / 16); i_ += NGT) ((u32x4*)(ws + WS_XS1))[i_] = (u32x4){0u, 0u, 0u, 0u};
            COPYP(I_NG, SP_NG, 24576); COPYP(I_LRE, SP_LRE, 8192); COPYP(I_LIM, SP_LIM, 8192); COPYP(I_LDT, SP_LDT, 128); COPYP(I_BRE, SP_BRE, 131072); COPYP(I_BIM, SP_BIM, 131072);
            COPYP(I_CRE, SP_CRE, 131072); COPYP(I_CIM, SP_CIM, 131072); COPYP(I_SD, SP_SD, 2048);
            for (int i = gt; i < 2 * SG * SN; i += NGT) {
                const int ag = i >> 6;
                const double dt = (double)expf(A.in[I_LDT][ag]);
                const double lr = A.in[I_LRE][i], li = A.in[I_LIM][i];
                double are, aim; cpow_lam(lr * dt, li * dt, 1, are, aim);
                const double den = lr * lr + li * li, nr = are - 1.0, ni = aim;
                const double fre = (nr * lr + ni * li) / den, fim = (ni * lr - nr * li) / den;
                spw[SP_AR + i] = (float)are; spw[SP_AI + i] = (float)aim;
                for (int c = 0; c < 16; ++c) { const double br = A.in[I_BRE][(size_t)i * SC + c], bi = A.in[I_BIM][(size_t)i * SC + c];
                    spw[SP_BBR + i * SC + c] = (float)(fre * br - fim * bi); spw[SP_BBI + i * SC + c] = (float)(fre * bi + fim * br); }
            }
            {
                float* PWw = (float*)(ws + WS_PW); float* KDw = (float*)(ws + WS_KD);
                for (int i = gt; i < 2 * SG * 65 * SN; i += NGT) { const int n = i & 63, d = (i >> 6) % 65, ag = (i >> 6) / 65;
                    const double dt = (double)expf(A.in[I_LDT][ag]); const double lr = A.in[I_LRE][ag * SN + n], li = A.in[I_LIM][ag * SN + n];
                    double pr, pi; cpow_lam(lr * dt, li * dt, d, pr, pi); PWw[2 * (size_t)i] = (float)pr; PWw[2 * (size_t)i + 1] = (float)pi; }
                for (int task = gw; task < 2 * SG * 64; task += NGW) { const int ag = task >> 6, d = task & 63, n = lane, i = ag * SN + n;
                    const double dt = (double)expf(A.in[I_LDT][ag]); const double lr = A.in[I_LRE][i], li = A.in[I_LIM][i];
                    double are, aim, pr, pi; cpow_lam(lr * dt, li * dt, 1, are, aim); cpow_lam(lr * dt, li * dt, d, pr, pi);
                    const double den = lr * lr + li * li, nr = are - 1.0, ni = aim; const double fre = (nr * lr + ni * li) / den, fim = (ni * lr - nr * li) / den;
                    float tre[16], tim[16];
#pragma unroll
                    for (int c = 0; c < 16; ++c) { const double br = A.in[I_BRE][(size_t)i * SC + c], bi = A.in[I_BIM][(size_t)i * SC + c]; const double bbr = fre * br - fim * bi, bbi = fre * bi + fim * br;
                        tre[c] = (float)(pr * bbr - pi * bbi); tim[c] = (float)(pr * bbi + pi * bbr); }
                    const int cl = (lane >> 2) & 15;
                    for (int c = 0; c < 16; ++c) { const float Cr = A.in[I_CRE][((size_t)ag * SC + c) * SN + n], Ci = A.in[I_CIM][((size_t)ag * SC + c) * SN + n]; float v[16];
#pragma unroll
                        for (int e = 0; e < 16; ++e) v[e] = Cr * tre[e] - Ci * tim[e];
                        const float tot = bfly16(v, lane); if ((lane & 3) == 0) KDw[((size_t)task * 16 + c) * 16 + cl] = tot; }
                }
            }
            row_update<0, 4>(A.in[I_X], XB, nullptr, RS, nullptr, 0.f, nullptr, gw, NGW, lane); PROBE_RU_X
        }
        p0 = 1;
        if (A.ph_hi > 1) { cg::this_grid().sync(); }
        if (tid == 0) {
            unsigned ok = (gridDim.x == 256u) ? 1u : 0u;
            for (int x = 0; x < 8; ++x) { const unsigned m = __hip_atomic_load((unsigned*)A.ws + CW_GMASK + 64 * x, __ATOMIC_RELAXED, __HIP_MEMORY_SCOPE_AGENT); if (__builtin_popcount(m) != 1) ok = 0u; }
            misc[2] = ok; }
        __syncthreads();
    }
    for (int p = p0; p < A.ph_hi; ++p) {
        {
            unsigned char* ws = A.ws; asm volatile("" : "+s"(ws));
            int lane_p = lane, gw_p = gw; asm volatile("" : "+v"(lane_p)); asm volatile("" : "+s"(gw_p));
            float* RS = (float*)(ws + WS_RS); bf16_t* Wb = (bf16_t*)(ws + WS_W); bf16_t* XB = (bf16_t*)(ws + WS_XB); bf16_t* HID = (bf16_t*)(ws + WS_HID);
            bf16_t* UA = (bf16_t*)(ws + WS_UA); bf16_t* Yb = (bf16_t*)(ws + WS_Y); bf16_t* Zb = (bf16_t*)(ws + WS_Z);
            bf16_t* Qb = (bf16_t*)A.out + (size_t)MTOK * DM; bf16_t* Ob = (bf16_t*)(ws + WS_O); bf16_t* Kb = (bf16_t*)(ws + WS_K); bf16_t* Vb = (bf16_t*)(ws + WS_V);
            float* X = A.out; const float* SP = (const float*)(ws + WS_SP); const float* NG = SP + SP_NG;
            const int q = p - 1, layer = q < 2 * NS5 ? q / NS5 : 2 + (q - 2 * NS5) / NAT, s = q < 2 * NS5 ? q % NS5 : (q - 2 * NS5) % NAT;
            const int nmix = layer < 2 ? NMIX5 : 3;
            const int sub = (s < 2) ? 0 : (s < 2 + nmix ? 1 : 2);
            EpiFused EF; EF.x16 = XB; EF.g = NG + (layer * 6 + (sub == 0 ? 1 : (sub == 1 ? 3 : 5))) * DM; EF.alpha = (sub == 1) ? 1.0f : 0.5f; EF.outf = (layer == 3 && sub == 2) ? X : nullptr;
            EF.xs1 = (float*)(ws + WS_XS1); EF.ssq2 = RS; EF.cnt = (unsigned*)ws + CW_PCNT; EF.want = 32u * (unsigned)(layer * 3 + sub + 1); EF.xl = lds + RING_BYTES + 1024; EF.cpn = -1;
            if (s < 2 || s >= 2 + nmix) {
                const int j = s < 2 ? 0 : 1, st = s < 2 ? s : s - 2 - nmix; const bf16_t* wgu = Wb + WO_FFN + (size_t)(layer * 2 + j) * W_FFN;
                if (st == 0) run_gemm(lds, XB, wgu, MTOK, 2 * DFF, DM, OpSwiglu{RS, HID});
                else run_gemm_fused(lds, HID, wgu + W_GU, DFF, EF);
            } else if (layer < 2) {
                const bf16_t* w = Wb + WO_SSM + (size_t)layer * 3 * W_SQ; const int st = s - 2;
                if (st == 0) { run_gemm(lds, XB, w, MTOK, DM, DM, OpUA{UA, RS}); int tid_p = tid; asm volatile("" : "+v"(tid_p)); const int gt_l = blockIdx.x * (NWAVES * 64) + tid_p; ssm_expand_tables(ws, layer, gt_l, (int)gridDim.x * NWAVES * 64); }
                else if (st == 1) {
                    run_gemm_b(lds, UA + 128, (const bf16_t*)(ws + WS_PT), 1024, 256, 1024, UA_LD, 1024, UA_G, (size_t)128 * 1024, SG, 0, OpSloc{(float*)(ws + WS_SLOC)});
                    asm volatile("s_waitcnt vmcnt(0)" ::: "memory"); __syncthreads();
                    int tid_p = tid; asm volatile("" : "+v"(tid_p));
                    for (int L = blockIdx.x; L < SG * 4; L += gridDim.x) ssm_carry_unit(ws, layer, L >> 2, L & 3, tid_p); }
                else if (st == 2) run_gemm_b(lds, UA, (const bf16_t*)(ws + WS_KQT), 1024, 1024, UA_LD, UA_LD, UA_LD, UA_G, (size_t)1024 * UA_LD, SG, 1, OpY{UA, Yb, SP + SP_SD + layer * SG * SC});
                else if (st == 3) run_gemm(lds, Yb, w + W_SQ, MTOK, DM, DM, OpGLU{Yb, Zb});
                else run_gemm_fused(lds, Zb, w + 2 * W_SQ, DM, EF);
            } else {
                const int bl = layer - 2, st = s - 2;
                if (st == 0) { if (bl == 0) { run_gemm(lds, XB, Wb + WO_QKV, MTOK, 2 * DM, DM, OpQKV{Qb, ws, RS}); run_gemm_n(lds, Wb + WO_QKV + 2 * W_SQ, XB, DM, MTOK, DM, OpVT{Vb, RS}); } else run_gemm(lds, XB, Wb + WO_Q1, MTOK, DM, DM, OpQKV{Qb, ws, RS}); }
                else if (st == 1) { ATTN_CALL; }
                else run_gemm_fused(lds, Ob, Wb + WO_O + (size_t)bl * W_SQ, DM, EF);
            }
            (void)lane_p; (void)gw_p; (void)Kb;
        }
        if (p + 1 < A.ph_hi) {
            const int q_ = p - 1, s_ = q_ < 2 * NS5 ? q_ % NS5 : (q_ - 2 * NS5) % NAT; const bool s5_ = q_ < 2 * NS5;
            const bool seam = s5_ ? (s_ >= 2 && s_ <= 4) || s_ == 6 : (s_ >= 2 && s_ <= 4);
            const bool fast = misc[2] != 0u;
            if (seam || !fast) { XcdBarrier xb_; xb_.bar = (unsigned*)A.ws; xb_.x = xb_xcc_id(); xb_.st = (volatile LAS unsigned*)(lds + RING_BYTES + 64); xcd_barrier(xb_); }
            else group_barrier((unsigned*)A.ws + CW_GCNT + 64 * (blockIdx.x & 7));
        }
    }
}

extern "C" void kernel_launch(void* const* d_in, const int* in_sizes, int n_in, void* d_out, int out_size, void* d_ws, size_t ws_size, hipStream_t stream) {
    static int grid = 0;
    if (grid == 0) {
        if (n_in != 21 || out_size != MTOK * DM || ws_size < WS_END) { fprintf(stderr, "kernel_launch: unexpected shapes (n_in %d out %d ws %zu)\n", n_in, out_size, ws_size); grid = -1; return; }
        int dev = 0, cus = 0, per_cu = 0;
        hipGetDevice(&dev); hipDeviceGetAttribute(&cus, hipDeviceAttributeMultiprocessorCount, dev);
        if (hipFuncSetAttribute((const void*)mk_fwd, hipFuncAttributeMaxDynamicSharedMemorySize, LDS_BYTES) != hipSuccess) { fprintf(stderr, "kernel_launch: hipFuncSetAttribute failed\n"); grid = -1; return; }
        hipOccupancyMaxActiveBlocksPerMultiprocessor(&per_cu, (const void*)mk_fwd, NWAVES * 64, LDS_BYTES);
        (void)hipGetLastError();
        if (per_cu < 1) per_cu = 1;
        grid = cus * 1;
        if (grid <= 0) grid = 256;
    }
    if (grid < 0) return;
    if (hipMemsetAsync(d_ws, 0, 24576, stream) != hipSuccess) { fprintf(stderr, "kernel_launch: memset of the barrier words failed\n"); return; }
    Args a{};
    for (int i = 0; i < 21; ++i) a.in[i] = (const float*)d_in[i];
    a.out = (float*)d_out; a.ws = (unsigned char*)d_ws;
#if MK_MULTI
    for (int p = 0; p < NPH; ++p) { a.ph_lo = p; a.ph_hi = p + 1; hipLaunchKernelGGL(mk_fwd, dim3(grid), dim3(NWAVES * 64), LDS_BYTES, stream, a); }
#else
    a.ph_lo = 0; a.ph_hi = NPH;
    void* args[] = {&a};
    hipError_t e = hipLaunchCooperativeKernel((const void*)mk_fwd, dim3(grid), dim3(NWAVES * 64), args, LDS_BYTES, stream);
    if (e != hipSuccess) fprintf(stderr, "cooperative launch failed: %s (grid %d)\n", hipGetErrorString(e), grid);
#endif
}
```

```cpp
#include <hip/hip_runtime.h>
#include <hip/hip_cooperative_groups.h>
#include <cstdio>
#include <cstdint>
namespace cg = cooperative_groups;
#ifndef MK_MULTI
#define MK_MULTI 0
#endif
#ifndef NO_SSM
#define SSM_CALL do { int lane_l = lane, wave_l = wave; asm volatile("" : "+v"(lane_l)); asm volatile("" : "+s"(wave_l)); ssm_naive_phase(ws, layer, lds, wave_l, lane_l); PROBE_SSM2 } while (0)
#else
#define SSM_CALL
#endif
#ifndef NO_ATTN
#ifdef ATTN_NAIVE
#define ATTN_CALL do { attn_naive_phase(Qb, Kb, Vb, Ob); PROBE_ATTN2 } while (0)
#else
#define ATTN_CALL do { int lane_l = lane; asm volatile("" : "+v"(lane_l)); attn_mfma_phase(Qb, Kb, Vb, Ob, lds, gw, NGW, wave, lane_l); } while (0)
#endif
#else
#define ATTN_CALL
#endif
#ifdef PROBE_SSM
#define PROBE_SSM2 asm volatile("" : "+v"(lane_l)); ssm_naive_phase(ws, layer, lds, wave_l, lane_l);
#else
#define PROBE_SSM2
#endif
#ifdef PROBE_ATTN
#define PROBE_ATTN2 asm volatile("" ::: "memory"); attn_naive_phase(Qb, Kb, Vb, Ob);
#else
#define PROBE_ATTN2
#endif
#ifdef PROBE_F1
#define PROBE_F1_X asm volatile("" ::: "memory"); run_gemm(lds, XB, wgu, MTOK, 2 * DFF, DM, OpSwiglu{RS, HID});
#else
#define PROBE_F1_X
#endif
#ifdef PROBE_F2
#define PROBE_F2_X asm volatile("" ::: "memory"); run_gemm(lds, HID, wgu + W_GU, MTOK, DM, DFF, OpStore{XB, DM, nullptr, 1.0f});
#else
#define PROBE_F2_X
#endif
#ifdef PROBE_RU
#define PROBE_RU_X asm volatile("" ::: "memory"); for (int rep_ = 0; rep_ < 4; ++rep_) { asm volatile("" ::: "memory"); row_update<0, 4>(A.in[I_X], X, XB, RS, nullptr, 0.f, gw, NGW, lane); }
#else
#define PROBE_RU_X
#endif
namespace pg8 {
#define PG8_LAS __attribute__((address_space(3)))
typedef unsigned short bf16_t;
typedef short bf16x8 __attribute__((ext_vector_type(8)));
typedef float f32x4 __attribute__((ext_vector_type(4)));
typedef unsigned u32x4 __attribute__((ext_vector_type(4)));
constexpr int BM = 256, BK = 64, HALF = 128, HTB = HALF * BK * 2  , STAGE_BYTES = 8 * HTB, NXCD = 8, WGM = 8;

__host__ __device__ __forceinline__ int lds_byte(int r, int c) { const int st = (r >> 4) * 2 + (c >> 5), rr = r & 15, cc = c & 31, ob = rr * 64 + cc * 2; return st * 1024 + (ob ^ (((ob >> 9) & 1) << 5)); }
__host__ __device__ __forceinline__ void stage_rc(int b, int& R, int& C) { const int st = b / 1024, sb = b % 1024, swz = sb ^ (((sb >> 9) & 1) << 5); R = (st >> 1) * 16 + swz / 64; C = (st & 1) * 32 + (swz % 64) / 2; }
__host__ __device__ __forceinline__ int perm32(int rho) { const int n = rho >> 4, i = rho & 15; return 8 * (i >> 2) + 4 * n + (i & 3); }

struct Unit { int pm, pn, z; };
struct Gemm { const bf16_t* A; const bf16_t* Bt; int M, N, K; int lda, ldb; size_t sAz, sBz; };

struct StaticOrder {
    int nM, nN, nwg, G, c;
    __host__ __device__ void init(int M, int N, int G_, int c_) { nM = M / BM; nN = N / BM; nwg = nM * nN; G = G_; c = c_; }
    __host__ __device__ bool next(int i, Unit& u) const {
        const long L = (long)i * G + c; if (L >= nwg) return false;
        int wgid = (int)L; { const int q = nwg / NXCD, r = nwg % NXCD, xcd = wgid % NXCD, off = wgid / NXCD; wgid = (xcd < r ? xcd * (q + 1) : r * (q + 1) + (xcd - r) * q) + off; }
        const int nig = WGM * nN, gid = wgid / nig, fm = gid * WGM, gsz = (nM - fm) < WGM ? (nM - fm) : WGM;
        u.pm = fm + ((wgid % nig) % gsz); u.pn = (wgid % nig) / gsz; u.z = 0; return true;
    }
    __device__ __forceinline__ void a_ready(const Unit&) const {}
    __device__ __forceinline__ void done(const Unit&) const {}
    __device__ __forceinline__ int unit_nt(const Unit&, int ntd) const { return ntd; }
};

struct PanelOrder {
    int nM, nN, G, c;
    __host__ __device__ void init(int M, int N, int G_, int c_) { nM = M / BM; nN = N / BM; G = G_; c = c_; }
    __host__ __device__ bool next(int i, Unit& u) const { const int k = i / nN; const long pm = (long)k * G + c; if (pm >= nM) return false; u.pm = (int)pm; u.pn = i - k * nN; u.z = 0; return true; }
    __device__ __forceinline__ void a_ready(const Unit&) const {}
    __device__ __forceinline__ void done(const Unit&) const {}
    __device__ __forceinline__ int unit_nt(const Unit&, int ntd) const { return ntd; }
};
struct PanelOrderN {
    int nM, nN, G, c;
    __host__ __device__ void init(int M, int N, int G_, int c_) { nM = M / BM; nN = N / BM; G = G_; c = c_; }
    __host__ __device__ bool next(int i, Unit& u) const { const int k = i / nM; const long pn = (long)k * G + c; if (pn >= nN) return false; u.pn = (int)pn; u.pm = i - k * nM; u.z = 0; return true; }
    __device__ __forceinline__ void a_ready(const Unit&) const {}
    __device__ __forceinline__ void done(const Unit&) const {}
    __device__ __forceinline__ int unit_nt(const Unit&, int ntd) const { return ntd; }
};
struct BatchOrder {
    int nM, nN, nwg, G, c, tri;
    __host__ __device__ void init(int M, int N, int nz, int G_, int c_, int tri_) { nM = M / BM; nN = N / BM; nwg = nz * nM * nN; G = G_; c = c_; tri = tri_; }
    __host__ __device__ bool next(int i, Unit& u) const { const long L = (long)i * G + c; if (L >= nwg) return false; const int per = nM * nN, l = (int)L; u.z = l / per; const int rem = l % per; u.pm = rem / nN; u.pn = tri ? (rem + i) % nN : rem % nN; return true; }
    __device__ __forceinline__ void a_ready(const Unit&) const {}
    __device__ __forceinline__ void done(const Unit&) const {}
    __device__ __forceinline__ int unit_nt(const Unit& u, int ntd) const { return tri ? 4 * u.pn + 6 : ntd; }
};
typedef float f32x2_c __attribute__((ext_vector_type(2))); typedef _Float16 h16x2_c __attribute__((ext_vector_type(2))); typedef _Float16 h16x8 __attribute__((ext_vector_type(8)));
__device__ __forceinline__ unsigned cvt_pk_bf16(float lo, float hi) { f32x2_c v = {lo, hi}; h16x2_c b = __builtin_convertvector(v, h16x2_c); return __builtin_bit_cast(unsigned, b); }
typedef float f32x2 __attribute__((ext_vector_type(2)));
template <class Epi, class Sched, bool ALIGN_EPI = false, bool SP2 = false>
__device__ __forceinline__ void gemm_phase(PG8_LAS unsigned char* lds, const Gemm g, const Sched& S, const Epi& E) {
    int tid_l = threadIdx.x; asm volatile("" : "+v"(tid_l)); const int tid = tid_l, wid = __builtin_amdgcn_readfirstlane(tid >> 6), lane = tid & 63, wr = wid >> 2, wc = wid & 3, fr = lane & 15, fq = lane >> 4;
    const int K = g.K, ntd = K / BK;
    unsigned voffA[2], voffB[2];
#pragma unroll
    for (int i = 0; i < 2; ++i) { int R, C; stage_rc(tid * 16 + i * 8192, R, C); const int Rb = Epi::PERM ? ((R & ~31) + perm32(R & 31)) : R;
        voffA[i] = (unsigned)(R * g.lda + C) * 2u; voffB[i] = (unsigned)(Rb * g.ldb + C) * 2u; }
    const size_t kstep = (size_t)(BK * 2);
    const size_t hstepA = (size_t)HALF * g.lda * 2, hstepB = (size_t)HALF * g.ldb * 2;
    const size_t tstepA = 2 * hstepA, tstepB = 2 * hstepB;
    const unsigned ldsw = (unsigned)wid * 1024u;
    const int aoff = lds_byte(wr * 64 + fr, fq * 8), boff = lds_byte(wc * 32 + fr, fq * 8);
#define PG8_SA(b, h) (((b) * 2 + (h)) * HTB)
#define PG8_SB(b, h) ((4 + (b) * 2 + (h)) * HTB)
#define PG8_STAGE(bufoff, gbase, voff) do { _Pragma("unroll") for (int _i = 0; _i < 2; ++_i) \
        __builtin_amdgcn_global_load_lds((const unsigned*)((const char*)(gbase) + (voff)[_i]), (PG8_LAS unsigned*)(lds + (bufoff) + ldsw + _i * 8192), 16, 0, 0); } while (0)
#define PG8_LDA(dst, b, h) do { _Pragma("unroll") for (int m = 0; m < 4; ++m) _Pragma("unroll") for (int k = 0; k < 2; ++k) dst[m][k] = *(const PG8_LAS bf16x8*)(lds + PG8_SA(b, h) + aoff + m * 2048 + k * 1024); } while (0)
#define PG8_LDB(dst, b, h) do { _Pragma("unroll") for (int n = 0; n < 2; ++n) _Pragma("unroll") for (int k = 0; k < 2; ++k) dst[n][k] = *(const PG8_LAS bf16x8*)(lds + PG8_SB(b, h) + boff + n * 2048 + k * 1024); } while (0)
#define PG8_MMA(ai, bj, At, Bt) do { __builtin_amdgcn_s_setprio(1); _Pragma("unroll") for (int m = 0; m < 4; ++m) _Pragma("unroll") for (int n = 0; n < 2; ++n) _Pragma("unroll") for (int k = 0; k < 2; ++k) \
        acc[ai][bj][m][n] = __builtin_amdgcn_mfma_f32_16x16x32_f16(__builtin_bit_cast(h16x8, Bt[n][k]), __builtin_bit_cast(h16x8, At[m][k]), acc[ai][bj][m][n], 0, 0, 0); __builtin_amdgcn_s_setprio(0); } while (0)
#define PG8_WAIT_V(n) asm volatile("s_waitcnt vmcnt(" #n ")" ::: "memory")
#define PG8_WAIT_L(n) asm volatile("s_waitcnt lgkmcnt(" #n ")" ::: "memory")
#define PG8_BAR __builtin_amdgcn_s_barrier()
#define PG8_SCHED __builtin_amdgcn_sched_barrier(0)
    Unit cur, nxt; int ui = 0;
    if (!S.next(0, cur)) return;
    int nt = S.unit_nt(cur, ntd);
    f32x4 acc[2][2][4][2];
#pragma unroll
    for (int a = 0; a < 2; ++a)
#pragma unroll
        for (int b = 0; b < 2; ++b)
#pragma unroll
            for (int m = 0; m < 4; ++m)
#pragma unroll
                for (int n = 0; n < 2; ++n) acc[a][b][m][n] = (f32x4){0.f, 0.f, 0.f, 0.f};
    bf16x8 At[4][2], B0[2][2], B1[2][2];
    const char* cA = (const char*)g.A + (size_t)cur.z * g.sAz * 2 + (size_t)cur.pm * tstepA; const char* cB = (const char*)g.Bt + (size_t)cur.z * g.sBz * 2 + (size_t)cur.pn * tstepB;
    S.a_ready(cur);
    if constexpr (SP2) {
        PG8_STAGE(PG8_SB(0, 0), cB, voffB); PG8_STAGE(PG8_SB(0, 1), cB + hstepB, voffB); PG8_STAGE(PG8_SA(0, 0), cA, voffA); PG8_STAGE(PG8_SA(0, 1), cA + hstepA, voffA);
        if (wr == 1) PG8_BAR;
        PG8_WAIT_V(2); PG8_BAR;
        PG8_STAGE(PG8_SB(1, 0), cB + kstep, voffB); PG8_STAGE(PG8_SA(1, 0), cA + kstep, voffA); PG8_STAGE(PG8_SB(1, 1), cB + hstepB + kstep, voffB);
        PG8_WAIT_V(6); PG8_BAR;
    } else {
        PG8_STAGE(PG8_SB(0, 0), cB, voffB); PG8_STAGE(PG8_SA(0, 0), cA, voffA); PG8_STAGE(PG8_SB(0, 1), cB + hstepB, voffB); PG8_STAGE(PG8_SA(0, 1), cA + hstepA, voffA);
        if (wr == 1) PG8_BAR;
        PG8_WAIT_V(4); PG8_BAR;
        PG8_STAGE(PG8_SB(1, 0), cB + kstep, voffB); PG8_STAGE(PG8_SA(1, 0), cA + kstep, voffA); PG8_STAGE(PG8_SB(1, 1), cB + hstepB + kstep, voffB);
        PG8_WAIT_V(6); PG8_BAR;
    }
    for (;;) {
        const bool has_next = S.next(ui + 1, nxt);
        const char* nA = has_next ? (const char*)g.A + (size_t)nxt.z * g.sAz * 2 + (size_t)nxt.pm * tstepA : cA; const char* nB = has_next ? (const char*)g.Bt + (size_t)nxt.z * g.sBz * 2 + (size_t)nxt.pn * tstepB : cB;
        for (int t = 0; t < nt; t += 2) {
            const bool last = (t == nt - 2);
            const char* a1 = cA + (size_t)(t + 1) * kstep;
            const char* a2 = last ? nA : cA + (size_t)(t + 2) * kstep; const char* b2 = last ? nB : cB + (size_t)(t + 2) * kstep;
            const char* a3 = a2 + kstep; const char* b3 = b2 + kstep;
            if (last && has_next) S.a_ready(nxt);
            if constexpr (SP2) {
            PG8_LDB(B0, 0, 0); PG8_LDB(B1, 0, 1); PG8_SCHED; PG8_LDA(At, 0, 0); PG8_STAGE(PG8_SA(1, 1), a1 + hstepA, voffA);
            PG8_WAIT_V(8); PG8_WAIT_L(0); PG8_BAR; PG8_MMA(0, 0, At, B0); PG8_MMA(0, 1, At, B1); PG8_BAR; PG8_SCHED;
            PG8_LDA(At, 0, 1); PG8_STAGE(PG8_SB(0, 0), b2, voffB); PG8_STAGE(PG8_SB(0, 1), b2 + hstepB, voffB); PG8_STAGE(PG8_SA(0, 0), a2, voffA);
            PG8_WAIT_V(8); PG8_WAIT_L(0); PG8_BAR; PG8_MMA(1, 0, At, B0); PG8_MMA(1, 1, At, B1); PG8_BAR; PG8_SCHED;
            PG8_LDB(B0, 1, 0); PG8_LDB(B1, 1, 1); PG8_SCHED; PG8_LDA(At, 1, 0); PG8_STAGE(PG8_SA(0, 1), a2 + hstepA, voffA);
            PG8_WAIT_V(8); PG8_WAIT_L(0); PG8_BAR; PG8_MMA(0, 0, At, B0); PG8_MMA(0, 1, At, B1); PG8_BAR; PG8_SCHED;
            PG8_LDA(At, 1, 1); PG8_STAGE(PG8_SB(1, 0), b3, voffB); PG8_STAGE(PG8_SB(1, 1), b3 + hstepB, voffB); PG8_STAGE(PG8_SA(1, 0), a3, voffA);
            PG8_WAIT_V(8); PG8_WAIT_L(0); PG8_BAR; PG8_MMA(1, 0, At, B0); PG8_MMA(1, 1, At, B1); PG8_BAR; PG8_SCHED;
            } else {
            PG8_LDB(B0, 0, 0); PG8_SCHED; PG8_LDA(At, 0, 0); PG8_STAGE(PG8_SA(1, 1), a1 + hstepA, voffA);
            PG8_WAIT_L(8); PG8_BAR; PG8_WAIT_L(0); PG8_MMA(0, 0, At, B0); PG8_BAR; PG8_SCHED;
            PG8_LDB(B1, 0, 1); PG8_STAGE(PG8_SB(0, 0), b2, voffB);
            PG8_BAR; PG8_WAIT_L(0); PG8_MMA(0, 1, At, B1); PG8_BAR;
            PG8_LDA(At, 0, 1); PG8_STAGE(PG8_SA(0, 0), a2, voffA);
            PG8_BAR; PG8_WAIT_L(0); PG8_MMA(1, 0, At, B0); PG8_BAR; PG8_SCHED;
            PG8_STAGE(PG8_SB(0, 1), b2 + hstepB, voffB);
            PG8_WAIT_V(6); PG8_BAR; PG8_MMA(1, 1, At, B1); PG8_BAR;
            PG8_LDB(B0, 1, 0); PG8_SCHED; PG8_LDA(At, 1, 0); PG8_STAGE(PG8_SA(0, 1), a2 + hstepA, voffA);
            PG8_WAIT_L(8); PG8_BAR; PG8_WAIT_L(0); PG8_MMA(0, 0, At, B0); PG8_BAR; PG8_SCHED;
            PG8_LDB(B1, 1, 1); PG8_STAGE(PG8_SB(1, 0), b3, voffB);
            PG8_BAR; PG8_WAIT_L(0); PG8_MMA(0, 1, At, B1); PG8_BAR;
            PG8_LDA(At, 1, 1); PG8_STAGE(PG8_SA(1, 0), a3, voffA);
            PG8_BAR; PG8_WAIT_L(0); PG8_MMA(1, 0, At, B0); PG8_BAR; PG8_SCHED;
            PG8_STAGE(PG8_SB(1, 1), b3 + hstepB, voffB);
            PG8_WAIT_V(6); PG8_BAR; PG8_MMA(1, 1, At, B1); PG8_BAR;
            }
        }
        if constexpr (ALIGN_EPI) { if (wr == 0) PG8_BAR; }
        if constexpr (!Epi::AFTER_DRAIN) { E(acc, cur, wr, wc, fr, fq); S.done(cur); }
        if (!has_next) break;
#pragma unroll
        for (int a = 0; a < 2; ++a)
#pragma unroll
            for (int b = 0; b < 2; ++b)
#pragma unroll
                for (int m = 0; m < 4; ++m)
#pragma unroll
                    for (int n = 0; n < 2; ++n) acc[a][b][m][n] = (f32x4){0.f, 0.f, 0.f, 0.f};
        cur = nxt; cA = nA; cB = nB; ++ui; nt = S.unit_nt(cur, ntd);
        if constexpr (ALIGN_EPI) { if (wr == 1) PG8_BAR; }
    }
    PG8_WAIT_V(0);
    if constexpr (!ALIGN_EPI) { if (wr == 0) PG8_BAR; }
    PG8_BAR;
    if constexpr (Epi::AFTER_DRAIN) { E.fused(acc, cur, wr, wc, fr, fq, lds, wid, lane); S.done(cur); }
#undef PG8_SA
#undef PG8_SB
#undef PG8_STAGE
#undef PG8_LDA
#undef PG8_LDB
#undef PG8_MMA
#undef PG8_WAIT_V
#undef PG8_WAIT_L
#undef PG8_BAR
#undef PG8_SCHED
}
}
typedef unsigned short bf16_t;
typedef float f32x4 __attribute__((ext_vector_type(4)));
typedef unsigned u32x4 __attribute__((ext_vector_type(4)));
typedef unsigned u32x2 __attribute__((ext_vector_type(2)));
constexpr int DM = 1024, NB = 16, SEQ = 4096, MTOK = NB * SEQ, DFF = 2816, NHEAD = 16, HDIM = 64;
constexpr int SG = 64, SC = 16, SN = 64;
constexpr float NORM_EPS = 1e-6f;
constexpr int UA_LD = 1152;
constexpr size_t UA_G = (size_t)1024 * UA_LD;
constexpr size_t MiB = 1u << 20;
constexpr size_t WS_RS = 1 * MiB;
constexpr size_t WS_XS1 = 158 * MiB;
constexpr int CW_PCNT = 16384;
constexpr size_t WS_W = 2 * MiB;
constexpr size_t W_GU = (size_t)2 * DFF * DM;
constexpr size_t W_DN = (size_t)DM * DFF;
constexpr size_t W_FFN = W_GU + W_DN;
constexpr size_t W_SQ = (size_t)DM * DM;
constexpr size_t WO_FFN = 0, WO_SSM = 8 * W_FFN, WO_QKV = WO_SSM + 6 * W_SQ, WO_Q1 = WO_QKV + 3 * W_SQ, WO_O = WO_Q1 + W_SQ, WO_END = WO_O + 2 * W_SQ;
static_assert(WS_W + WO_END * 2 <= 160 * MiB, "weights fit");
constexpr size_t WS_XB = 160 * MiB;
constexpr size_t WS_HID = 288 * MiB;
constexpr size_t WS_Y = WS_HID, WS_Z = WS_HID + 128 * MiB, WS_O = WS_HID + 128 * MiB;
constexpr size_t WS_K = 640 * MiB, WS_V = 768 * MiB;
constexpr size_t WS_UA = 832 * MiB;
constexpr size_t WS_SP = 976 * MiB, WS_TAB = 980 * MiB, WS_END = 996 * MiB;
constexpr int SP_NG = 0, SP_LRE = 24576, SP_LIM = SP_LRE + 8192, SP_LDT = SP_LIM + 8192, SP_BRE = SP_LDT + 128, SP_BIM = SP_BRE + 131072, SP_CRE = SP_BIM + 131072, SP_CIM = SP_CRE + 131072, SP_SD = SP_CIM + 131072, SP_AR = SP_SD + 2048, SP_AI = SP_AR + 8192, SP_BBR = SP_AI + 8192, SP_BBI = SP_BBR + 131072, SP_END = SP_BBI + 131072;
static_assert((size_t)SP_END * 4 <= 4 * MiB, "SP fits");
constexpr size_t WS_KQT = WS_K, WS_PT = WS_K + 144 * MiB, WS_SLOC = WS_K + 160 * MiB;
constexpr size_t WS_PW = WS_TAB, WS_KD = WS_TAB + 5 * MiB;
static_assert((size_t)2 * 64 * 65 * 64 * 8 <= 5 * MiB && WS_SLOC + (size_t)64 * 1024 * 128 * 4 <= WS_UA && WS_UA + UA_G * 64 * 2 <= WS_SP, "tables fit");
static_assert(WS_HID + (size_t)MTOK * DFF * 2 <= WS_K, "hid fits");

typedef _Float16 h16x2 __attribute__((ext_vector_type(2)));
__device__ __forceinline__ float bf_lo(unsigned w) { return (float)__builtin_bit_cast(h16x2, w)[0]; }
__device__ __forceinline__ float bf_hi(unsigned w) { return (float)__builtin_bit_cast(h16x2, w)[1]; }
__device__ __forceinline__ float wave_sum(float v) {
#pragma unroll
    for (int o = 1; o < 64; o <<= 1) v += __shfl_xor(v, o);
    return v;
}
__device__ __forceinline__ float sigmoidf_(float v) { return __builtin_amdgcn_rcpf(1.0f + __expf(-v)); }
__device__ __forceinline__ float gelu_tanh(float x) { const float v = 1.5957691216057308f * (x + 0.044715f * x * x * x); return x * sigmoidf_(v); }
using pg8::Unit; using pg8::cvt_pk_bf16;
__device__ __forceinline__ float rs4(const float* ssq, int row) { const f32x4 q = *(const f32x4*)(ssq + (size_t)row * 4); return rsqrtf(((q[0] + q[1]) + (q[2] + q[3])) * (1.0f / DM) + NORM_EPS); }

#define LAS __attribute__((address_space(3)))
template <class Op> struct EpiGen {
    static constexpr bool PERM = true, AFTER_DRAIN = false;
    Op op; LAS float* rsl; mutable int cpm;
    __device__ __forceinline__ void operator()(const f32x4 (&acc)[2][2][4][2], const Unit& u, int wr, int wc, int fr, int fq) const {
        const int row0 = u.pm * 256 + wr * 64 + fr, cin = wc * 32 + 8 * fq;
        if constexpr (Op::ROW_RS) {
            if (u.pm != cpm) {
                const int t = (wr * 4 + wc) * 64 + fq * 16 + fr;
                __builtin_amdgcn_s_barrier();
                if (t < 256) rsl[t] = rs4(op.rs, u.pm * 256 + t);
                asm volatile("s_waitcnt lgkmcnt(0)" ::: "memory"); __builtin_amdgcn_s_barrier(); asm volatile("" ::: "memory");
                cpm = u.pm;
            }
        }
        if constexpr (Op::HAS_UNIT) op.unit_init(u, cin);
#pragma unroll
        for (int ai = 0; ai < 2; ++ai) {
            float rsc[4];
#pragma unroll
            for (int m = 0; m < 4; ++m) { if constexpr (Op::ROW_RS) rsc[m] = rsl[wr * 64 + fr + ai * 128 + m * 16] * op.factor(u); else rsc[m] = op.scale(u, row0 + ai * 128 + m * 16); }
            if constexpr (Op::HAS_PRE) {
                u32x4 pa[4], pb[4];
#pragma unroll
                for (int m = 0; m < 4; ++m) op.pre(u, row0 + ai * 128 + m * 16, cin, pa[m], pb[m]);
#pragma unroll
                for (int m = 0; m < 4; ++m) { op.run(u, row0 + ai * 128 + m * 16, cin, rsc[m], acc[ai][0][m][0], acc[ai][0][m][1], acc[ai][1][m][0], acc[ai][1][m][1], pa[m], pb[m]); asm volatile("" ::: "memory"); }
            } else {
#pragma unroll
                for (int m = 0; m < 4; ++m) { op(u, row0 + ai * 128 + m * 16, cin, rsc[m], acc[ai][0][m][0], acc[ai][0][m][1], acc[ai][1][m][0], acc[ai][1][m][1]); asm volatile("" ::: "memory"); }
            }
        }
    }
};
#ifndef ST_WT
#define ST_WT 0
#endif
#ifndef ST_NT
#define ST_NT 0
#endif
__device__ __forceinline__ void st16(void* p, u32x4 v) {
#if ST_WT
    asm volatile("global_store_dwordx4 %0, %1, off sc1\n\ts_nop 1" :: "v"(p), "v"(v) : "memory");
#elif ST_NT
    __builtin_nontemporal_store(v, (u32x4*)p);
#else
    *(u32x4*)p = v;
#endif
}
__device__ __forceinline__ u32x4 pack8(f32x4 a, f32x4 b) { u32x4 w; w.x = cvt_pk_bf16(a[0], a[1]); w.y = cvt_pk_bf16(a[2], a[3]); w.z = cvt_pk_bf16(b[0], b[1]); w.w = cvt_pk_bf16(b[2], b[3]); return w; }
struct OpSwiglu { const float* rs; bf16_t* H;
    static constexpr bool ROW_RS = true, HAS_PRE = false, HAS_UNIT = false;
    __device__ __forceinline__ float factor(const Unit& u) const { return 1.0f; }
    __device__ __forceinline__ float scale(const Unit&, int row) const { return rs4(rs, row); }
    __device__ __forceinline__ void operator()(const Unit& u, int row, int cin, float r, f32x4 g0, f32x4 g1, f32x4 u0, f32x4 u1) const {
        f32x4 h0, h1; const float r2 = r * r, rn = r * -1.4426950408889634f;
#pragma unroll
        for (int i = 0; i < 4; ++i) {
            const float ea = __builtin_amdgcn_exp2f(g0[i] * rn), eb = __builtin_amdgcn_exp2f(g1[i] * rn);
            h0[i] = (g0[i] * u0[i]) * (r2 * __builtin_amdgcn_rcpf(1.0f + ea)); h1[i] = (g1[i] * u1[i]) * (r2 * __builtin_amdgcn_rcpf(1.0f + eb)); }
        st16((H + (size_t)row * DFF + u.pn * 128 + cin), pack8(h0, h1));
    } };
struct OpStore { bf16_t* O; int ldc; const float* rs; float sc;
    static constexpr bool ROW_RS = false, HAS_PRE = false, HAS_UNIT = false;
    __device__ __forceinline__ float scale(const Unit&, int row) const { return rs ? rs4(rs, row) * sc : sc; }
    __device__ __forceinline__ void operator()(const Unit& u, int row, int cin, float r, f32x4 a0, f32x4 a1, f32x4 b0, f32x4 b1) const {
        bf16_t* p = O + (size_t)row * ldc + u.pn * 256 + cin;
        st16(p, pack8(a0 * r, a1 * r)); st16((p + 128), pack8(b0 * r, b1 * r));
    } };
struct OpQKV { bf16_t* Q; unsigned char* ws; const float* rs;
    static constexpr bool ROW_RS = true, HAS_PRE = false, HAS_UNIT = false;
    __device__ __forceinline__ float factor(const Unit& u) const { return ((u.pn >> 2) == 0 ? 0.18033688011112042f : 1.0f); }
    __device__ __forceinline__ float scale(const Unit& u, int row) const { return rs4(rs, row) * ((u.pn >> 2) == 0 ? 0.18033688011112042f : 1.0f); }
    __device__ __forceinline__ void operator()(const Unit& u, int row, int cin, float r, f32x4 a0, f32x4 a1, f32x4 b0, f32x4 b1) const {
        const int t = u.pn >> 2; bf16_t* base = (t == 0) ? Q : (bf16_t*)(ws + WS_K);
        bf16_t* p = base + (size_t)row * DM + (u.pn & 3) * 256 + cin;
        st16(p, pack8(a0 * r, a1 * r)); st16((p + 128), pack8(b0 * r, b1 * r));
    } };
struct OpUA { bf16_t* UA; const float* rs;
    static constexpr bool ROW_RS = true, HAS_PRE = false, HAS_UNIT = false;
    __device__ __forceinline__ float factor(const Unit& u) const { return 1.0f; }
    __device__ __forceinline__ float scale(const Unit&, int row) const { return rs4(rs, row); }
    __device__ __forceinline__ void operator()(const Unit& u, int row, int cin, float r, f32x4 a0, f32x4 a1, f32x4 b0, f32x4 b1) const {
        const int col = u.pn * 256 + cin; const size_t ro = (size_t)(row >> 6) * UA_LD + 128 + (row & 63) * 16 + (col & 15);
        st16((UA + (size_t)(col >> 4) * UA_G + ro), pack8(a0 * r, a1 * r));
        st16((UA + (size_t)((col + 128) >> 4) * UA_G + ro), pack8(b0 * r, b1 * r));
    } };
struct OpGLU { const bf16_t* Y; bf16_t* Z;
    static constexpr bool ROW_RS = false, HAS_PRE = true, HAS_UNIT = false;
    __device__ __forceinline__ float scale(const Unit&, int) const { return 1.0f; }
    __device__ __forceinline__ void pre(const Unit& u, int row, int cin, u32x4& pa, u32x4& pb) const { const size_t off = (size_t)row * DM + u.pn * 256 + cin; pa = *(const u32x4*)(Y + off); pb = *(const u32x4*)(Y + off + 128); }
    __device__ __forceinline__ void run(const Unit& u, int row, int cin, float, f32x4 a0, f32x4 a1, f32x4 b0, f32x4 b1, u32x4 pa, u32x4 pb) const {
        const size_t off = (size_t)row * DM + u.pn * 256 + cin;
#pragma unroll
        for (int hb = 0; hb < 2; ++hb) { const u32x4 y = hb ? pb : pa; const f32x4 c0 = hb ? b0 : a0, c1 = hb ? b1 : a1; f32x4 z0, z1;
            z0[0] = bf_lo(y.x) * sigmoidf_(c0[0]); z0[1] = bf_hi(y.x) * sigmoidf_(c0[1]); z0[2] = bf_lo(y.y) * sigmoidf_(c0[2]); z0[3] = bf_hi(y.y) * sigmoidf_(c0[3]);
            z1[0] = bf_lo(y.z) * sigmoidf_(c1[0]); z1[1] = bf_hi(y.z) * sigmoidf_(c1[1]); z1[2] = bf_lo(y.w) * sigmoidf_(c1[2]); z1[3] = bf_hi(y.w) * sigmoidf_(c1[3]);
            st16((Z + off + hb * 128), pack8(z0, z1)); }
    } };
struct OpVT { bf16_t* VT; const float* rs; mutable f32x4 r0, r1, r2, r3;
    static constexpr bool ROW_RS = false, HAS_PRE = false, HAS_UNIT = true;
    __device__ __forceinline__ float scale(const Unit&, int) const { return 1.0f; }
    __device__ __forceinline__ void unit_init(const Unit& u, int cin) const { const int col = u.pn * 256 + cin;
#pragma unroll
        for (int e = 0; e < 4; ++e) { r0[e] = rs4(rs, col + e); r1[e] = rs4(rs, col + 4 + e); r2[e] = rs4(rs, col + 128 + e); r3[e] = rs4(rs, col + 132 + e); } }
    __device__ __forceinline__ void operator()(const Unit& u, int row, int cin, float, f32x4 a0, f32x4 a1, f32x4 b0, f32x4 b1) const {
        const int col = u.pn * 256 + cin; bf16_t* p = VT + (size_t)row * MTOK + col;
        st16(p, pack8(a0 * r0, a1 * r1)); st16((p + 128), pack8(b0 * r2, b1 * r3));
    } };
struct OpSloc { float* SL;
    static constexpr bool ROW_RS = false, HAS_PRE = false, HAS_UNIT = false;
    __device__ __forceinline__ float scale(const Unit&, int) const { return 1.0f; }
    __device__ __forceinline__ void operator()(const Unit& u, int row, int cin, float, f32x4 a0, f32x4 a1, f32x4 b0, f32x4 b1) const {
        float* p = SL + ((size_t)u.z * 1024 + row) * 128 + cin; *(f32x4*)p = a0; *(f32x4*)(p + 4) = a1; (void)b0; (void)b1;
    } };
struct OpY { const bf16_t* UA; bf16_t* Y; const float* dsk; mutable f32x4 da0, da1, db0, db1;
    static constexpr bool ROW_RS = false, HAS_PRE = true, HAS_UNIT = true;
    __device__ __forceinline__ float scale(const Unit&, int) const { return 1.0f; }
    __device__ __forceinline__ void unit_init(const Unit& u, int cin) const { const int c0 = cin & 15; const float* d = dsk + u.z * 16 + c0; da0 = *(const f32x4*)d; da1 = *(const f32x4*)(d + 4); db0 = da0; db1 = da1; }
    __device__ __forceinline__ void pre(const Unit& u, int row, int cin, u32x4& pa, u32x4& pb) const { const bf16_t* p = UA + (size_t)u.z * UA_G + (size_t)row * UA_LD + 128 + u.pn * 256 + cin; pa = *(const u32x4*)p; pb = *(const u32x4*)(p + 128); }
    __device__ __forceinline__ void run(const Unit& u, int row, int cin, float, f32x4 a0, f32x4 a1, f32x4 b0, f32x4 b1, u32x4 pa, u32x4 pb) const {
#pragma unroll
        for (int hb = 0; hb < 2; ++hb) { const int n = u.pn * 256 + hb * 128 + cin, l = n >> 4, c0 = n & 15; const f32x4 v0 = hb ? b0 : a0, v1 = hb ? b1 : a1; const u32x4 uu = hb ? pb : pa;
            const f32x4 d0 = hb ? db0 : da0, d1 = hb ? db1 : da1; f32x4 y0, y1;
            y0[0] = gelu_tanh(v0[0] + d0[0] * bf_lo(uu.x)); y0[1] = gelu_tanh(v0[1] + d0[1] * bf_hi(uu.x)); y0[2] = gelu_tanh(v0[2] + d0[2] * bf_lo(uu.y)); y0[3] = gelu_tanh(v0[3] + d0[3] * bf_hi(uu.y));
            y1[0] = gelu_tanh(v1[0] + d1[0] * bf_lo(uu.z)); y1[1] = gelu_tanh(v1[1] + d1[1] * bf_hi(uu.z)); y1[2] = gelu_tanh(v1[2] + d1[2] * bf_lo(uu.w)); y1[3] = gelu_tanh(v1[3] + d1[3] * bf_hi(uu.w));
            st16((Y + ((size_t)row * 64 + l) * DM + u.z * 16 + c0), pack8(y0, y1)); }
    } };
struct EpiFused {
    static constexpr bool PERM = true, AFTER_DRAIN = false;
    bf16_t* x16; const float* g; float alpha; float* outf; float* xs1; float* ssq2; unsigned* cnt; unsigned want; LAS unsigned char* xl;
    mutable int cpn;
    __device__ __forceinline__ void operator()(const f32x4 (&acc)[2][2][4][2], const Unit& u, int wr, int wc, int fr, int fq) const {
        LAS float* P = (LAS float*)xl; LAS float* S = P + 1024;
        const int wid = wr * 4 + wc, lane = fq * 16 + fr, prow0 = u.pm * 256;
        const int col0 = u.pn * 256 + wc * 32 + 8 * fq;
        u32x4 xpa[4], xpb[4];
#pragma unroll
        for (int i = 0; i < 4; ++i) { const size_t off = (size_t)(prow0 + wr * 64 + i * 16 + fr) * DM + col0; xpa[i] = *(const u32x4*)(x16 + off); xpb[i] = *(const u32x4*)(x16 + off + 128); }
#pragma unroll
        for (int ai = 0; ai < 2; ++ai)
#pragma unroll
            for (int m = 0; m < 4; ++m) { float sq = 0.f;
#pragma unroll
                for (int bj = 0; bj < 2; ++bj)
#pragma unroll
                    for (int n = 0; n < 2; ++n) { const f32x4 v = acc[ai][bj][m][n]; sq += (v[0] * v[0] + v[1] * v[1]) + (v[2] * v[2] + v[3] * v[3]); }
                sq += __shfl_xor(sq, 16); sq += __shfl_xor(sq, 32);
                if (fq == 0) P[(ai * 128 + wr * 64 + m * 16 + fr) * 4 + wc] = sq; }
        asm volatile("s_waitcnt lgkmcnt(0)" ::: "memory"); __builtin_amdgcn_s_barrier(); asm volatile("" ::: "memory");
        const int row = wid * 32 + (lane & 31);
        unsigned long long* sl64 = (unsigned long long*)xs1 + (size_t)(prow0 + row) * 4;
        if (lane < 32) { const float t = (P[row * 4 + 0] + P[row * 4 + 1]) + (P[row * 4 + 2] + P[row * 4 + 3]);
            __hip_atomic_store(sl64 + u.pn, ((unsigned long long)want << 32) | (unsigned long long)__float_as_uint(t), __ATOMIC_RELAXED, __HIP_MEMORY_SCOPE_AGENT); }
        { unsigned sp = 0u; unsigned long long v0, v1, v2, v3;
            for (;;) {
                v0 = __hip_atomic_load(sl64 + 0, __ATOMIC_RELAXED, __HIP_MEMORY_SCOPE_AGENT); v1 = __hip_atomic_load(sl64 + 1, __ATOMIC_RELAXED, __HIP_MEMORY_SCOPE_AGENT);
                v2 = __hip_atomic_load(sl64 + 2, __ATOMIC_RELAXED, __HIP_MEMORY_SCOPE_AGENT); v3 = __hip_atomic_load(sl64 + 3, __ATOMIC_RELAXED, __HIP_MEMORY_SCOPE_AGENT);
                const bool ok = ((unsigned)(v0 >> 32) == want) && ((unsigned)(v1 >> 32) == want) && ((unsigned)(v2 >> 32) == want) && ((unsigned)(v3 >> 32) == want);
                if (__all(ok) || ++sp > (1u << 20)) break;
                __builtin_amdgcn_s_sleep(1);
            }
            if (lane < 32) { const float t0 = __uint_as_float((unsigned)v0), t1 = __uint_as_float((unsigned)v1), t2 = __uint_as_float((unsigned)v2), t3 = __uint_as_float((unsigned)v3);
                S[row] = alpha * rsqrtf(((t0 + t1) + (t2 + t3)) * (1.0f / DM) + NORM_EPS); } }
        asm volatile("s_waitcnt vmcnt(0) lgkmcnt(0)" ::: "memory"); __builtin_amdgcn_s_barrier(); asm volatile("" ::: "memory");
        LAS float* gl = (LAS float*)(xl + 5632);
        if (u.pn != cpn) { const int t_ = wid * 64 + lane; __builtin_amdgcn_s_barrier(); if (t_ < 256) gl[t_] = g[u.pn * 256 + t_]; asm volatile("s_waitcnt vmcnt(0) lgkmcnt(0)" ::: "memory"); __builtin_amdgcn_s_barrier(); asm volatile("" ::: "memory"); cpn = u.pn; }
        const f32x4 ga0 = *(const LAS f32x4*)(gl + wc * 32 + 8 * fq), ga1 = *(const LAS f32x4*)(gl + wc * 32 + 8 * fq + 4), gb0 = *(const LAS f32x4*)(gl + 128 + wc * 32 + 8 * fq), gb1 = *(const LAS f32x4*)(gl + 128 + wc * 32 + 8 * fq + 4);
#pragma unroll
        for (int ai = 0; ai < 2; ++ai) {
            if (ai == 1) {
#pragma unroll
                for (int i = 0; i < 4; ++i) { const size_t off = (size_t)(prow0 + 128 + wr * 64 + i * 16 + fr) * DM + col0; xpa[i] = *(const u32x4*)(x16 + off); xpb[i] = *(const u32x4*)(x16 + off + 128); }
            }
#pragma unroll
            for (int m = 0; m < 4; ++m) { const int rl = ai * 128 + wr * 64 + m * 16 + fr; const float r = S[rl]; const size_t off = (size_t)(prow0 + rl) * DM + col0;
                const u32x4 xa = xpa[m], xb = xpb[m];
                f32x4 a0 = {bf_lo(xa.x), bf_hi(xa.x), bf_lo(xa.y), bf_hi(xa.y)}, a1 = {bf_lo(xa.z), bf_hi(xa.z), bf_lo(xa.w), bf_hi(xa.w)}, b0 = {bf_lo(xb.x), bf_hi(xb.x), bf_lo(xb.y), bf_hi(xb.y)}, b1 = {bf_lo(xb.z), bf_hi(xb.z), bf_lo(xb.w), bf_hi(xb.w)};
                a0 += acc[ai][0][m][0] * r * ga0; a1 += acc[ai][0][m][1] * r * ga1; b0 += acc[ai][1][m][0] * r * gb0; b1 += acc[ai][1][m][1] * r * gb1;
                float sq = ((a0[0] * a0[0] + a0[1] * a0[1]) + (a0[2] * a0[2] + a0[3] * a0[3])) + ((a1[0] * a1[0] + a1[1] * a1[1]) + (a1[2] * a1[2] + a1[3] * a1[3]));
                sq += ((b0[0] * b0[0] + b0[1] * b0[1]) + (b0[2] * b0[2] + b0[3] * b0[3])) + ((b1[0] * b1[0] + b1[1] * b1[1]) + (b1[2] * b1[2] + b1[3] * b1[3]));
                if (outf) { float* o = outf + off; *(f32x4*)o = a0; *(f32x4*)(o + 4) = a1; *(f32x4*)(o + 128) = b0; *(f32x4*)(o + 132) = b1; }
                else { st16(x16 + off, pack8(a0, a1)); st16(x16 + off + 128, pack8(b0, b1)); }
                sq += __shfl_xor(sq, 16); sq += __shfl_xor(sq, 32);
                if (fq == 0) P[rl * 4 + wc] = sq;
                asm volatile("" ::: "memory"); }
        }
        asm volatile("s_waitcnt lgkmcnt(0)" ::: "memory"); __builtin_amdgcn_s_barrier(); asm volatile("" ::: "memory");
        if (lane < 32) ssq2[(size_t)(prow0 + row) * 4 + u.pn] = (P[row * 4 + 0] + P[row * 4 + 1]) + (P[row * 4 + 2] + P[row * 4 + 3]);
        asm volatile("s_waitcnt lgkmcnt(0)" ::: "memory"); __builtin_amdgcn_s_barrier(); asm volatile("" ::: "memory");
    }
};
constexpr int NWAVES = 8, LDS_BYTES = 147456, RING_BYTES = 131072;
struct Args { const float* in[21]; float* out; unsigned char* ws; int ph_lo, ph_hi; };
enum { I_X = 0, I_NG, I_WG, I_WU, I_WD, I_SWIN, I_LRE, I_LIM, I_LDT, I_BRE, I_BIM, I_CRE, I_CIM, I_SD, I_SWGLU, I_SWOUT, I_KVG, I_WK, I_WV, I_WQ, I_WO };

__device__ __forceinline__ unsigned pk2(float lo, float hi) { return cvt_pk_bf16(lo, hi); }
#define TR_LOAD(V, G, ITEM) do { const int kb_ = (ITEM) / nblk_, nb_ = (ITEM) % nblk_; \
    _Pragma("unroll") for (int i = 0; i < 8; ++i) { const int kk = 8 * i + (lane >> 3); V[i] = *(const f32x4*)(W + (size_t)(64 * kb_ + kk) * N + 32 * nb_ + (lane & 7) * 4); G[i] = gain ? gain[64 * kb_ + kk] : 1.0f; } } while (0)
#define TR_STORE(V, G, ITEM) do { const int kb_ = (ITEM) / nblk_, nb_ = (ITEM) % nblk_, k0 = 64 * kb_, n0 = 32 * nb_; \
    _Pragma("unroll") for (int i = 0; i < 8; ++i) { const int kk = 8 * i + (lane >> 3), nn = (lane & 7) * 4; const f32x4 v = V[i] * G[i]; \
        scr[kk * 33 + nn] = v[0]; scr[kk * 33 + nn + 1] = v[1]; scr[kk * 33 + nn + 2] = v[2]; scr[kk * 33 + nn + 3] = v[3]; } \
    asm volatile("s_waitcnt lgkmcnt(0)" ::: "memory"); \
    const int c = lane & 7; const int r0 = mode == 0 ? row_off + n0 : (256 * (n0 >> 7) + (n0 & 127) + (mode == 2 ? 128 : 0)); \
    _Pragma("unroll") for (int j = 0; j < 4; ++j) { const int n = (lane >> 3) + 8 * j; const LAS float* s = scr + (8 * c) * 33 + n; \
        u32x4 o; o.x = pk2(s[0 * 33], s[1 * 33]); o.y = pk2(s[2 * 33], s[3 * 33]); o.z = pk2(s[4 * 33], s[5 * 33]); o.w = pk2(s[6 * 33], s[7 * 33]); \
        *(u32x4*)(WT + (size_t)(r0 + n) * K + k0 + 8 * c) = o; } \
    asm volatile("s_waitcnt lgkmcnt(0)" ::: "memory"); } while (0)
__device__ __forceinline__ int conv_matrix(const float* W, int K, int N, const float* gain, int mode, bf16_t* WT, int row_off, LAS float* scr, int cstart, int NGW, int lane) {
    const int n_items = (K / 64) * (N / 32), nblk_ = N / 32; int it = cstart;
    f32x4 va[8], vb[8]; float ga[8], gb[8];
    if (it < n_items) TR_LOAD(va, ga, it);
    while (it < n_items) {
        if (it + NGW < n_items) TR_LOAD(vb, gb, it + NGW);
        TR_STORE(va, ga, it); it += NGW;
        if (it >= n_items) break;
        if (it + NGW < n_items) TR_LOAD(va, ga, it + NGW);
        TR_STORE(vb, gb, it); it += NGW;
    }
    return it - n_items;
}
#undef TR_LOAD
#undef TR_STORE
#define CONV(Wp, K_, N_, gain_, mode_, dst_, roff_) cstart = conv_matrix((Wp), (K_), (N_), (gain_), (mode_), (dst_), (roff_), scr, cstart, NGW, lane)

template <int MODE, int RR> __device__ __forceinline__ void row_update(const float* xin, bf16_t* x16, const bf16_t* T, float* rs, const float* g, float alpha, float* outf, int gw, int NGW, int lane) {
    f32x4 gv[4];
    if (MODE == 1) {
#pragma unroll
        for (int h = 0; h < 2; ++h) { gv[2 * h] = *(const f32x4*)(g + h * 512 + lane * 8); gv[2 * h + 1] = *(const f32x4*)(g + h * 512 + lane * 8 + 4); }
    }
    const int nblk_ = NGW / NWAVES, blk_ = gw / NWAVES; const bool g256_ = (nblk_ == 256);
    for (int it = 0; it < (MTOK / 256 + nblk_ - 1) / nblk_ * (32 / RR); ++it) {
        const int k_ = it / (32 / RR); const int pmi = g256_ ? ((blk_ & 7) * 32 + (blk_ >> 3)) : (blk_ + k_ * nblk_); if (pmi >= MTOK / 256) break;
        const int base = pmi * 256 + (gw % NWAVES) * 32 + (it % (32 / RR)) * RR;
        f32x4 xv[RR][4]; u32x4 tw[RR][2]; float red[RR];
#pragma unroll
        for (int rr = 0; rr < RR; ++rr) { const bf16_t* br = x16 + (size_t)(base + rr) * DM;
#pragma unroll
            for (int h = 0; h < 2; ++h) {
                if (MODE == 0) { const float* xr = xin + (size_t)(base + rr) * DM; xv[rr][2 * h] = *(const f32x4*)(xr + h * 512 + lane * 8); xv[rr][2 * h + 1] = *(const f32x4*)(xr + h * 512 + lane * 8 + 4); }
                else { const u32x4 xw = *(const u32x4*)(br + h * 512 + lane * 8); tw[rr][h] = *(const u32x4*)(T + (size_t)(base + rr) * DM + h * 512 + lane * 8);
                    xv[rr][2 * h] = (f32x4){bf_lo(xw.x), bf_hi(xw.x), bf_lo(xw.y), bf_hi(xw.y)}; xv[rr][2 * h + 1] = (f32x4){bf_lo(xw.z), bf_hi(xw.z), bf_lo(xw.w), bf_hi(xw.w)}; } } }
        if (MODE == 1) {
            float tv[RR][16];
#pragma unroll
            for (int rr = 0; rr < RR; ++rr) { float ss = 0.f;
#pragma unroll
                for (int h = 0; h < 2; ++h) { const u32x4 t = tw[rr][h];
                    tv[rr][8 * h + 0] = bf_lo(t.x); tv[rr][8 * h + 1] = bf_hi(t.x); tv[rr][8 * h + 2] = bf_lo(t.y); tv[rr][8 * h + 3] = bf_hi(t.y); tv[rr][8 * h + 4] = bf_lo(t.z); tv[rr][8 * h + 5] = bf_hi(t.z); tv[rr][8 * h + 6] = bf_lo(t.w); tv[rr][8 * h + 7] = bf_hi(t.w); }
#pragma unroll
                for (int i = 0; i < 16; ++i) ss += tv[rr][i] * tv[rr][i];
                red[rr] = ss; }
#pragma unroll
            for (int o = 1; o < 64; o <<= 1) {
#pragma unroll
                for (int rr = 0; rr < RR; ++rr) red[rr] += __shfl_xor(red[rr], o); }
#pragma unroll
            for (int rr = 0; rr < RR; ++rr) { const float r = alpha * rsqrtf(red[rr] * (1.0f / DM) + NORM_EPS);
#pragma unroll
                for (int h = 0; h < 2; ++h)
#pragma unroll
                    for (int i = 0; i < 4; ++i) { xv[rr][2 * h][i] += tv[rr][8 * h + i] * r * gv[2 * h][i]; xv[rr][2 * h + 1][i] += tv[rr][8 * h + 4 + i] * r * gv[2 * h + 1][i]; } }
        }
        if (MODE == 1 && outf != nullptr) {
#pragma unroll
            for (int rr = 0; rr < RR; ++rr) { float* xo = outf + (size_t)(base + rr) * DM;
#pragma unroll
                for (int h = 0; h < 2; ++h) { *(f32x4*)(xo + h * 512 + lane * 8) = xv[rr][2 * h]; *(f32x4*)(xo + h * 512 + lane * 8 + 4) = xv[rr][2 * h + 1]; } }
            continue;
        }
#pragma unroll
        for (int rr = 0; rr < RR; ++rr) { float s2 = 0.f;
#pragma unroll
            for (int j = 0; j < 4; ++j) s2 += (xv[rr][j][0] * xv[rr][j][0] + xv[rr][j][1] * xv[rr][j][1]) + (xv[rr][j][2] * xv[rr][j][2] + xv[rr][j][3] * xv[rr][j][3]);
            red[rr] = s2; }
#pragma unroll
        for (int o = 1; o < 64; o <<= 1) {
#pragma unroll
            for (int rr = 0; rr < RR; ++rr) red[rr] += __shfl_xor(red[rr], o); }
#pragma unroll
        for (int rr = 0; rr < RR; ++rr) {
            if (lane == 0) { if (MODE == 0) *(f32x4*)(rs + (size_t)(base + rr) * 4) = (f32x4){red[rr], 0.f, 0.f, 0.f}; else rs[base + rr] = rsqrtf(red[rr] * (1.0f / DM) + NORM_EPS); }
            bf16_t* br = x16 + (size_t)(base + rr) * DM;
#pragma unroll
            for (int h = 0; h < 2; ++h) st16((br + h * 512 + lane * 8), pack8(xv[rr][2 * h], xv[rr][2 * h + 1]));
        }
    }
}

__device__ __forceinline__ void sincos2pi(double r, double& s, double& c) {
    const double x = r * 6.283185307179586476925, x2 = x * x;
    double ts = 1.0 / 121645100408832000.0 * -1.0;
    double ps = -1.0 / 25852016738884976640000.0;
    ps = ps * x2 + 1.0 / 51090942171709440000.0;
    ps = ps * x2 - 1.0 / 121645100408832000.0;
    ps = ps * x2 + 1.0 / 355687428096000.0;
    ps = ps * x2 - 1.0 / 1307674368000.0;
    ps = ps * x2 + 1.0 / 6227020800.0;
    ps = ps * x2 - 1.0 / 39916800.0;
    ps = ps * x2 + 1.0 / 362880.0;
    ps = ps * x2 - 1.0 / 5040.0;
    ps = ps * x2 + 1.0 / 120.0;
    ps = ps * x2 - 1.0 / 6.0;
    ps = ps * x2 + 1.0;
    s = ps * x; (void)ts;
    double pc = 1.0 / 620448401733239439360000.0;
    pc = pc * x2 - 1.0 / 1124000727777607680000.0;
    pc = pc * x2 + 1.0 / 2432902008176640000.0;
    pc = pc * x2 - 1.0 / 6402373705728000.0;
    pc = pc * x2 + 1.0 / 20922789888000.0;
    pc = pc * x2 - 1.0 / 87178291200.0;
    pc = pc * x2 + 1.0 / 479001600.0;
    pc = pc * x2 - 1.0 / 3628800.0;
    pc = pc * x2 + 1.0 / 40320.0;
    pc = pc * x2 - 1.0 / 720.0;
    pc = pc * x2 + 1.0 / 24.0;
    pc = pc * x2 - 0.5;
    c = pc * x2 + 1.0;
}
__device__ __forceinline__ double exp_small(double v) {
    double p = 1.0 / 87178291200.0;
    p = p * v + 1.0 / 6227020800.0; p = p * v + 1.0 / 479001600.0; p = p * v + 1.0 / 39916800.0; p = p * v + 1.0 / 3628800.0; p = p * v + 1.0 / 362880.0; p = p * v + 1.0 / 40320.0;
    p = p * v + 1.0 / 5040.0; p = p * v + 1.0 / 720.0; p = p * v + 1.0 / 120.0; p = p * v + 1.0 / 24.0; p = p * v + 1.0 / 6.0; p = p * v + 0.5; p = p * v + 1.0; p = p * v + 1.0; return p;
}
__device__ __forceinline__ double exp_neg(double v) { double e = exp_small(v * 0.0625); e *= e; e *= e; e *= e; e *= e; return e; }
__device__ __forceinline__ void cpow_lam(double lrdt, double lidt, int d, double& re, double& im) {
    double m = (double)d * lrdt;
    double mag = 1.0;
    while (m < -8.0) { mag *= 3.3546262790251185e-4; m += 8.0; }
    while (m > 0.5) { mag *= 1.6487212707001282; m -= 0.5; }
    mag *= (m <= 0.0) ? exp_neg(m) : exp_small(m);
    double rev = (double)d * lidt * 0.15915494309189533577; rev -= __builtin_rint(rev);
    double s, c; sincos2pi(rev, s, c); re = mag * c; im = mag * s;
}

__device__ __forceinline__ void ssm_naive_phase(unsigned char* ws, int a, LAS unsigned char* lds, int wave, int lane) {
    if (wave >= 4) return;
    const float* sp = (const float*)(ws + WS_SP);
    const bf16_t* UA = (const bf16_t*)(ws + WS_UA); bf16_t* Y = (bf16_t*)(ws + WS_Y);
    LAS float* ul = (LAS float*)(lds + wave * 8192); LAS float* yl = ul + 1024;
    for (int task = blockIdx.x * 4 + wave; task < NB * SG; task += gridDim.x * 4) {
        const int b = task >> 6, g = task & 63, n = lane;
        float bbr[16], bbi[16], cr[16], ci[16];
        const int agn = (a * SG + g) * SN + n;
#pragma unroll
        for (int c4 = 0; c4 < 4; ++c4) { const f32x4 r4 = *(const f32x4*)(sp + SP_BBR + agn * SC + c4 * 4), i4 = *(const f32x4*)(sp + SP_BBI + agn * SC + c4 * 4);
#pragma unroll
            for (int e = 0; e < 4; ++e) { bbr[c4 * 4 + e] = r4[e]; bbi[c4 * 4 + e] = i4[e]; } }
#pragma unroll
        for (int c = 0; c < 16; ++c) { cr[c] = sp[SP_CRE + ((a * SG + g) * SC + c) * SN + n]; ci[c] = sp[SP_CIM + ((a * SG + g) * SC + c) * SN + n]; }
        const float ar = sp[SP_AR + agn], ai = sp[SP_AI + agn];
        const int cl = (lane >> 2) & 15; const float dl = sp[SP_SD + (a * SG + g) * SC + cl];
        float sr = 0.f, si = 0.f;
        for (int k = 0; k < 64; ++k) {
            { const bf16_t* src = UA + (size_t)g * UA_G + (size_t)(b * 64 + k) * UA_LD + 128 + lane * 16;
              const u32x4 p0 = *(const u32x4*)src, p1 = *(const u32x4*)(src + 8);
              LAS f32x4* d = (LAS f32x4*)(ul + lane * 16);
              d[0] = (f32x4){bf_lo(p0.x), bf_hi(p0.x), bf_lo(p0.y), bf_hi(p0.y)}; d[1] = (f32x4){bf_lo(p0.z), bf_hi(p0.z), bf_lo(p0.w), bf_hi(p0.w)};
              d[2] = (f32x4){bf_lo(p1.x), bf_hi(p1.x), bf_lo(p1.y), bf_hi(p1.y)}; d[3] = (f32x4){bf_lo(p1.z), bf_hi(p1.z), bf_lo(p1.w), bf_hi(p1.w)}; }
            asm volatile("s_waitcnt lgkmcnt(0)" ::: "memory");
#pragma unroll 2
            for (int j = 0; j < 64; ++j) {
                const LAS f32x4* up = (const LAS f32x4*)(ul + j * 16); const f32x4 u0 = up[0], u1 = up[1], u2 = up[2], u3 = up[3];
                const float uu[16] = {u0[0], u0[1], u0[2], u0[3], u1[0], u1[1], u1[2], u1[3], u2[0], u2[1], u2[2], u2[3], u3[0], u3[1], u3[2], u3[3]};
                float bur = 0.f, bui = 0.f;
#pragma unroll
                for (int c = 0; c < 16; ++c) { bur += bbr[c] * uu[c]; bui += bbi[c] * uu[c]; }
                const float nsr = ar * sr - ai * si + bur, nsi = ar * si + ai * sr + bui; sr = nsr; si = nsi;
                float v[16];
#pragma unroll
                for (int c = 0; c < 16; ++c) v[c] = sr * cr[c] - si * ci[c];
                float w8[8], w4[4], w2[2], w1;
                { const bool h = (lane & 32) != 0;
#pragma unroll
                  for (int i = 0; i < 8; ++i) { const float send = h ? v[i] : v[i + 8], keep = h ? v[i + 8] : v[i]; w8[i] = keep + __shfl_xor(send, 32); } }
                { const bool h = (lane & 16) != 0;
#pragma unroll
                  for (int i = 0; i < 4; ++i) { const float send = h ? w8[i] : w8[i + 4], keep = h ? w8[i + 4] : w8[i]; w4[i] = keep + __shfl_xor(send, 16); } }
                { const bool h = (lane & 8) != 0;
#pragma unroll
                  for (int i = 0; i < 2; ++i) { const float send = h ? w4[i] : w4[i + 2], keep = h ? w4[i + 2] : w4[i]; w2[i] = keep + __shfl_xor(send, 8); } }
                { const bool h = (lane & 4) != 0; const float send = h ? w2[0] : w2[1], keep = h ? w2[1] : w2[0]; w1 = keep + __shfl_xor(send, 4); }
                w1 += __shfl_xor(w1, 2); w1 += __shfl_xor(w1, 1);
                const float yv = gelu_tanh(w1 + dl * ul[j * 16 + cl]);
                if ((lane & 3) == 0) yl[j * 16 + cl] = yv;
            }
            asm volatile("s_waitcnt lgkmcnt(0)" ::: "memory");
            { const LAS f32x4* yp = (const LAS f32x4*)(yl + lane * 16); const f32x4 y0 = yp[0], y1 = yp[1], y2 = yp[2], y3 = yp[3];
              bf16_t* dst = Y + (size_t)(b * SEQ + k * 64 + lane) * DM + g * 16;
              st16(dst, pack8(y0, y1)); st16((dst + 8), pack8(y2, y3)); }
            asm volatile("s_waitcnt lgkmcnt(0)" ::: "memory");
        }
    }
}

__device__ __forceinline__ void attn_naive_phase(const bf16_t* Q, const bf16_t* K, const bf16_t* V, bf16_t* O) {
    for (int unit = blockIdx.x; unit < NB * NHEAD * (SEQ / 512); unit += gridDim.x) {
        const int bh = unit >> 3, tc = unit & 7, b = bh >> 4, h = bh & 15, t = tc * 512 + (int)threadIdx.x;
        const size_t row = (size_t)b * SEQ + t;
        float q[64], o[64];
        { const u32x4* qp = (const u32x4*)(Q + row * DM + h * 64);
#pragma unroll
          for (int i = 0; i < 8; ++i) { const u32x4 w = qp[i]; q[8 * i] = bf_lo(w.x); q[8 * i + 1] = bf_hi(w.x); q[8 * i + 2] = bf_lo(w.y); q[8 * i + 3] = bf_hi(w.y); q[8 * i + 4] = bf_lo(w.z); q[8 * i + 5] = bf_hi(w.z); q[8 * i + 6] = bf_lo(w.w); q[8 * i + 7] = bf_hi(w.w); } }
#pragma unroll
        for (int i = 0; i < 64; ++i) o[i] = 0.f;
        float R = 0.f;
        for (int s = t - 1; s >= 0; --s) {
            const u32x4* kp = (const u32x4*)(K + ((size_t)b * SEQ + s) * DM + h * 64);
            float z = 0.f;
#pragma unroll
            for (int i = 0; i < 8; ++i) { const u32x4 w = kp[i]; z += q[8 * i] * bf_lo(w.x) + q[8 * i + 1] * bf_hi(w.x) + q[8 * i + 2] * bf_lo(w.y) + q[8 * i + 3] * bf_hi(w.y) + q[8 * i + 4] * bf_lo(w.z) + q[8 * i + 5] * bf_hi(w.z) + q[8 * i + 6] * bf_lo(w.w) + q[8 * i + 7] * bf_hi(w.w); }
            const float sp = fmaxf(z, 0.f) + __logf(1.0f + __expf(-fabsf(z)));
            R -= sp;
            const float w = __expf(z + R);
            { const bf16_t* vt = V + (size_t)(h * 64) * MTOK + (size_t)b * SEQ + s;
#pragma unroll
              for (int i = 0; i < 64; ++i) o[i] += w * bf_lo((unsigned)vt[(size_t)i * MTOK]); }
            if (R < -40.f) break;
        }
        u32x4* op = (u32x4*)(O + row * DM + h * 64);
#pragma unroll
        for (int i = 0; i < 8; ++i) { u32x4 w; w.x = cvt_pk_bf16(o[8 * i], o[8 * i + 1]); w.y = cvt_pk_bf16(o[8 * i + 2], o[8 * i + 3]); w.z = cvt_pk_bf16(o[8 * i + 4], o[8 * i + 5]); w.w = cvt_pk_bf16(o[8 * i + 6], o[8 * i + 7]); op[i] = w; }
    }
}

typedef short bf16x8 __attribute__((ext_vector_type(8)));
typedef float f32x16 __attribute__((ext_vector_type(16)));
template <bool DIAG> __device__ __forceinline__ void sb_tile(const f32x16& st, float& R, int r32, int hi, u32x4& p0, u32x4& p1) {
    float L[16], gs[4], og[4], w[16];
#pragma unroll
    for (int r = 0; r < 16; ++r) { const float z = st[r]; const float lg = __builtin_amdgcn_logf(1.0f + __builtin_amdgcn_exp2f(-fabsf(z))); const float v = -(fmaxf(z, 0.f) + lg);
        if (DIAG) { const int kap = (r & 3) + 8 * (r >> 2) + 4 * hi; L[r] = (kap >= r32) ? 0.f : v; } else L[r] = v; }
#pragma unroll
    for (int g = 0; g < 4; ++g) { gs[g] = (L[4 * g] + L[4 * g + 1]) + (L[4 * g + 2] + L[4 * g + 3]); og[g] = __shfl_xor(gs[g], 32); }
    float above = 0.f;
#pragma unroll
    for (int g = 3; g >= 0; --g) {
        float run = R + above + (hi == 0 ? og[g] : 0.f);
#pragma unroll
        for (int e = 3; e >= 0; --e) { const int r = 4 * g + e; run += L[r]; const float wv = __builtin_amdgcn_exp2f(st[r] + run);
            if (DIAG) { const int kap = e + 8 * g + 4 * hi; w[r] = (kap >= r32) ? 0.f : wv; } else w[r] = wv; }
        above += gs[g] + og[g];
    }
    R += above;
    p0.x = cvt_pk_bf16(w[0], w[1]); p0.y = cvt_pk_bf16(w[2], w[3]); p0.z = cvt_pk_bf16(w[4], w[5]); p0.w = cvt_pk_bf16(w[6], w[7]);
    p1.x = cvt_pk_bf16(w[8], w[9]); p1.y = cvt_pk_bf16(w[10], w[11]); p1.z = cvt_pk_bf16(w[12], w[13]); p1.w = cvt_pk_bf16(w[14], w[15]);
}
__device__ __forceinline__ void attn_mfma_phase(const bf16_t* Q, const bf16_t* K, const bf16_t* VT, bf16_t* O, LAS unsigned char* lds, int gw, int NGW, int wave, int lane) {
    const int r32 = lane & 31, hi = lane >> 5;
    LAS bf16_t* stg = (LAS bf16_t*)(lds + wave * 16384);
    LAS unsigned char* kst = lds + wave * 16384 + 4096; LAS unsigned char* vst = kst + 32 * 144;
#define ATT_LOAD(KR, VR, RB, HH, S0) do { \
        _Pragma("unroll") for (int i = 0; i < 4; ++i) { KR[i] = *(const u32x4*)(K + ((RB) + (S0) + 8 * i + (lane >> 3)) * DM + (HH) * 64 + (lane & 7) * 8); \
            VR[i] = *(const u32x4*)(VT + (size_t)((HH) * 64 + 16 * i + (lane >> 2)) * MTOK + (RB) + (S0) + (lane & 3) * 8); } } while (0)
#define ATT_LOADQ(QF, RB, HH, T0) do { _Pragma("unroll") for (int d0 = 0; d0 < 4; ++d0) QF[d0] = *(const bf16x8*)(Q + ((RB) + (T0) + r32) * DM + (HH) * 64 + d0 * 16 + hi * 8); } while (0)
    const int NUNIT = NB * NHEAD * (SEQ / 32);
    bf16x8 qn[4]; u32x4 krn[4], vrn[4];
    if (gw < NUNIT) { const int bh_ = gw >> 7, t0_ = (gw & 127) * 32; const size_t rb_ = (size_t)(bh_ >> 4) * SEQ; ATT_LOADQ(qn, rb_, bh_ & 15, t0_); ATT_LOAD(krn, vrn, rb_, bh_ & 15, t0_); }
    for (int unit = gw; unit < NUNIT; unit += NGW) {
        const int qb = unit & 127, bh = unit >> 7, b = bh >> 4, h = bh & 15, t0 = qb * 32;
        const size_t rowb = (size_t)b * SEQ;
        bf16x8 qf[4]; u32x4 kr[4], vr[4];
#pragma unroll
        for (int i = 0; i < 4; ++i) { qf[i] = qn[i]; kr[i] = krn[i]; vr[i] = vrn[i]; }
        f32x16 o0, o1;
#pragma unroll
        for (int r = 0; r < 16; ++r) { o0[r] = 0.f; o1[r] = 0.f; }
        float R = 0.f;
        bool nxt_pending = (unit + NGW < NUNIT);
        for (int s0 = t0; s0 >= 0; s0 -= 32) {
            const bool more = s0 >= 32;
#pragma unroll
            for (int i = 0; i < 4; ++i) { *(LAS u32x4*)(kst + (8 * i + (lane >> 3)) * 144 + (lane & 7) * 16) = kr[i]; *(LAS u32x4*)(vst + (16 * i + (lane >> 2)) * 80 + (lane & 3) * 16) = vr[i]; }
            asm volatile("s_waitcnt lgkmcnt(0)" ::: "memory");
            if (more) ATT_LOAD(kr, vr, rowb, h, s0 - 32);
            if (nxt_pending) { nxt_pending = false; const int un_ = unit + NGW, bh_ = un_ >> 7, t0_ = (un_ & 127) * 32; const size_t rb_ = (size_t)(bh_ >> 4) * SEQ; ATT_LOADQ(qn, rb_, bh_ & 15, t0_); ATT_LOAD(krn, vrn, rb_, bh_ & 15, t0_); }
            bf16x8 kf[4], vf[2][2];
#pragma unroll
            for (int d0 = 0; d0 < 4; ++d0) kf[d0] = *(const LAS bf16x8*)(kst + r32 * 144 + d0 * 32 + hi * 16);
#pragma unroll
            for (int db = 0; db < 2; ++db)
#pragma unroll
                for (int ks = 0; ks < 2; ++ks) { const u32x2 lo_ = *(const LAS u32x2*)(vst + (r32 + 32 * db) * 80 + 32 * ks + 8 * hi), h8_ = *(const LAS u32x2*)(vst + (r32 + 32 * db) * 80 + 32 * ks + 8 * hi + 16);
                    const u32x4 v_ = {lo_.x, lo_.y, h8_.x, h8_.y}; vf[db][ks] = __builtin_bit_cast(bf16x8, v_); }
            asm volatile("s_waitcnt lgkmcnt(0)" ::: "memory");
            f32x16 st;
#pragma unroll
            for (int r = 0; r < 16; ++r) st[r] = 0.f;
#pragma unroll
            for (int d0 = 0; d0 < 4; ++d0) st = __builtin_amdgcn_mfma_f32_32x32x16_f16(__builtin_bit_cast(pg8::h16x8, kf[d0]), __builtin_bit_cast(pg8::h16x8, qf[d0]), st, 0, 0, 0);
            u32x4 p0, p1;
            if (s0 == t0) sb_tile<true>(st, R, r32, hi, p0, p1); else sb_tile<false>(st, R, r32, hi, p0, p1);
            const bf16x8 pa0 = __builtin_bit_cast(bf16x8, p0), pa1 = __builtin_bit_cast(bf16x8, p1);
            o0 = __builtin_amdgcn_mfma_f32_32x32x16_f16(__builtin_bit_cast(pg8::h16x8, pa0), __builtin_bit_cast(pg8::h16x8, vf[0][0]), o0, 0, 0, 0); o0 = __builtin_amdgcn_mfma_f32_32x32x16_f16(__builtin_bit_cast(pg8::h16x8, pa1), __builtin_bit_cast(pg8::h16x8, vf[0][1]), o0, 0, 0, 0);
            o1 = __builtin_amdgcn_mfma_f32_32x32x16_f16(__builtin_bit_cast(pg8::h16x8, pa0), __builtin_bit_cast(pg8::h16x8, vf[1][0]), o1, 0, 0, 0); o1 = __builtin_amdgcn_mfma_f32_32x32x16_f16(__builtin_bit_cast(pg8::h16x8, pa1), __builtin_bit_cast(pg8::h16x8, vf[1][1]), o1, 0, 0, 0);
            if (__all(R < -34.f)) break;
        }
#pragma unroll
        for (int r = 0; r < 16; ++r) { const int q = (r & 3) + 8 * (r >> 2) + 4 * hi; stg[q * 64 + r32] = (bf16_t)(cvt_pk_bf16(o0[r], 0.f) & 0xffffu); stg[q * 64 + 32 + r32] = (bf16_t)(cvt_pk_bf16(o1[r], 0.f) & 0xffffu); }
        asm volatile("s_waitcnt lgkmcnt(0)" ::: "memory");
#pragma unroll
        for (int i = 0; i < 4; ++i) { const int row = i * 8 + (lane >> 3), ch = lane & 7; const u32x4 v = *(const LAS u32x4*)(stg + row * 64 + ch * 8); *(u32x4*)(O + (rowb + t0 + row) * DM + h * 64 + ch * 8) = v; }
        asm volatile("s_waitcnt lgkmcnt(0)" ::: "memory");
    }
#undef ATT_LOAD
#undef ATT_LOADQ
}

__device__ __forceinline__ float bfly16(const float (&v)[16], int lane) {
    float w8[8], w4[4], w2[2], w1;
    { const bool h = (lane & 32) != 0;
#pragma unroll
      for (int i = 0; i < 8; ++i) { const float send = h ? v[i] : v[i + 8], keep = h ? v[i + 8] : v[i]; w8[i] = keep + __shfl_xor(send, 32); } }
    { const bool h = (lane & 16) != 0;
#pragma unroll
      for (int i = 0; i < 4; ++i) { const float send = h ? w8[i] : w8[i + 4], keep = h ? w8[i + 4] : w8[i]; w4[i] = keep + __shfl_xor(send, 16); } }
    { const bool h = (lane & 8) != 0;
#pragma unroll
      for (int i = 0; i < 2; ++i) { const float send = h ? w4[i] : w4[i + 2], keep = h ? w4[i + 2] : w4[i]; w2[i] = keep + __shfl_xor(send, 8); } }
    { const bool h = (lane & 4) != 0; const float send = h ? w2[0] : w2[1], keep = h ? w2[1] : w2[0]; w1 = keep + __shfl_xor(send, 4); }
    w1 += __shfl_xor(w1, 2); w1 += __shfl_xor(w1, 1); return w1;
}
__device__ __forceinline__ void ssm_expand_tables(unsigned char* ws, int a, int gt, int NGT) {
    const float* sp = (const float*)(ws + WS_SP); const float* PW = (const float*)(ws + WS_PW); const float* KD = (const float*)(ws + WS_KD);
    bf16_t* KQT = (bf16_t*)(ws + WS_KQT); bf16_t* PT = (bf16_t*)(ws + WS_PT);
#pragma unroll 4
    for (int idx = gt; idx < SG * 1024 * 128; idx += NGT) {
        const int cj = idx & 127, rowi = idx >> 7, g = rowi >> 10, n = rowi & 1023, l = n >> 4, c = n & 15, j = cj >> 1, c0 = (cj & 1) * 8, d = l - j, dc = d < 0 ? 0 : d;
        if (cj >= 32 * ((l >> 4) + 1)) continue;
        const float* kd = KD + ((size_t)((a * SG + g) * 64 + dc) * 16 + c) * 16 + c0; f32x4 v0 = *(const f32x4*)kd, v1 = *(const f32x4*)(kd + 4);
        if (d < 0) { v0 = (f32x4){0.f, 0.f, 0.f, 0.f}; v1 = v0; }
        st16((KQT + (size_t)rowi * UA_LD + 128 + cj * 8), pack8(v0, v1));
    }
#pragma unroll 2
    for (int idx = gt; idx < SG * 1024 * 16; idx += NGT) {
        const int ck = idx & 15, rowi = idx >> 4, g = rowi >> 10, n = rowi & 1023, l = n >> 4, c = n & 15, nb = (ck & 7) * 8; const bool imag = ck >= 8; f32x4 v0, v1;
        const float* cr = sp + SP_CRE + ((a * SG + g) * SC + c) * SN + nb; const float* ci = sp + SP_CIM + ((a * SG + g) * SC + c) * SN + nb; const float* pw = PW + ((size_t)((a * SG + g) * 65 + l + 1) * 64 + nb) * 2;
#pragma unroll
        for (int e = 0; e < 8; ++e) { const float Cr = cr[e], Ci = ci[e], pr = pw[2 * e], pi = pw[2 * e + 1]; const float val = imag ? -(Cr * pi + Ci * pr) : (Cr * pr - Ci * pi); if (e < 4) v0[e] = val; else v1[e - 4] = val; }
        st16((KQT + (size_t)rowi * UA_LD + ck * 8), pack8(v0, v1));
    }
#pragma unroll 2
    for (int idx = gt; idx < SG * 128 * 128; idx += NGT) {
        const int ck = idx & 127, rowi = idx >> 7, g = rowi >> 7, r = rowi & 127, np = r & 63, j = ck >> 1, c0 = (ck & 1) * 8; const bool imag = r >= 64;
        const float* pw = PW + ((size_t)((a * SG + g) * 65 + 63 - j) * 64 + np) * 2; const float pr = pw[0], pi = pw[1];
        const float* br = sp + SP_BBR + ((a * SG + g) * SN + np) * SC + c0; const float* bi = sp + SP_BBI + ((a * SG + g) * SN + np) * SC + c0; f32x4 v0, v1;
#pragma unroll
        for (int e = 0; e < 8; ++e) { const float val = imag ? (pr * bi[e] + pi * br[e]) : (pr * br[e] - pi * bi[e]); if (e < 4) v0[e] = val; else v1[e - 4] = val; }
        st16((PT + (size_t)rowi * 1024 + ck * 8), pack8(v0, v1));
    }
}
__device__ __forceinline__ void ssm_carry(unsigned char* ws, int a, int gt, int NGT) {
    const float* PW = (const float*)(ws + WS_PW); const float* SL = (const float*)(ws + WS_SLOC); bf16_t* UA = (bf16_t*)(ws + WS_UA);
    for (int idx = gt; idx < SG * NB * SN; idx += NGT) {
        const int n = idx & 63, b = (idx >> 6) & 15, g = idx >> 10;
        const float* pw = PW + ((size_t)((a * SG + g) * 65 + 64) * 64 + n) * 2; const float ar = pw[0], ai = pw[1];
        float sr = 0.f, si = 0.f;
#pragma unroll 8
        for (int k = 0; k < 64; ++k) { const int chunk = b * 64 + k; bf16_t* up = UA + (size_t)g * UA_G + (size_t)chunk * UA_LD; const float* sl = SL + ((size_t)g * 1024 + chunk) * 128;
            up[n] = (bf16_t)(cvt_pk_bf16(sr, 0.f) & 0xffffu); up[64 + n] = (bf16_t)(cvt_pk_bf16(si, 0.f) & 0xffffu);
            const float lr = sl[n], li = sl[64 + n]; const float nsr = ar * sr - ai * si + lr, nsi = ar * si + ai * sr + li; sr = nsr; si = nsi; }
    }
}
__device__ __forceinline__ void ssm_carry_unit(unsigned char* ws, int a, int g, int pm4, int t) {
    if (t >= 256) return;
    const float* PW = (const float*)(ws + WS_PW); const float* SL = (const float*)(ws + WS_SLOC); bf16_t* UA = (bf16_t*)(ws + WS_UA);
    const int n = t & 63, b = 4 * pm4 + (t >> 6);
    const float* pw = PW + ((size_t)((a * SG + g) * 65 + 64) * 64 + n) * 2; const float ar = pw[0], ai = pw[1];
    float sr = 0.f, si = 0.f;
#pragma unroll 8
    for (int k = 0; k < 64; ++k) { const int chunk = b * 64 + k; bf16_t* up = UA + (size_t)g * UA_G + (size_t)chunk * UA_LD; const float* sl = SL + ((size_t)g * 1024 + chunk) * 128;
        up[n] = (bf16_t)(cvt_pk_bf16(sr, 0.f) & 0xffffu); up[64 + n] = (bf16_t)(cvt_pk_bf16(si, 0.f) & 0xffffu);
        const float lr = sl[n], li = sl[64 + n]; const float nsr = ar * sr - ai * si + lr, nsi = ar * si + ai * sr + li; sr = nsr; si = nsi; }
}

#define GAS __attribute__((address_space(1)))
#define XB_TMO      128
#define XB_XCNT(j)  (256  + 64 * (j))
#define XB_XSUB(j)  (1280 + 64 * (j))
#define XB_XGEN(j)  (2304 + 64 * (j))
#define XB_TOP      3328
#define XB_TOPGEN   3392
#define XCD_BAR_WORDS 3456
#define XB_SPIN_CAP (1u << 18)

__device__ __forceinline__ unsigned xb_ld(unsigned* p)              { return __hip_atomic_load(p, __ATOMIC_RELAXED, __HIP_MEMORY_SCOPE_AGENT); }
__device__ __forceinline__ unsigned xb_add(unsigned* p, unsigned v) { return __hip_atomic_fetch_add(p, v, __ATOMIC_RELAXED, __HIP_MEMORY_SCOPE_AGENT); }
__device__ __forceinline__ unsigned xb_xcc_id() { return (unsigned)__builtin_amdgcn_s_getreg((3 << 11) | 20) & 0xFu; }
#define XB_SPIN(cond, bar) do { unsigned _sp = 0; while (cond) { __builtin_amdgcn_s_sleep(1); \
    if ((++_sp & 255u) == 0u) { if (xb_ld(&(bar)[XB_TMO])) break; if (_sp > XB_SPIN_CAP) { atomicAdd(&(bar)[XB_TMO], 1u); break; } } } } while (0)

struct XcdBarrier {
    unsigned* bar; unsigned x;
    volatile LAS unsigned* st;
};

__device__ __forceinline__ XcdBarrier xcd_barrier_post(unsigned* bar, volatile LAS unsigned* st) {
    XcdBarrier b; b.bar = bar; b.x = xb_xcc_id(); b.st = st;
    if (threadIdx.x == 0) (void)xb_add(&bar[XB_XCNT(b.x)], 1u);
    return b;
}
__device__ __forceinline__ void xcd_barrier_complete(unsigned* bar, unsigned x, unsigned& nloc, unsigned& nx) {
    const unsigned G = gridDim.x * gridDim.y * gridDim.z;
    unsigned sum, cnt, mine, sp = 0u;
    for (;;) {
        sum = 0u; cnt = 0u; mine = 0u;
#pragma unroll
        for (unsigned j = 0; j < 16; ++j) { const unsigned c = xb_ld(&bar[XB_XCNT(j)]); sum += c; cnt += (c > 0u) ? 1u : 0u; mine = (j == x) ? c : mine; }
        if (sum == G) break;
        __builtin_amdgcn_s_sleep(1);
        if ((++sp & 255u) == 0u) { if (xb_ld(&bar[XB_TMO])) break; if (sp > XB_SPIN_CAP) { atomicAdd(&bar[XB_TMO], 1u); break; } }
    }
    nloc = mine > 0u ? mine : 1u; nx = cnt > 0u ? cnt : 1u;
}

__device__ __forceinline__ void xcd_barrier(const XcdBarrier& b) {
    asm volatile("s_waitcnt vmcnt(0)" ::: "memory");
    __syncthreads();
    if (threadIdx.x == 0) {
        unsigned* bar = b.bar;
        __builtin_amdgcn_s_waitcnt(0);
        unsigned nloc = b.st[0], nx = b.st[1];
        if (nloc == 0u) { xcd_barrier_complete(bar, b.x, nloc, nx); b.st[0] = nloc; b.st[1] = nx; }
        const unsigned old = xb_add(&bar[XB_XSUB(b.x)], 1u);
        const unsigned gen = old / nloc;
        if (old + 1u == (gen + 1u) * nloc) {
            __builtin_amdgcn_fence(__ATOMIC_RELEASE, "agent");
            asm volatile("s_waitcnt vmcnt(0)" ::: "memory");
            const unsigned og = xb_add(&bar[XB_TOP], 1u);
            const unsigned tg = og / nx;
            if (og + 1u == (tg + 1u) * nx) xb_add(&bar[XB_TOPGEN], 1u);
            else XB_SPIN(xb_ld(&bar[XB_TOPGEN]) == tg, bar);
            __builtin_amdgcn_fence(__ATOMIC_ACQUIRE, "agent");
            xb_add(&bar[XB_XGEN(b.x)], 1u);
            asm volatile("s_waitcnt vmcnt(0)" ::: "memory");
        } else {
            XB_SPIN(xb_ld(&bar[XB_XGEN(b.x)]) == gen, bar);
            __builtin_amdgcn_fence(__ATOMIC_ACQUIRE, "agent");
            asm volatile("s_waitcnt vmcnt(0)" ::: "memory");
        }
    }
    __syncthreads();
}

constexpr int CW_GMASK = 4096, CW_GCNT = 4096 + 512;
__device__ __forceinline__ void group_barrier(unsigned* cnt) {
    asm volatile("s_waitcnt vmcnt(0)" ::: "memory");
    __syncthreads();
    if (threadIdx.x == 0) {
        const unsigned old = __hip_atomic_fetch_add(cnt, 1u, __ATOMIC_RELAXED, __HIP_MEMORY_SCOPE_AGENT), target = (old / 32u + 1u) * 32u; unsigned sp = 0u;
        while (__hip_atomic_load(cnt, __ATOMIC_RELAXED, __HIP_MEMORY_SCOPE_AGENT) < target) { __builtin_amdgcn_s_sleep(1); if (++sp > (1u << 22)) break; }
        __builtin_amdgcn_fence(__ATOMIC_ACQUIRE, "agent");
        asm volatile("s_waitcnt vmcnt(0)" ::: "memory");
    }
    __syncthreads();
}

constexpr int NS5 = 9, NMIX5 = 5, NAT = 7;
constexpr int NPH = 1 + 2 * NS5 + 2 * NAT;
template <class Op> __device__ __forceinline__ void run_gemm(LAS unsigned char* lds, const bf16_t* A, const bf16_t* Bt, int M, int N, int K, const Op& op) {
    pg8::Gemm g{A, Bt, M, N, K, K, K, 0, 0}; pg8::StaticOrder S; S.init(M, N, (int)gridDim.x, (int)blockIdx.x); EpiGen<Op> E{op, (LAS float*)(lds + RING_BYTES + 8192), -1};
    pg8::gemm_phase<EpiGen<Op>, pg8::StaticOrder, true, true>(lds, g, S, E);
}
template <class Op> __device__ __forceinline__ void run_gemm_n(LAS unsigned char* lds, const bf16_t* A, const bf16_t* Bt, int M, int N, int K, const Op& op) {
    pg8::Gemm g{A, Bt, M, N, K, K, K, 0, 0}; pg8::StaticOrder S; S.init(M, N, (int)gridDim.x, (int)blockIdx.x); EpiGen<Op> E{op, (LAS float*)(lds + RING_BYTES + 8192), -1};
    pg8::gemm_phase<EpiGen<Op>, pg8::StaticOrder, true, true>(lds, g, S, E);
}
__device__ __forceinline__ void run_gemm_fused(LAS unsigned char* lds, const bf16_t* A, const bf16_t* Bt, int K, const EpiFused& E) {
    pg8::Gemm g{A, Bt, MTOK, DM, K, K, K, 0, 0}; pg8::StaticOrder S; S.init(MTOK, DM, (int)gridDim.x, (int)blockIdx.x);
    pg8::gemm_phase<EpiFused, pg8::StaticOrder, true, true>(lds, g, S, E);
}
template <class Op> __device__ __forceinline__ void run_gemm_b(LAS unsigned char* lds, const bf16_t* A, const bf16_t* Bt, int M, int N, int K, int lda, int ldb, size_t sAz, size_t sBz, int nz, int tri, const Op& op) {
    pg8::Gemm g{A, Bt, M, N, K, lda, ldb, sAz, sBz}; pg8::BatchOrder S; S.init(M, N, nz, (int)gridDim.x, (int)blockIdx.x, tri); EpiGen<Op> E{op, (LAS float*)(lds + RING_BYTES + 8192), -1};
    pg8::gemm_phase<EpiGen<Op>, pg8::BatchOrder, true, true>(lds, g, S, E);
}
__global__ void __launch_bounds__(NWAVES * 64, 2) mk_fwd(Args A) {
    extern __shared__ __attribute__((aligned(16))) unsigned char lds_raw[];
    LAS unsigned char* lds = (LAS unsigned char*)lds_raw;
    const int tid = threadIdx.x, lane = tid & 63, wave = __builtin_amdgcn_readfirstlane(tid >> 6);
    const int gw = blockIdx.x * NWAVES + wave, NGW = gridDim.x * NWAVES;
    unsigned char* ws = A.ws;
    float* RS = (float*)(ws + WS_RS); bf16_t* Wb = (bf16_t*)(ws + WS_W); bf16_t* XB = (bf16_t*)(ws + WS_XB); bf16_t* HID = (bf16_t*)(ws + WS_HID);
    bf16_t* UA = (bf16_t*)(ws + WS_UA); bf16_t* Yb = (bf16_t*)(ws + WS_Y); bf16_t* Zb = (bf16_t*)(ws + WS_Z);
    bf16_t* Qb = (bf16_t*)A.out + (size_t)MTOK * DM; bf16_t* Ob = (bf16_t*)(ws + WS_O); bf16_t* Kb = (bf16_t*)(ws + WS_K); bf16_t* Vb = (bf16_t*)(ws + WS_V);
    float* X = A.out; const float* SP = (const float*)(ws + WS_SP); const float* NG = SP + SP_NG;
    volatile LAS unsigned* misc = (volatile LAS unsigned*)(lds + RING_BYTES + 64);
    if (tid < 4) misc[tid] = 0u;
    __syncthreads();
    if (tid == 0) __hip_atomic_fetch_or((unsigned*)A.ws + CW_GMASK + 64 * (blockIdx.x & 7), 1u << xb_xcc_id(), __ATOMIC_RELAXED, __HIP_MEMORY_SCOPE_AGENT);
    (void)xcd_barrier_post((unsigned*)A.ws, misc);
    int p0 = A.ph_lo;
    if (p0 == 0) {
        {
            LAS float* scr = (LAS float*)(lds + wave * 16384); int cstart = gw;
            const float* NGi = A.in[I_NG];
            for (int l = 0; l < 4; ++l) for (int j = 0; j < 2; ++j) { const int lj = l * 2 + j; bf16_t* wgu = Wb + WO_FFN + (size_t)lj * W_FFN; const float* gn = NGi + (l * 6 + (j ? 4 : 0)) * DM;
                CONV(A.in[I_WG] + (size_t)lj * DM * DFF, DM, DFF, gn, 1, wgu, 0); CONV(A.in[I_WU] + (size_t)lj * DM * DFF, DM, DFF, gn, 2, wgu, 0);
                CONV(A.in[I_WD] + (size_t)lj * DFF * DM, DFF, DM, (const float*)nullptr, 0, wgu + W_GU, 0); }
            for (int a = 0; a < 2; ++a) { bf16_t* w = Wb + WO_SSM + (size_t)a * 3 * W_SQ;
                CONV(A.in[I_SWIN] + (size_t)a * W_SQ, DM, DM, NGi + (a * 6 + 2) * DM, 0, w, 0); CONV(A.in[I_SWGLU] + (size_t)a * W_SQ, DM, DM, (const float*)nullptr, 0, w + W_SQ, 0);
                CONV(A.in[I_SWOUT] + (size_t)a * W_SQ, DM, DM, (const float*)nullptr, 0, w + 2 * W_SQ, 0); }
            CONV(A.in[I_WQ], DM, DM, NGi + (2 * 6 + 2) * DM, 0, Wb + WO_QKV, 0); CONV(A.in[I_WK], DM, DM, A.in[I_KVG], 0, Wb + WO_QKV, DM); CONV(A.in[I_WV], DM, DM, A.in[I_KVG], 0, Wb + WO_QKV, 2 * DM);
            CONV(A.in[I_WQ] + W_SQ, DM, DM, NGi + (3 * 6 + 2) * DM, 0, Wb + WO_Q1, 0);
            CONV(A.in[I_WO], DM, DM, (const float*)nullptr, 0, Wb + WO_O, 0); CONV(A.in[I_WO] + W_SQ, DM, DM, (const float*)nullptr, 0, Wb + WO_O + W_SQ, 0);
            float* spw = (float*)(ws + WS_SP); const int gt = blockIdx.x * (NWAVES * 64) + tid, NGT = gridDim.x * NWAVES * 64;
#define COPYP(idx, off, n) for (int i_ = gt; i_ < (n); i_ += NGT) spw[(off) + i_] = A.in[idx][i_]
            for (int i_ = gt; i_ < (int)((size_t)MTOK * 4 * 8 / 16); i_ += NGT) ((u32x4*)(ws + WS_XS1))[i_] = (u32x4){0u, 0u, 0u, 0u};
            COPYP(I_NG, SP_NG, 24576); COPYP(I_LRE, SP_LRE, 8192); COPYP(I_LIM, SP_LIM, 8192); COPYP(I_LDT, SP_LDT, 128); COPYP(I_BRE, SP_BRE, 131072); COPYP(I_BIM, SP_BIM, 131072);
            COPYP(I_CRE, SP_CRE, 131072); COPYP(I_CIM, SP_CIM, 131072); COPYP(I_SD, SP_SD, 2048);
            for (int i = gt; i < 2 * SG * SN; i += NGT) {
                const int ag = i >> 6;
                const double dt = (double)expf(A.in[I_LDT][ag]);
                const double lr = A.in[I_LRE][i], li = A.in[I_LIM][i];
                double are, aim; cpow_lam(lr * dt, li * dt, 1, are, aim);
                const double den = lr * lr + li * li, nr = are - 1.0, ni = aim;
                const double fre = (nr * lr + ni * li) / den, fim = (ni * lr - nr * li) / den;
                spw[SP_AR + i] = (float)are; spw[SP_AI + i] = (float)aim;
                for (int c = 0; c < 16; ++c) { const double br = A.in[I_BRE][(size_t)i * SC + c], bi = A.in[I_BIM][(size_t)i * SC + c];
                    spw[SP_BBR + i * SC + c] = (float)(fre * br - fim * bi); spw[SP_BBI + i * SC + c] = (float)(fre * bi + fim * br); }
            }
            {
                float* PWw = (float*)(ws + WS_PW); float* KDw = (float*)(ws + WS_KD);
                for (int i = gt; i < 2 * SG * 65 * SN; i += NGT) { const int n = i & 63, d = (i >> 6) % 65, ag = (i >> 6) / 65;
                    const double dt = (double)expf(A.in[I_LDT][ag]); const double lr = A.in[I_LRE][ag * SN + n], li = A.in[I_LIM][ag * SN + n];
                    double pr, pi; cpow_lam(lr * dt, li * dt, d, pr, pi); PWw[2 * (size_t)i] = (float)pr; PWw[2 * (size_t)i + 1] = (float)pi; }
                for (int task = gw; task < 2 * SG * 64; task += NGW) { const int ag = task >> 6, d = task & 63, n = lane, i = ag * SN + n;
                    const double dt = (double)expf(A.in[I_LDT][ag]); const double lr = A.in[I_LRE][i], li = A.in[I_LIM][i];
                    double are, aim, pr, pi; cpow_lam(lr * dt, li * dt, 1, are, aim); cpow_lam(lr * dt, li * dt, d, pr, pi);
                    const double den = lr * lr + li * li, nr = are - 1.0, ni = aim; const double fre = (nr * lr + ni * li) / den, fim = (ni * lr - nr * li) / den;
                    float tre[16], tim[16];
#pragma unroll
                    for (int c = 0; c < 16; ++c) { const double br = A.in[I_BRE][(size_t)i * SC + c], bi = A.in[I_BIM][(size_t)i * SC + c]; const double bbr = fre * br - fim * bi, bbi = fre * bi + fim * br;
                        tre[c] = (float)(pr * bbr - pi * bbi); tim[c] = (float)(pr * bbi + pi * bbr); }
                    const int cl = (lane >> 2) & 15;
                    for (int c = 0; c < 16; ++c) { const float Cr = A.in[I_CRE][((size_t)ag * SC + c) * SN + n], Ci = A.in[I_CIM][((size_t)ag * SC + c) * SN + n]; float v[16];
#pragma unroll
                        for (int e = 0; e < 16; ++e) v[e] = Cr * tre[e] - Ci * tim[e];
                        const float tot = bfly16(v, lane); if ((lane & 3) == 0) KDw[((size_t)task * 16 + c) * 16 + cl] = tot; }
                }
            }
            row_update<0, 4>(A.in[I_X], XB, nullptr, RS, nullptr, 0.f, nullptr, gw, NGW, lane); PROBE_RU_X
        }
        p0 = 1;
        if (A.ph_hi > 1) { cg::this_grid().sync(); }
        if (tid == 0) {
            unsigned ok = (gridDim.x == 256u) ? 1u : 0u;
            for (int x = 0; x < 8; ++x) { const unsigned m = __hip_atomic_load((unsigned*)A.ws + CW_GMASK + 64 * x, __ATOMIC_RELAXED, __HIP_MEMORY_SCOPE_AGENT); if (__builtin_popcount(m) != 1) ok = 0u; }
            misc[2] = ok; }
        __syncthreads();
    }
    for (int p = p0; p < A.ph_hi; ++p) {
        {
            unsigned char* ws = A.ws; asm volatile("" : "+s"(ws));
            int lane_p = lane, gw_p = gw; asm volatile("" : "+v"(lane_p)); asm volatile("" : "+s"(gw_p));
            float* RS = (float*)(ws + WS_RS); bf16_t* Wb = (bf16_t*)(ws + WS_W); bf16_t* XB = (bf16_t*)(ws + WS_XB); bf16_t* HID = (bf16_t*)(ws + WS_HID);
            bf16_t* UA = (bf16_t*)(ws + WS_UA); bf16_t* Yb = (bf16_t*)(ws + WS_Y); bf16_t* Zb = (bf16_t*)(ws + WS_Z);
            bf16_t* Qb = (bf16_t*)A.out + (size_t)MTOK * DM; bf16_t* Ob = (bf16_t*)(ws + WS_O); bf16_t* Kb = (bf16_t*)(ws + WS_K); bf16_t* Vb = (bf16_t*)(ws + WS_V);
            float* X = A.out; const float* SP = (const float*)(ws + WS_SP); const float* NG = SP + SP_NG;
            const int q = p - 1, layer = q < 2 * NS5 ? q / NS5 : 2 + (q - 2 * NS5) / NAT, s = q < 2 * NS5 ? q % NS5 : (q - 2 * NS5) % NAT;
            const int nmix = layer < 2 ? NMIX5 : 3;
            const int sub = (s < 2) ? 0 : (s < 2 + nmix ? 1 : 2);
            EpiFused EF; EF.x16 = XB; EF.g = NG + (layer * 6 + (sub == 0 ? 1 : (sub == 1 ? 3 : 5))) * DM; EF.alpha = (sub == 1) ? 1.0f : 0.5f; EF.outf = (layer == 3 && sub == 2) ? X : nullptr;
            EF.xs1 = (float*)(ws + WS_XS1); EF.ssq2 = RS; EF.cnt = (unsigned*)ws + CW_PCNT; EF.want = 32u * (unsigned)(layer * 3 + sub + 1); EF.xl = lds + RING_BYTES + 1024; EF.cpn = -1;
            if (s < 2 || s >= 2 + nmix) {
                const int j = s < 2 ? 0 : 1, st = s < 2 ? s : s - 2 - nmix; const bf16_t* wgu = Wb + WO_FFN + (size_t)(layer * 2 + j) * W_FFN;
                if (st == 0) run_gemm(lds, XB, wgu, MTOK, 2 * DFF, DM, OpSwiglu{RS, HID});
                else run_gemm_fused(lds, HID, wgu + W_GU, DFF, EF);
            } else if (layer < 2) {
                const bf16_t* w = Wb + WO_SSM + (size_t)layer * 3 * W_SQ; const int st = s - 2;
                if (st == 0) { run_gemm(lds, XB, w, MTOK, DM, DM, OpUA{UA, RS}); int tid_p = tid; asm volatile("" : "+v"(tid_p)); const int gt_l = blockIdx.x * (NWAVES * 64) + tid_p; ssm_expand_tables(ws, layer, gt_l, (int)gridDim.x * NWAVES * 64); }
                else if (st == 1) {
                    run_gemm_b(lds, UA + 128, (const bf16_t*)(ws + WS_PT), 1024, 256, 1024, UA_LD, 1024, UA_G, (size_t)128 * 1024, SG, 0, OpSloc{(float*)(ws + WS_SLOC)});
                    asm volatile("s_waitcnt vmcnt(0)" ::: "memory"); __syncthreads();
                    int tid_p = tid; asm volatile("" : "+v"(tid_p));
                    for (int L = blockIdx.x; L < SG * 4; L += gridDim.x) ssm_carry_unit(ws, layer, L >> 2, L & 3, tid_p); }
                else if (st == 2) run_gemm_b(lds, UA, (const bf16_t*)(ws + WS_KQT), 1024, 1024, UA_LD, UA_LD, UA_LD, UA_G, (size_t)1024 * UA_LD, SG, 1, OpY{UA, Yb, SP + SP_SD + layer * SG * SC});
                else if (st == 3) run_gemm(lds, Yb, w + W_SQ, MTOK, DM, DM, OpGLU{Yb, Zb});
                else run_gemm_fused(lds, Zb, w + 2 * W_SQ, DM, EF);
            } else {
                const int bl = layer - 2, st = s - 2;
                if (st == 0) { if (bl == 0) { run_gemm(lds, XB, Wb + WO_QKV, MTOK, 2 * DM, DM, OpQKV{Qb, ws, RS}); run_gemm_n(lds, Wb + WO_QKV + 2 * W_SQ, XB, DM, MTOK, DM, OpVT{Vb, RS}); } else run_gemm(lds, XB, Wb + WO_Q1, MTOK, DM, DM, OpQKV{Qb, ws, RS}); }
                else if (st == 1) { ATTN_CALL; }
                else run_gemm_fused(lds, Ob, Wb + WO_O + (size_t)bl * W_SQ, DM, EF);
            }
            (void)lane_p; (void)gw_p; (void)Kb;
        }
        if (p + 1 < A.ph_hi) {
            const int q_ = p - 1, s_ = q_ < 2 * NS5 ? q_ % NS5 : (q_ - 2 * NS5) % NAT; const bool s5_ = q_ < 2 * NS5;
            const bool seam = s5_ ? (s_ >= 2 && s_ <= 4) || s_ == 6 : (s_ >= 2 && s_ <= 4);
            const bool fast = misc[2] != 0u;
            if (seam || !fast) { XcdBarrier xb_; xb_.bar = (unsigned*)A.ws; xb_.x = xb_xcc_id(); xb_.st = (volatile LAS unsigned*)(lds + RING_BYTES + 64); xcd_barrier(xb_); }
            else group_barrier((unsigned*)A.ws + CW_GCNT + 64 * (blockIdx.x & 7));
        }
    }
}

extern "C" void kernel_launch(void* const* d_in, const int* in_sizes, int n_in, void* d_out, int out_size, void* d_ws, size_t ws_size, hipStream_t stream) {
    static int grid = 0;
    if (grid == 0) {
        if (n_in != 21 || out_size != MTOK * DM || ws_size < WS_END) { fprintf(stderr, "kernel_launch: unexpected shapes (n_in %d out %d ws %zu)\n", n_in, out_size, ws_size); grid = -1; return; }
        int dev = 0, cus = 0, per_cu = 0;
        hipGetDevice(&dev); hipDeviceGetAttribute(&cus, hipDeviceAttributeMultiprocessorCount, dev);
        if (hipFuncSetAttribute((const void*)mk_fwd, hipFuncAttributeMaxDynamicSharedMemorySize, LDS_BYTES) != hipSuccess) { fprintf(stderr, "kernel_launch: hipFuncSetAttribute failed\n"); grid = -1; return; }
        hipOccupancyMaxActiveBlocksPerMultiprocessor(&per_cu, (const void*)mk_fwd, NWAVES * 64, LDS_BYTES);
        (void)hipGetLastError();
        if (per_cu < 1) per_cu = 1;
        grid = cus * 1;
        if (grid <= 0) grid = 256;
    }
    if (grid < 0) return;
    if (hipMemsetAsync(d_ws, 0, 24576, stream) != hipSuccess) { fprintf(stderr, "kernel_launch: memset of the barrier words failed\n"); return; }
    Args a{};
    for (int i = 0; i < 21; ++i) a.in[i] = (const float*)d_in[i];
    a.out = (float*)d_out; a.ws = (unsigned char*)d_ws;
#if MK_MULTI
    for (int p = 0; p < NPH; ++p) { a.ph_lo = p; a.ph_hi = p + 1; hipLaunchKernelGGL(mk_fwd, dim3(grid), dim3(NWAVES * 64), LDS_BYTES, stream, a); }
#else
    a.ph_lo = 0; a.ph_hi = NPH;
    void* args[] = {&a};
    hipError_t e = hipLaunchCooperativeKernel((const void*)mk_fwd, dim3(grid), dim3(NWAVES * 64), args, LDS_BYTES, stream);
    if (e != hipSuccess) fprintf(stderr, "cooperative launch failed: %s (grid %d)\n", hipGetErrorString(e), grid);
#endif
}
```

```cpp
#include <hip/hip_runtime.h>
#include <hip/hip_cooperative_groups.h>
#include <cstdio>
#include <cstdint>
namespace cg = cooperative_groups;
#ifndef MK_MULTI
#define MK_MULTI 0
#endif
#ifndef NO_SSM
#define SSM_CALL do { int lane_l = lane, wave_l = wave; asm volatile("" : "+v"(lane_l)); asm volatile("" : "+s"(wave_l)); ssm_naive_phase(ws, layer, lds, wave_l, lane_l); PROBE_SSM2 } while (0)
#else
#define SSM_CALL
#endif
#ifndef NO_ATTN
#ifdef ATTN_NAIVE
#define ATTN_CALL do { attn_naive_phase(Qb, Kb, Vb, Ob); PROBE_ATTN2 } while (0)
#else
#define ATTN_CALL do { int lane_l = lane; asm volatile("" : "+v"(lane_l)); attn_mfma_phase(Qb, Kb, Vb, Ob, lds, gw, NGW, wave, lane_l); } while (0)
#endif
#else
#define ATTN_CALL
#endif
#ifdef PROBE_SSM
#define PROBE_SSM2 asm volatile("" : "+v"(lane_l)); ssm_naive_phase(ws, layer, lds, wave_l, lane_l);
#else
#define PROBE_SSM2
#endif
#ifdef PROBE_ATTN
#define PROBE_ATTN2 asm volatile("" ::: "memory"); attn_naive_phase(Qb, Kb, Vb, Ob);
#else
#define PROBE_ATTN2
#endif
#ifdef PROBE_F1
#define PROBE_F1_X asm volatile("" ::: "memory"); run_gemm(lds, XB, wgu, MTOK, 2 * DFF, DM, OpSwiglu{RS, HID});
#else
#define PROBE_F1_X
#endif
#ifdef PROBE_F2
#define PROBE_F2_X asm volatile("" ::: "memory"); run_gemm(lds, HID, wgu + W_GU, MTOK, DM, DFF, OpStore{XB, DM, nullptr, 1.0f});
#else
#define PROBE_F2_X
#endif
#ifdef PROBE_RU
#define PROBE_RU_X asm volatile("" ::: "memory"); for (int rep_ = 0; rep_ < 4; ++rep_) { asm volatile("" ::: "memory"); row_update<0, 4>(A.in[I_X], X, XB, RS, nullptr, 0.f, gw, NGW, lane); }
#else
#define PROBE_RU_X
#endif
namespace pg8 {
#define PG8_LAS __attribute__((address_space(3)))
typedef unsigned short bf16_t;
typedef short bf16x8 __attribute__((ext_vector_type(8)));
typedef float f32x4 __attribute__((ext_vector_type(4)));
typedef unsigned u32x4 __attribute__((ext_vector_type(4)));
constexpr int BM = 256, BK = 64, HALF = 128, HTB = HALF * BK * 2  , STAGE_BYTES = 8 * HTB, NXCD = 8, WGM = 8;

__host__ __device__ __forceinline__ int lds_byte(int r, int c) { const int st = (r >> 4) * 2 + (c >> 5), rr = r & 15, cc = c & 31, ob = rr * 64 + cc * 2; return st * 1024 + (ob ^ (((ob >> 9) & 1) << 5)); }
__host__ __device__ __forceinline__ void stage_rc(int b, int& R, int& C) { const int st = b / 1024, sb = b % 1024, swz = sb ^ (((sb >> 9) & 1) << 5); R = (st >> 1) * 16 + swz / 64; C = (st & 1) * 32 + (swz % 64) / 2; }
__host__ __device__ __forceinline__ int perm32(int rho) { const int n = rho >> 4, i = rho & 15; return 8 * (i >> 2) + 4 * n + (i & 3); }

struct Unit { int pm, pn, z; };
struct Gemm { const bf16_t* A; const bf16_t* Bt; int M, N, K; int lda, ldb; size_t sAz, sBz; };

struct StaticOrder {
    int nM, nN, nwg, G, c;
    __host__ __device__ void init(int M, int N, int G_, int c_) { nM = M / BM; nN = N / BM; nwg = nM * nN; G = G_; c = c_; }
    __host__ __device__ bool next(int i, Unit& u) const {
        const long L = (long)i * G + c; if (L >= nwg) return false;
        int wgid = (int)L; { const int q = nwg / NXCD, r = nwg % NXCD, xcd = wgid % NXCD, off = wgid / NXCD; wgid = (xcd < r ? xcd * (q + 1) : r * (q + 1) + (xcd - r) * q) + off; }
        const int nig = WGM * nN, gid = wgid / nig, fm = gid * WGM, gsz = (nM - fm) < WGM ? (nM - fm) : WGM;
        u.pm = fm + ((wgid % nig) % gsz); u.pn = (wgid % nig) / gsz; u.z = 0; return true;
    }
    __device__ __forceinline__ void a_ready(const Unit&) const {}
    __device__ __forceinline__ void done(const Unit&) const {}
    __device__ __forceinline__ int unit_nt(const Unit&, int ntd) const { return ntd; }
};

struct PanelOrder {
    int nM, nN, G, c;
    __host__ __device__ void init(int M, int N, int G_, int c_) { nM = M / BM; nN = N / BM; G = G_; c = c_; }
    __host__ __device__ bool next(int i, Unit& u) const { const int k = i / nN; const long pm = (long)k * G + c; if (pm >= nM) return false; u.pm = (int)pm; u.pn = i - k * nN; u.z = 0; return true; }
    __device__ __forceinline__ void a_ready(const Unit&) const {}
    __device__ __forceinline__ void done(const Unit&) const {}
    __device__ __forceinline__ int unit_nt(const Unit&, int ntd) const { return ntd; }
};
struct PanelOrderN {
    int nM, nN, G, c;
    __host__ __device__ void init(int M, int N, int G_, int c_) { nM = M / BM; nN = N / BM; G = G_; c = c_; }
    __host__ __device__ bool next(int i, Unit& u) const { const int k = i / nM; const long pn = (long)k * G + c; if (pn >= nN) return false; u.pn = (int)pn; u.pm = i - k * nM; u.z = 0; return true; }
    __device__ __forceinline__ void a_ready(const Unit&) const {}
    __device__ __forceinline__ void done(const Unit&) const {}
    __device__ __forceinline__ int unit_nt(const Unit&, int ntd) const { return ntd; }
};
struct BatchOrder {
    int nM, nN, nwg, G, c, tri;
    __host__ __device__ void init(int M, int N, int nz, int G_, int c_, int tri_) { nM = M / BM; nN = N / BM; nwg = nz * nM * nN; G = G_; c = c_; tri = tri_; }
    __host__ __device__ bool next(int i, Unit& u) const { const long L = (long)i * G + c; if (L >= nwg) return false; const int per = nM * nN, l = (int)L; u.z = l / per; const int rem = l % per; u.pm = rem / nN; u.pn = tri ? (rem + i) % nN : rem % nN; return true; }
    __device__ __forceinline__ void a_ready(const Unit&) const {}
    __device__ __forceinline__ void done(const Unit&) const {}
    __device__ __forceinline__ int unit_nt(const Unit& u, int ntd) const { return tri ? 4 * u.pn + 6 : ntd; }
};
typedef float f32x2_c __attribute__((ext_vector_type(2))); typedef _Float16 h16x2_c __attribute__((ext_vector_type(2))); typedef _Float16 h16x8 __attribute__((ext_vector_type(8)));
__device__ __forceinline__ unsigned cvt_pk_bf16(float lo, float hi) { f32x2_c v = {lo, hi}; h16x2_c b = __builtin_convertvector(v, h16x2_c); return __builtin_bit_cast(unsigned, b); }
typedef float f32x2 __attribute__((ext_vector_type(2)));
template <class Epi, class Sched, bool ALIGN_EPI = false, bool SP2 = false>
__device__ __forceinline__ void gemm_phase(PG8_LAS unsigned char* lds, const Gemm g, const Sched& S, const Epi& E) {
    int tid_l = threadIdx.x; asm volatile("" : "+v"(tid_l)); const int tid = tid_l, wid = __builtin_amdgcn_readfirstlane(tid >> 6), lane = tid & 63, wr = wid >> 2, wc = wid & 3, fr = lane & 15, fq = lane >> 4;
    const int K = g.K, ntd = K / BK;
    unsigned voffA[2], voffB[2];
#pragma unroll
    for (int i = 0; i < 2; ++i) { int R, C; stage_rc(tid * 16 + i * 8192, R, C); const int Rb = Epi::PERM ? ((R & ~31) + perm32(R & 31)) : R;
        voffA[i] = (unsigned)(R * g.lda + C) * 2u; voffB[i] = (unsigned)(Rb * g.ldb + C) * 2u; }
    const size_t kstep = (size_t)(BK * 2);
    const size_t hstepA = (size_t)HALF * g.lda * 2, hstepB = (size_t)HALF * g.ldb * 2;
    const size_t tstepA = 2 * hstepA, tstepB = 2 * hstepB;
    const unsigned ldsw = (unsigned)wid * 1024u;
    const int aoff = lds_byte(wr * 64 + fr, fq * 8), boff = lds_byte(wc * 32 + fr, fq * 8);
#define PG8_SA(b, h) (((b) * 2 + (h)) * HTB)
#define PG8_SB(b, h) ((4 + (b) * 2 + (h)) * HTB)
#define PG8_STAGE(bufoff, gbase, voff) do { _Pragma("unroll") for (int _i = 0; _i < 2; ++_i) \
        __builtin_amdgcn_global_load_lds((const unsigned*)((const char*)(gbase) + (voff)[_i]), (PG8_LAS unsigned*)(lds + (bufoff) + ldsw + _i * 8192), 16, 0, 0); } while (0)
#define PG8_LDA(dst, b, h) do { _Pragma("unroll") for (int m = 0; m < 4; ++m) _Pragma("unroll") for (int k = 0; k < 2; ++k) dst[m][k] = *(const PG8_LAS bf16x8*)(lds + PG8_SA(b, h) + aoff + m * 2048 + k * 1024); } while (0)
#define PG8_LDB(dst, b, h) do { _Pragma("unroll") for (int n = 0; n < 2; ++n) _Pragma("unroll") for (int k = 0; k < 2; ++k) dst[n][k] = *(const PG8_LAS bf16x8*)(lds + PG8_SB(b, h) + boff + n * 2048 + k * 1024); } while (0)
#define PG8_MMA(ai, bj, At, Bt) do { __builtin_amdgcn_s_setprio(1); _Pragma("unroll") for (int m = 0; m < 4; ++m) _Pragma("unroll") for (int n = 0; n < 2; ++n) _Pragma("unroll") for (int k = 0; k < 2; ++k) \
        acc[ai][bj][m][n] = __builtin_amdgcn_mfma_f32_16x16x32_f16(__builtin_bit_cast(h16x8, Bt[n][k]), __builtin_bit_cast(h16x8, At[m][k]), acc[ai][bj][m][n], 0, 0, 0); __builtin_amdgcn_s_setprio(0); } while (0)
#define PG8_WAIT_V(n) asm volatile("s_waitcnt vmcnt(" #n ")" ::: "memory")
#define PG8_WAIT_L(n) asm volatile("s_waitcnt lgkmcnt(" #n ")" ::: "memory")
#define PG8_BAR __builtin_amdgcn_s_barrier()
#define PG8_SCHED __builtin_amdgcn_sched_barrier(0)
    Unit cur, nxt; int ui = 0;
    if (!S.next(0, cur)) return;
    int nt = S.unit_nt(cur, ntd);
    f32x4 acc[2][2][4][2];
#pragma unroll
    for (int a = 0; a < 2; ++a)
#pragma unroll
        for (int b = 0; b < 2; ++b)
#pragma unroll
            for (int m = 0; m < 4; ++m)
#pragma unroll
                for (int n = 0; n < 2; ++n) acc[a][b][m][n] = (f32x4){0.f, 0.f, 0.f, 0.f};
    bf16x8 At[4][2], B0[2][2], B1[2][2];
    const char* cA = (const char*)g.A + (size_t)cur.z * g.sAz * 2 + (size_t)cur.pm * tstepA; const char* cB = (const char*)g.Bt + (size_t)cur.z * g.sBz * 2 + (size_t)cur.pn * tstepB;
    S.a_ready(cur);
    if constexpr (SP2) {
        PG8_STAGE(PG8_SB(0, 0), cB, voffB); PG8_STAGE(PG8_SB(0, 1), cB + hstepB, voffB); PG8_STAGE(PG8_SA(0, 0), cA, voffA); PG8_STAGE(PG8_SA(0, 1), cA + hstepA, voffA);
        if (wr == 1) PG8_BAR;
        PG8_WAIT_V(2); PG8_BAR;
        PG8_STAGE(PG8_SB(1, 0), cB + kstep, voffB); PG8_STAGE(PG8_SA(1, 0), cA + kstep, voffA); PG8_STAGE(PG8_SB(1, 1), cB + hstepB + kstep, voffB);
        PG8_WAIT_V(6); PG8_BAR;
    } else {
        PG8_STAGE(PG8_SB(0, 0), cB, voffB); PG8_STAGE(PG8_SA(0, 0), cA, voffA); PG8_STAGE(PG8_SB(0, 1), cB + hstepB, voffB); PG8_STAGE(PG8_SA(0, 1), cA + hstepA, voffA);
        if (wr == 1) PG8_BAR;
        PG8_WAIT_V(4); PG8_BAR;
        PG8_STAGE(PG8_SB(1, 0), cB + kstep, voffB); PG8_STAGE(PG8_SA(1, 0), cA + kstep, voffA); PG8_STAGE(PG8_SB(1, 1), cB + hstepB + kstep, voffB);
        PG8_WAIT_V(6); PG8_BAR;
    }
    for (;;) {
        const bool has_next = S.next(ui + 1, nxt);
        const char* nA = has_next ? (const char*)g.A + (size_t)nxt.z * g.sAz * 2 + (size_t)nxt.pm * tstepA : cA; const char* nB = has_next ? (const char*)g.Bt + (size_t)nxt.z * g.sBz * 2 + (size_t)nxt.pn * tstepB : cB;
        for (int t = 0; t < nt; t += 2) {
            const bool last = (t == nt - 2);
            const char* a1 = cA + (size_t)(t + 1) * kstep;
            const char* a2 = last ? nA : cA + (size_t)(t + 2) * kstep; const char* b2 = last ? nB : cB + (size_t)(t + 2) * kstep;
            const char* a3 = a2 + kstep; const char* b3 = b2 + kstep;
            if (last && has_next) S.a_ready(nxt);
            if constexpr (SP2) {
            PG8_LDB(B0, 0, 0); PG8_LDB(B1, 0, 1); PG8_SCHED; PG8_LDA(At, 0, 0); PG8_STAGE(PG8_SA(1, 1), a1 + hstepA, voffA);
            PG8_WAIT_V(8); PG8_WAIT_L(0); PG8_BAR; PG8_MMA(0, 0, At, B0); PG8_MMA(0, 1, At, B1); PG8_BAR; PG8_SCHED;
            PG8_LDA(At, 0, 1); PG8_STAGE(PG8_SB(0, 0), b2, voffB); PG8_STAGE(PG8_SB(0, 1), b2 + hstepB, voffB); PG8_STAGE(PG8_SA(0, 0), a2, voffA);
            PG8_WAIT_V(8); PG8_WAIT_L(0); PG8_BAR; PG8_MMA(1, 0, At, B0); PG8_MMA(1, 1, At, B1); PG8_BAR; PG8_SCHED;
            PG8_LDB(B0, 1, 0); PG8_LDB(B1, 1, 1); PG8_SCHED; PG8_LDA(At, 1, 0); PG8_STAGE(PG8_SA(0, 1), a2 + hstepA, voffA);
            PG8_WAIT_V(8); PG8_WAIT_L(0); PG8_BAR; PG8_MMA(0, 0, At, B0); PG8_MMA(0, 1, At, B1); PG8_BAR; PG8_SCHED;
            PG8_LDA(At, 1, 1); PG8_STAGE(PG8_SB(1, 0), b3, voffB); PG8_STAGE(PG8_SB(1, 1), b3 + hstepB, voffB); PG8_STAGE(PG8_SA(1, 0), a3, voffA);
            PG8_WAIT_V(8); PG8_WAIT_L(0); PG8_BAR; PG8_MMA(1, 0, At, B0); PG8_MMA(1, 1, At, B1); PG8_BAR; PG8_SCHED;
            } else {
            PG8_LDB(B0, 0, 0); PG8_SCHED; PG8_LDA(At, 0, 0); PG8_STAGE(PG8_SA(1, 1), a1 + hstepA, voffA);
            PG8_WAIT_L(8); PG8_BAR; PG8_WAIT_L(0); PG8_MMA(0, 0, At, B0); PG8_BAR; PG8_SCHED;
            PG8_LDB(B1, 0, 1); PG8_STAGE(PG8_SB(0, 0), b2, voffB);
            PG8_BAR; PG8_WAIT_L(0); PG8_MMA(0, 1, At, B1); PG8_BAR;
            PG8_LDA(At, 0, 1); PG8_STAGE(PG8_SA(0, 0), a2, voffA);
            PG8_BAR; PG8_WAIT_L(0); PG8_MMA(1, 0, At, B0); PG8_BAR; PG8_SCHED;
            PG8_STAGE(PG8_SB(0, 1), b2 + hstepB, voffB);
            PG8_WAIT_V(6); PG8_BAR; PG8_MMA(1, 1, At, B1); PG8_BAR;
            PG8_LDB(B0, 1, 0); PG8_SCHED; PG8_LDA(At, 1, 0); PG8_STAGE(PG8_SA(0, 1), a2 + hstepA, voffA);
            PG8_WAIT_L(8); PG8_BAR; PG8_WAIT_L(0); PG8_MMA(0, 0, At, B0); PG8_BAR; PG8_SCHED;
            PG8_LDB(B1, 1, 1); PG8_STAGE(PG8_SB(1, 0), b3, voffB);
            PG8_BAR; PG8_WAIT_L(0); PG8_MMA(0, 1, At, B1); PG8_BAR;
            PG8_LDA(At, 1, 1); PG8_STAGE(PG8_SA(1, 0), a3, voffA);
            PG8_BAR; PG8_WAIT_L(0); PG8_MMA(1, 0, At, B0); PG8_BAR; PG8_SCHED;
            PG8_STAGE(PG8_SB(1, 1), b3 + hstepB, voffB);
            PG8_WAIT_V(6); PG8_BAR; PG8_MMA(1, 1, At, B1); PG8_BAR;
            }
        }
        if constexpr (ALIGN_EPI) { if (wr == 0) PG8_BAR; }
        if constexpr (!Epi::AFTER_DRAIN) { E(acc, cur, wr, wc, fr, fq); S.done(cur); }
        if (!has_next) break;
#pragma unroll
        for (int a = 0; a < 2; ++a)
#pragma unroll
            for (int b = 0; b < 2; ++b)
#pragma unroll
                for (int m = 0; m < 4; ++m)
#pragma unroll
                    for (int n = 0; n < 2; ++n) acc[a][b][m][n] = (f32x4){0.f, 0.f, 0.f, 0.f};
        cur = nxt; cA = nA; cB = nB; ++ui; nt = S.unit_nt(cur, ntd);
        if constexpr (ALIGN_EPI) { if (wr == 1) PG8_BAR; }
    }
    PG8_WAIT_V(0);
    if constexpr (!ALIGN_EPI) { if (wr == 0) PG8_BAR; }
    PG8_BAR;
    if constexpr (Epi::AFTER_DRAIN) { E.fused(acc, cur, wr, wc, fr, fq, lds, wid, lane); S.done(cur); }
#undef PG8_SA
#undef PG8_SB
#undef PG8_STAGE
#undef PG8_LDA
#undef PG8_LDB
#undef PG8_MMA
#undef PG8_WAIT_V
#undef PG8_WAIT_L
#undef PG8_BAR
#undef PG8_SCHED
}
}
typedef unsigned short bf16_t;
typedef float f32x4 __attribute__((ext_vector_type(4)));
typedef unsigned u32x4 __attribute__((ext_vector_type(4)));
typedef unsigned u32x2 __attribute__((ext_vector_type(2)));
constexpr int DM = 1024, NB = 16, SEQ = 4096, MTOK = NB * SEQ, DFF = 2816, NHEAD = 16, HDIM = 64;
constexpr int SG = 64, SC = 16, SN = 64;
constexpr float NORM_EPS = 1e-6f;
constexpr int UA_LD = 1152;
constexpr size_t UA_G = (size_t)1024 * UA_LD;
constexpr size_t MiB = 1u << 20;
constexpr size_t WS_RS = 1 * MiB;
constexpr size_t WS_XS1 = 158 * MiB;
constexpr int CW_PCNT = 16384;
constexpr size_t WS_W = 2 * MiB;
constexpr size_t W_GU = (size_t)2 * DFF * DM;
constexpr size_t W_DN = (size_t)DM * DFF;
constexpr size_t W_FFN = W_GU + W_DN;
constexpr size_t W_SQ = (size_t)DM * DM;
constexpr size_t WO_FFN = 0, WO_SSM = 8 * W_FFN, WO_QKV = WO_SSM + 6 * W_SQ, WO_Q1 = WO_QKV + 3 * W_SQ, WO_O = WO_Q1 + W_SQ, WO_END = WO_O + 2 * W_SQ;
static_assert(WS_W + WO_END * 2 <= 160 * MiB, "weights fit");
constexpr size_t WS_XB = 160 * MiB;
constexpr size_t WS_HID = 288 * MiB;
constexpr size_t WS_Y = WS_HID, WS_Z = WS_HID + 128 * MiB, WS_O = WS_HID + 128 * MiB;
constexpr size_t WS_K = 640 * MiB, WS_V = 768 * MiB;
constexpr size_t WS_UA = 832 * MiB;
constexpr size_t WS_SP = 976 * MiB, WS_TAB = 980 * MiB, WS_END = 996 * MiB;
constexpr int SP_NG = 0, SP_LRE = 24576, SP_LIM = SP_LRE + 8192, SP_LDT = SP_LIM + 8192, SP_BRE = SP_LDT + 128, SP_BIM = SP_BRE + 131072, SP_CRE = SP_BIM + 131072, SP_CIM = SP_CRE + 131072, SP_SD = SP_CIM + 131072, SP_AR = SP_SD + 2048, SP_AI = SP_AR + 8192, SP_BBR = SP_AI + 8192, SP_BBI = SP_BBR + 131072, SP_END = SP_BBI + 131072;
static_assert((size_t)SP_END * 4 <= 4 * MiB, "SP fits");
constexpr size_t WS_KQT = WS_K, WS_PT = WS_K + 144 * MiB, WS_SLOC = WS_K + 160 * MiB;
constexpr size_t WS_PW = WS_TAB, WS_KD = WS_TAB + 5 * MiB;
static_assert((size_t)2 * 64 * 65 * 64 * 8 <= 5 * MiB && WS_SLOC + (size_t)64 * 1024 * 128 * 4 <= WS_UA && WS_UA + UA_G * 64 * 2 <= WS_SP, "tables fit");
static_assert(WS_HID + (size_t)MTOK * DFF * 2 <= WS_K, "hid fits");

typedef _Float16 h16x2 __attribute__((ext_vector_type(2)));
__device__ __forceinline__ float bf_lo(unsigned w) { return (float)__builtin_bit_cast(h16x2, w)[0]; }
__device__ __forceinline__ float bf_hi(unsigned w) { return (float)__builtin_bit_cast(h16x2, w)[1]; }
__device__ __forceinline__ float wave_sum(float v) {
#pragma unroll
    for (int o = 1; o < 64; o <<= 1) v += __shfl_xor(v, o);
    return v;
}
__device__ __forceinline__ float sigmoidf_(float v) { return __builtin_amdgcn_rcpf(1.0f + __expf(-v)); }
__device__ __forceinline__ float gelu_tanh(float x) { const float v = 1.5957691216057308f * (x + 0.044715f * x * x * x); return x * sigmoidf_(v); }
using pg8::Unit; using pg8::cvt_pk_bf16;
__device__ __forceinline__ float rs4(const float* ssq, int row) { const f32x4 q = *(const f32x4*)(ssq + (size_t)row * 4); return rsqrtf(((q[0] + q[1]) + (q[2] + q[3])) * (1.0f / DM) + NORM_EPS); }

#define LAS __attribute__((address_space(3)))
template <class Op> struct EpiGen {
    static constexpr bool PERM = true, AFTER_DRAIN = false;
    Op op; LAS float* rsl; mutable int cpm;
    __device__ __forceinline__ void operator()(const f32x4 (&acc)[2][2][4][2], const Unit& u, int wr, int wc, int fr, int fq) const {
        const int row0 = u.pm * 256 + wr * 64 + fr, cin = wc * 32 + 8 * fq;
        if constexpr (Op::ROW_RS) {
            if (u.pm != cpm) {
                const int t = (wr * 4 + wc) * 64 + fq * 16 + fr;
                __builtin_amdgcn_s_barrier();
                if (t < 256) rsl[t] = rs4(op.rs, u.pm * 256 + t);
                asm volatile("s_waitcnt lgkmcnt(0)" ::: "memory"); __builtin_amdgcn_s_barrier(); asm volatile("" ::: "memory");
                cpm = u.pm;
            }
        }
        if constexpr (Op::HAS_UNIT) op.unit_init(u, cin);
#pragma unroll
        for (int ai = 0; ai < 2; ++ai) {
            float rsc[4];
#pragma unroll
            for (int m = 0; m < 4; ++m) { if constexpr (Op::ROW_RS) rsc[m] = rsl[wr * 64 + fr + ai * 128 + m * 16] * op.factor(u); else rsc[m] = op.scale(u, row0 + ai * 128 + m * 16); }
            if constexpr (Op::HAS_PRE) {
                u32x4 pa[4], pb[4];
#pragma unroll
                for (int m = 0; m < 4; ++m) op.pre(u, row0 + ai * 128 + m * 16, cin, pa[m], pb[m]);
#pragma unroll
                for (int m = 0; m < 4; ++m) { op.run(u, row0 + ai * 128 + m * 16, cin, rsc[m], acc[ai][0][m][0], acc[ai][0][m][1], acc[ai][1][m][0], acc[ai][1][m][1], pa[m], pb[m]); asm volatile("" ::: "memory"); }
            } else {
#pragma unroll
                for (int m = 0; m < 4; ++m) { op(u, row0 + ai * 128 + m * 16, cin, rsc[m], acc[ai][0][m][0], acc[ai][0][m][1], acc[ai][1][m][0], acc[ai][1][m][1]); asm volatile("" ::: "memory"); }
            }
        }
    }
};
#ifndef ST_WT
#define ST_WT 0
#endif
#ifndef ST_NT
#define ST_NT 0
#endif
__device__ __forceinline__ void st16(void* p, u32x4 v) {
#if ST_WT
    asm volatile("global_store_dwordx4 %0, %1, off sc1\n\ts_nop 1" :: "v"(p), "v"(v) : "memory");
#elif ST_NT
    __builtin_nontemporal_store(v, (u32x4*)p);
#else
    *(u32x4*)p = v;
#endif
}
__device__ __forceinline__ u32x4 pack8(f32x4 a, f32x4 b) { u32x4 w; w.x = cvt_pk_bf16(a[0], a[1]); w.y = cvt_pk_bf16(a[2], a[3]); w.z = cvt_pk_bf16(b[0], b[1]); w.w = cvt_pk_bf16(b[2], b[3]); return w; }
struct OpSwiglu { const float* rs; bf16_t* H;
    static constexpr bool ROW_RS = true, HAS_PRE = false, HAS_UNIT = false;
    __device__ __forceinline__ float factor(const Unit& u) const { return 1.0f; }
    __device__ __forceinline__ float scale(const Unit&, int row) const { return rs4(rs, row); }
    __device__ __forceinline__ void operator()(const Unit& u, int row, int cin, float r, f32x4 g0, f32x4 g1, f32x4 u0, f32x4 u1) const {
        f32x4 h0, h1; const float r2 = r * r, rn = r * -1.4426950408889634f;
#pragma unroll
        for (int i = 0; i < 4; ++i) {
            const float ea = __builtin_amdgcn_exp2f(g0[i] * rn), eb = __builtin_amdgcn_exp2f(g1[i] * rn);
            h0[i] = (g0[i] * u0[i]) * (r2 * __builtin_amdgcn_rcpf(1.0f + ea)); h1[i] = (g1[i] * u1[i]) * (r2 * __builtin_amdgcn_rcpf(1.0f + eb)); }
        st16((H + (size_t)row * DFF + u.pn * 128 + cin), pack8(h0, h1));
    } };
struct OpStore { bf16_t* O; int ldc; const float* rs; float sc;
    static constexpr bool ROW_RS = false, HAS_PRE = false, HAS_UNIT = false;
    __device__ __forceinline__ float scale(const Unit&, int row) const { return rs ? rs4(rs, row) * sc : sc; }
    __device__ __forceinline__ void operator()(const Unit& u, int row, int cin, float r, f32x4 a0, f32x4 a1, f32x4 b0, f32x4 b1) const {
        bf16_t* p = O + (size_t)row * ldc + u.pn * 256 + cin;
        st16(p, pack8(a0 * r, a1 * r)); st16((p + 128), pack8(b0 * r, b1 * r));
    } };
struct OpQKV { bf16_t* Q; unsigned char* ws; const float* rs;
    static constexpr bool ROW_RS = true, HAS_PRE = false, HAS_UNIT = false;
    __device__ __forceinline__ float factor(const Unit& u) const { return ((u.pn >> 2) == 0 ? 0.18033688011112042f : 1.0f); }
    __device__ __forceinline__ float scale(const Unit& u, int row) const { return rs4(rs, row) * ((u.pn >> 2) == 0 ? 0.18033688011112042f : 1.0f); }
    __device__ __forceinline__ void operator()(const Unit& u, int row, int cin, float r, f32x4 a0, f32x4 a1, f32x4 b0, f32x4 b1) const {
        const int t = u.pn >> 2; bf16_t* base = (t == 0) ? Q : (bf16_t*)(ws + WS_K);
        bf16_t* p = base + (size_t)row * DM + (u.pn & 3) * 256 + cin;
        st16(p, pack8(a0 * r, a1 * r)); st16((p + 128), pack8(b0 * r, b1 * r));
    } };
struct OpUA { bf16_t* UA; const float* rs;
    static constexpr bool ROW_RS = true, HAS_PRE = false, HAS_UNIT = false;
    __device__ __forceinline__ float factor(const Unit& u) const { return 1.0f; }
    __device__ __forceinline__ float scale(const Unit&, int row) const { return rs4(rs, row); }
    __device__ __forceinline__ void operator()(const Unit& u, int row, int cin, float r, f32x4 a0, f32x4 a1, f32x4 b0, f32x4 b1) const {
        const int col = u.pn * 256 + cin; const size_t ro = (size_t)(row >> 6) * UA_LD + 128 + (row & 63) * 16 + (col & 15);
        st16((UA + (size_t)(col >> 4) * UA_G + ro), pack8(a0 * r, a1 * r));
        st16((UA + (size_t)((col + 128) >> 4) * UA_G + ro), pack8(b0 * r, b1 * r));
    } };
struct OpGLU { const bf16_t* Y; bf16_t* Z;
    static constexpr bool ROW_RS = false, HAS_PRE = true, HAS_UNIT = false;
    __device__ __forceinline__ float scale(const Unit&, int) const { return 1.0f; }
    __device__ __forceinline__ void pre(const Unit& u, int row, int cin, u32x4& pa, u32x4& pb) const { const size_t off = (size_t)row * DM + u.pn * 256 + cin; pa = *(const u32x4*)(Y + off); pb = *(const u32x4*)(Y + off + 128); }
    __device__ __forceinline__ void run(const Unit& u, int row, int cin, float, f32x4 a0, f32x4 a1, f32x4 b0, f32x4 b1, u32x4 pa, u32x4 pb) const {
        const size_t off = (size_t)row * DM + u.pn * 256 + cin;
#pragma unroll
        for (int hb = 0; hb < 2; ++hb) { const u32x4 y = hb ? pb : pa; const f32x4 c0 = hb ? b0 : a0, c1 = hb ? b1 : a1; f32x4 z0, z1;
            z0[0] = bf_lo(y.x) * sigmoidf_(c0[0]); z0[1] = bf_hi(y.x) * sigmoidf_(c0[1]); z0[2] = bf_lo(y.y) * sigmoidf_(c0[2]); z0[3] = bf_hi(y.y) * sigmoidf_(c0[3]);
            z1[0] = bf_lo(y.z) * sigmoidf_(c1[0]); z1[1] = bf_hi(y.z) * sigmoidf_(c1[1]); z1[2] = bf_lo(y.w) * sigmoidf_(c1[2]); z1[3] = bf_hi(y.w) * sigmoidf_(c1[3]);
            st16((Z + off + hb * 128), pack8(z0, z1)); }
    } };
struct OpVT { bf16_t* VT; const float* rs; mutable f32x4 r0, r1, r2, r3;
    static constexpr bool ROW_RS = false, HAS_PRE = false, HAS_UNIT = true;
    __device__ __forceinline__ float scale(const Unit&, int) const { return 1.0f; }
    __device__ __forceinline__ void unit_init(const Unit& u, int cin) const { const int col = u.pn * 256 + cin;
#pragma unroll
        for (int e = 0; e < 4; ++e) { r0[e] = rs4(rs, col + e); r1[e] = rs4(rs, col + 4 + e); r2[e] = rs4(rs, col + 128 + e); r3[e] = rs4(rs, col + 132 + e); } }
    __device__ __forceinline__ void operator()(const Unit& u, int row, int cin, float, f32x4 a0, f32x4 a1, f32x4 b0, f32x4 b1) const {
        const int col = u.pn * 256 + cin; bf16_t* p = VT + (size_t)row * MTOK + col;
        st16(p, pack8(a0 * r0, a1 * r1)); st16((p + 128), pack8(b0 * r2, b1 * r3));
    } };
struct OpSloc { float* SL;
    static constexpr bool ROW_RS = false, HAS_PRE = false, HAS_UNIT = false;
    __device__ __forceinline__ float scale(const Unit&, int) const { return 1.0f; }
    __device__ __forceinline__ void operator()(const Unit& u, int row, int cin, float, f32x4 a0, f32x4 a1, f32x4 b0, f32x4 b1) const {
        float* p = SL + ((size_t)u.z * 1024 + row) * 128 + cin; *(f32x4*)p = a0; *(f32x4*)(p + 4) = a1; (void)b0; (void)b1;
    } };
struct OpY { const bf16_t* UA; bf16_t* Y; const float* dsk; mutable f32x4 da0, da1, db0, db1;
    static constexpr bool ROW_RS = false, HAS_PRE = true, HAS_UNIT = true;
    __device__ __forceinline__ float scale(const Unit&, int) const { return 1.0f; }
    __device__ __forceinline__ void unit_init(const Unit& u, int cin) const { const int c0 = cin & 15; const float* d = dsk + u.z * 16 + c0; da0 = *(const f32x4*)d; da1 = *(const f32x4*)(d + 4); db0 = da0; db1 = da1; }
    __device__ __forceinline__ void pre(const Unit& u, int row, int cin, u32x4& pa, u32x4& pb) const { const bf16_t* p = UA + (size_t)u.z * UA_G + (size_t)row * UA_LD + 128 + u.pn * 256 + cin; pa = *(const u32x4*)p; pb = *(const u32x4*)(p + 128); }
    __device__ __forceinline__ void run(const Unit& u, int row, int cin, float, f32x4 a0, f32x4 a1, f32x4 b0, f32x4 b1, u32x4 pa, u32x4 pb) const {
#pragma unroll
        for (int hb = 0; hb < 2; ++hb) { const int n = u.pn * 256 + hb * 128 + cin, l = n >> 4, c0 = n & 15; const f32x4 v0 = hb ? b0 : a0, v1 = hb ? b1 : a1; const u32x4 uu = hb ? pb : pa;
            const f32x4 d0 = hb ? db0 : da0, d1 = hb ? db1 : da1; f32x4 y0, y1;
            y0[0] = gelu_tanh(v0[0] + d0[0] * bf_lo(uu.x)); y0[1] = gelu_tanh(v0[1] + d0[1] * bf_hi(uu.x)); y0[2] = gelu_tanh(v0[2] + d0[2] * bf_lo(uu.y)); y0[3] = gelu_tanh(v0[3] + d0[3] * bf_hi(uu.y));
            y1[0] = gelu_tanh(v1[0] + d1[0] * bf_lo(uu.z)); y1[1] = gelu_tanh(v1[1] + d1[1] * bf_hi(uu.z)); y1[2] = gelu_tanh(v1[2] + d1[2] * bf_lo(uu.w)); y1[3] = gelu_tanh(v1[3] + d1[3] * bf_hi(uu.w));
            st16((Y + ((size_t)row * 64 + l) * DM + u.z * 16 + c0), pack8(y0, y1)); }
    } };
struct EpiFused {
    static constexpr bool PERM = true, AFTER_DRAIN = false;
    bf16_t* x16; const float* g; float alpha; float* outf; float* xs1; float* ssq2; unsigned* cnt; unsigned want; LAS unsigned char* xl;
    mutable int cpn;
    __device__ __forceinline__ void operator()(const f32x4 (&acc)[2][2][4][2], const Unit& u, int wr, int wc, int fr, int fq) const {
        LAS float* P = (LAS float*)xl; LAS float* S = P + 1024;
        const int wid = wr * 4 + wc, lane = fq * 16 + fr, prow0 = u.pm * 256;
        const int col0 = u.pn * 256 + wc * 32 + 8 * fq;
        u32x4 xpa[4], xpb[4];
#pragma unroll
        for (int i = 0; i < 4; ++i) { const size_t off = (size_t)(prow0 + wr * 64 + i * 16 + fr) * DM + col0; xpa[i] = *(const u32x4*)(x16 + off); xpb[i] = *(const u32x4*)(x16 + off + 128); }
#pragma unroll
        for (int ai = 0; ai < 2; ++ai)
#pragma unroll
            for (int m = 0; m < 4; ++m) { float sq = 0.f;
#pragma unroll
                for (int bj = 0; bj < 2; ++bj)
#pragma unroll
                    for (int n = 0; n < 2; ++n) { const f32x4 v = acc[ai][bj][m][n]; sq += (v[0] * v[0] + v[1] * v[1]) + (v[2] * v[2] + v[3] * v[3]); }
                sq += __shfl_xor(sq, 16); sq += __shfl_xor(sq, 32);
                if (fq == 0) P[(ai * 128 + wr * 64 + m * 16 + fr) * 4 + wc] = sq; }
        asm volatile("s_waitcnt lgkmcnt(0)" ::: "memory"); __builtin_amdgcn_s_barrier(); asm volatile("" ::: "memory");
        const int row = wid * 32 + (lane & 31);
        unsigned long long* sl64 = (unsigned long long*)xs1 + (size_t)(prow0 + row) * 4;
        if (lane < 32) { const float t = (P[row * 4 + 0] + P[row * 4 + 1]) + (P[row * 4 + 2] + P[row * 4 + 3]);
            __hip_atomic_store(sl64 + u.pn, ((unsigned long long)want << 32) | (unsigned long long)__float_as_uint(t), __ATOMIC_RELAXED, __HIP_MEMORY_SCOPE_AGENT); }
        { unsigned sp = 0u; unsigned long long v0, v1, v2, v3;
            for (;;) {
                v0 = __hip_atomic_load(sl64 + 0, __ATOMIC_RELAXED, __HIP_MEMORY_SCOPE_AGENT); v1 = __hip_atomic_load(sl64 + 1, __ATOMIC_RELAXED, __HIP_MEMORY_SCOPE_AGENT);
                v2 = __hip_atomic_load(sl64 + 2, __ATOMIC_RELAXED, __HIP_MEMORY_SCOPE_AGENT); v3 = __hip_atomic_load(sl64 + 3, __ATOMIC_RELAXED, __HIP_MEMORY_SCOPE_AGENT);
                const bool ok = ((unsigned)(v0 >> 32) == want) && ((unsigned)(v1 >> 32) == want) && ((unsigned)(v2 >> 32) == want) && ((unsigned)(v3 >> 32) == want);
                if (__all(ok) || ++sp > (1u << 20)) break;
                __builtin_amdgcn_s_sleep(1);
            }
            if (lane < 32) { const float t0 = __uint_as_float((unsigned)v0), t1 = __uint_as_float((unsigned)v1), t2 = __uint_as_float((unsigned)v2), t3 = __uint_as_float((unsigned)v3);
                S[row] = alpha * rsqrtf(((t0 + t1) + (t2 + t3)) * (1.0f / DM) + NORM_EPS); } }
        asm volatile("s_waitcnt vmcnt(0) lgkmcnt(0)" ::: "memory"); __builtin_amdgcn_s_barrier(); asm volatile("" ::: "memory");
        LAS float* gl = (LAS float*)(xl + 5632);
        if (u.pn != cpn) { const int t_ = wid * 64 + lane; __builtin_amdgcn_s_barrier(); if (t_ < 256) gl[t_] = g[u.pn * 256 + t_]; asm volatile("s_waitcnt vmcnt(0) lgkmcnt(0)" ::: "memory"); __builtin_amdgcn_s_barrier(); asm volatile("" ::: "memory"); cpn = u.pn; }
        const f32x4 ga0 = *(const LAS f32x4*)(gl + wc * 32 + 8 * fq), ga1 = *(const LAS f32x4*)(gl + wc * 32 + 8 * fq + 4), gb0 = *(const LAS f32x4*)(gl + 128 + wc * 32 + 8 * fq), gb1 = *(const LAS f32x4*)(gl + 128 + wc * 32 + 8 * fq + 4);
#pragma unroll
        for (int ai = 0; ai < 2; ++ai) {
            if (ai == 1) {
#pragma unroll
                for (int i = 0; i < 4; ++i) { const size_t off = (size_t)(prow0 + 128 + wr * 64 + i * 16 + fr) * DM + col0; xpa[i] = *(const u32x4*)(x16 + off); xpb[i] = *(const u32x4*)(x16 + off + 128); }
            }
#pragma unroll
            for (int m = 0; m < 4; ++m) { const int rl = ai * 128 + wr * 64 + m * 16 + fr; const float r = S[rl]; const size_t off = (size_t)(prow0 + rl) * DM + col0;
                const u32x4 xa = xpa[m], xb = xpb[m];
                f32x4 a0 = {bf_lo(xa.x), bf_hi(xa.x), bf_lo(xa.y), bf_hi(xa.y)}, a1 = {bf_lo(xa.z), bf_hi(xa.z), bf_lo(xa.w), bf_hi(xa.w)}, b0 = {bf_lo(xb.x), bf_hi(xb.x), bf_lo(xb.y), bf_hi(xb.y)}, b1 = {bf_lo(xb.z), bf_hi(xb.z), bf_lo(xb.w), bf_hi(xb.w)};
                a0 += acc[ai][0][m][0] * r * ga0; a1 += acc[ai][0][m][1] * r * ga1; b0 += acc[ai][1][m][0] * r * gb0; b1 += acc[ai][1][m][1] * r * gb1;
                float sq = ((a0[0] * a0[0] + a0[1] * a0[1]) + (a0[2] * a0[2] + a0[3] * a0[3])) + ((a1[0] * a1[0] + a1[1] * a1[1]) + (a1[2] * a1[2] + a1[3] * a1[3]));
                sq += ((b0[0] * b0[0] + b0[1] * b0[1]) + (b0[2] * b0[2] + b0[3] * b0[3])) + ((b1[0] * b1[0] + b1[1] * b1[1]) + (b1[2] * b1[2] + b1[3] * b1[3]));
                if (outf) { float* o = outf + off; *(f32x4*)o = a0; *(f32x4*)(o + 4) = a1; *(f32x4*)(o + 128) = b0; *(f32x4*)(o + 132) = b1; }
                else { st16(x16 + off, pack8(a0, a1)); st16(x16 + off + 128, pack8(b0, b1)); }
                sq += __shfl_xor(sq, 16); sq += __shfl_xor(sq, 32);
                if (fq == 0) P[rl * 4 + wc] = sq;
                asm volatile("" ::: "memory"); }
        }
        asm volatile("s_waitcnt lgkmcnt(0)" ::: "memory"); __builtin_amdgcn_s_barrier(); asm volatile("" ::: "memory");
        if (lane < 32) ssq2[(size_t)(prow0 + row) * 4 + u.pn] = (P[row * 4 + 0] + P[row * 4 + 1]) + (P[row * 4 + 2] + P[row * 4 + 3]);
        asm volatile("s_waitcnt lgkmcnt(0)" ::: "memory"); __builtin_amdgcn_s_barrier(); asm volatile("" ::: "memory");
    }
};
constexpr int NWAVES = 8, LDS_BYTES = 147456, RING_BYTES = 131072;
struct Args { const float* in[21]; float* out; unsigned char* ws; int ph_lo, ph_hi; };
enum { I_X = 0, I_NG, I_WG, I_WU, I_WD, I_SWIN, I_LRE, I_LIM, I_LDT, I_BRE, I_BIM, I_CRE, I_CIM, I_SD, I_SWGLU, I_SWOUT, I_KVG, I_WK, I_WV, I_WQ, I_WO };

__device__ __forceinline__ unsigned pk2(float lo, float hi) { return cvt_pk_bf16(lo, hi); }
#define TR_LOAD(V, G, ITEM) do { const int kb_ = (ITEM) / nblk_, nb_ = (ITEM) % nblk_; \
    _Pragma("unroll") for (int i = 0; i < 8; ++i) { const int kk = 8 * i + (lane >> 3); V[i] = *(const f32x4*)(W + (size_t)(64 * kb_ + kk) * N + 32 * nb_ + (lane & 7) * 4); G[i] = gain ? gain[64 * kb_ + kk] : 1.0f; } } while (0)
#define TR_STORE(V, G, ITEM) do { const int kb_ = (ITEM) / nblk_, nb_ = (ITEM) % nblk_, k0 = 64 * kb_, n0 = 32 * nb_; \
    _Pragma("unroll") for (int i = 0; i < 8; ++i) { const int kk = 8 * i + (lane >> 3), nn = (lane & 7) * 4; const f32x4 v = V[i] * G[i]; \
        scr[kk * 33 + nn] = v[0]; scr[kk * 33 + nn + 1] = v[1]; scr[kk * 33 + nn + 2] = v[2]; scr[kk * 33 + nn + 3] = v[3]; } \
    asm volatile("s_waitcnt lgkmcnt(0)" ::: "memory"); \
    const int c = lane & 7; const int r0 = mode == 0 ? row_off + n0 : (256 * (n0 >> 7) + (n0 & 127) + (mode == 2 ? 128 : 0)); \
    _Pragma("unroll") for (int j = 0; j < 4; ++j) { const int n = (lane >> 3) + 8 * j; const LAS float* s = scr + (8 * c) * 33 + n; \
        u32x4 o; o.x = pk2(s[0 * 33], s[1 * 33]); o.y = pk2(s[2 * 33], s[3 * 33]); o.z = pk2(s[4 * 33], s[5 * 33]); o.w = pk2(s[6 * 33], s[7 * 33]); \
        *(u32x4*)(WT + (size_t)(r0 + n) * K + k0 + 8 * c) = o; } \
    asm volatile("s_waitcnt lgkmcnt(0)" ::: "memory"); } while (0)
__device__ __forceinline__ int conv_matrix(const float* W, int K, int N, const float* gain, int mode, bf16_t* WT, int row_off, LAS float* scr, int cstart, int NGW, int lane) {
    const int n_items = (K / 64) * (N / 32), nblk_ = N / 32; int it = cstart;
    f32x4 va[8], vb[8]; float ga[8], gb[8];
    if (it < n_items) TR_LOAD(va, ga, it);
    while (it < n_items) {
        if (it + NGW < n_items) TR_LOAD(vb, gb, it + NGW);
        TR_STORE(va, ga, it); it += NGW;
        if (it >= n_items) break;
        if (it + NGW < n_items) TR_LOAD(va, ga, it + NGW);
        TR_STORE(vb, gb, it); it += NGW;
    }
    return it - n_items;
}
#undef TR_LOAD
#undef TR_STORE
#define CONV(Wp, K_, N_, gain_, mode_, dst_, roff_) cstart = conv_matrix((Wp), (K_), (N_), (gain_), (mode_), (dst_), (roff_), scr, cstart, NGW, lane)

template <int MODE, int RR> __device__ __forceinline__ void row_update(const float* xin, bf16_t* x16, const bf16_t* T, float* rs, const float* g, float alpha, float* outf, int gw, int NGW, int lane) {
    f32x4 gv[4];
    if (MODE == 1) {
#pragma unroll
        for (int h = 0; h < 2; ++h) { gv[2 * h] = *(const f32x4*)(g + h * 512 + lane * 8); gv[2 * h + 1] = *(const f32x4*)(g + h * 512 + lane * 8 + 4); }
    }
    const int nblk_ = NGW / NWAVES, blk_ = gw / NWAVES; const bool g256_ = (nblk_ == 256);
    for (int it = 0; it < (MTOK / 256 + nblk_ - 1) / nblk_ * (32 / RR); ++it) {
        const int k_ = it / (32 / RR); const int pmi = g256_ ? ((blk_ & 7) * 32 + (blk_ >> 3)) : (blk_ + k_ * nblk_); if (pmi >= MTOK / 256) break;
        const int base = pmi * 256 + (gw % NWAVES) * 32 + (it % (32 / RR)) * RR;
        f32x4 xv[RR][4]; u32x4 tw[RR][2]; float red[RR];
#pragma unroll
        for (int rr = 0; rr < RR; ++rr) { const bf16_t* br = x16 + (size_t)(base + rr) * DM;
#pragma unroll
            for (int h = 0; h < 2; ++h) {
                if (MODE == 0) { const float* xr = xin + (size_t)(base + rr) * DM; xv[rr][2 * h] = *(const f32x4*)(xr + h * 512 + lane * 8); xv[rr][2 * h + 1] = *(const f32x4*)(xr + h * 512 + lane * 8 + 4); }
                else { const u32x4 xw = *(const u32x4*)(br + h * 512 + lane * 8); tw[rr][h] = *(const u32x4*)(T + (size_t)(base + rr) * DM + h * 512 + lane * 8);
                    xv[rr][2 * h] = (f32x4){bf_lo(xw.x), bf_hi(xw.x), bf_lo(xw.y), bf_hi(xw.y)}; xv[rr][2 * h + 1] = (f32x4){bf_lo(xw.z), bf_hi(xw.z), bf_lo(xw.w), bf_hi(xw.w)}; } } }
        if (MODE == 1) {
            float tv[RR][16];
#pragma unroll
            for (int rr = 0; rr < RR; ++rr) { float ss = 0.f;
#pragma unroll
                for (int h = 0; h < 2; ++h) { const u32x4 t = tw[rr][h];
                    tv[rr][8 * h + 0] = bf_lo(t.x); tv[rr][8 * h + 1] = bf_hi(t.x); tv[rr][8 * h + 2] = bf_lo(t.y); tv[rr][8 * h + 3] = bf_hi(t.y); tv[rr][8 * h + 4] = bf_lo(t.z); tv[rr][8 * h + 5] = bf_hi(t.z); tv[rr][8 * h + 6] = bf_lo(t.w); tv[rr][8 * h + 7] = bf_hi(t.w); }
#pragma unroll
                for (int i = 0; i < 16; ++i) ss += tv[rr][i] * tv[rr][i];
                red[rr] = ss; }
#pragma unroll
            for (int o = 1; o < 64; o <<= 1) {
#pragma unroll
                for (int rr = 0; rr < RR; ++rr) red[rr] += __shfl_xor(red[rr], o); }
#pragma unroll
            for (int rr = 0; rr < RR; ++rr) { const float r = alpha * rsqrtf(red[rr] * (1.0f / DM) + NORM_EPS);
#pragma unroll
                for (int h = 0; h < 2; ++h)
#pragma unroll
                    for (int i = 0; i < 4; ++i) { xv[rr][2 * h][i] += tv[rr][8 * h + i] * r * gv[2 * h][i]; xv[rr][2 * h + 1][i] += tv[rr][8 * h + 4 + i] * r * gv[2 * h + 1][i]; } }
        }
        if (MODE == 1 && outf != nullptr) {
#pragma unroll
            for (int rr = 0; rr < RR; ++rr) { float* xo = outf + (size_t)(base + rr) * DM;
#pragma unroll
                for (int h = 0; h < 2; ++h) { *(f32x4*)(xo + h * 512 + lane * 8) = xv[rr][2 * h]; *(f32x4*)(xo + h * 512 + lane * 8 + 4) = xv[rr][2 * h + 1]; } }
            continue;
        }
#pragma unroll
        for (int rr = 0; rr < RR; ++rr) { float s2 = 0.f;
#pragma unroll
            for (int j = 0; j < 4; ++j) s2 += (xv[rr][j][0] * xv[rr][j][0] + xv[rr][j][1] * xv[rr][j][1]) + (xv[rr][j][2] * xv[rr][j][2] + xv[rr][j][3] * xv[rr][j][3]);
            red[rr] = s2; }
#pragma unroll
        for (int o = 1; o < 64; o <<= 1) {
#pragma unroll
            for (int rr = 0; rr < RR; ++rr) red[rr] += __shfl_xor(red[rr], o); }
#pragma unroll
        for (int rr = 0; rr < RR; ++rr) {
            if (lane == 0) { if (MODE == 0) *(f32x4*)(rs + (size_t)(base + rr) * 4) = (f32x4){red[rr], 0.f, 0.f, 0.f}; else rs[base + rr] = rsqrtf(red[rr] * (1.0f / DM) + NORM_EPS); }
            bf16_t* br = x16 + (size_t)(base + rr) * DM;
#pragma unroll
            for (int h = 0; h < 2; ++h) st16((br + h * 512 + lane * 8), pack8(xv[rr][2 * h], xv[rr][2 * h + 1]));
        }
    }
}

__device__ __forceinline__ void sincos2pi(double r, double& s, double& c) {
    const double x = r * 6.283185307179586476925, x2 = x * x;
    double ts = 1.0 / 121645100408832000.0 * -1.0;
    double ps = -1.0 / 25852016738884976640000.0;
    ps = ps * x2 + 1.0 / 51090942171709440000.0;
    ps = ps * x2 - 1.0 / 121645100408832000.0;
    ps = ps * x2 + 1.0 / 355687428096000.0;
    ps = ps * x2 - 1.0 / 1307674368000.0;
    ps = ps * x2 + 1.0 / 6227020800.0;
    ps = ps * x2 - 1.0 / 39916800.0;
    ps = ps * x2 + 1.0 / 362880.0;
    ps = ps * x2 - 1.0 / 5040.0;
    ps = ps * x2 + 1.0 / 120.0;
    ps = ps * x2 - 1.0 / 6.0;
    ps = ps * x2 + 1.0;
    s = ps * x; (void)ts;
    double pc = 1.0 / 620448401733239439360000.0;
    pc = pc * x2 - 1.0 / 1124000727777607680000.0;
    pc = pc * x2 + 1.0 / 2432902008176640000.0;
    pc = pc * x2 - 1.0 / 6402373705728000.0;
    pc = pc * x2 + 1.0 / 20922789888000.0;
    pc = pc * x2 - 1.0 / 87178291200.0;
    pc = pc * x2 + 1.0 / 479001600.0;
    pc = pc * x2 - 1.0 / 3628800.0;
    pc = pc * x2 + 1.0 / 40320.0;
    pc = pc * x2 - 1.0 / 720.0;
    pc = pc * x2 + 1.0 / 24.0;
    pc = pc * x2 - 0.5;
    c = pc * x2 + 1.0;
}
__device__ __forceinline__ double exp_small(double v) {
    double p = 1.0 / 87178291200.0;
    p = p * v + 1.0 / 6227020800.0; p = p * v + 1.0 / 479001600.0; p = p * v + 1.0 / 39916800.0; p = p * v + 1.0 / 3628800.0; p = p * v + 1.0 / 362880.0; p = p * v + 1.0 / 40320.0;
    p = p * v + 1.0 / 5040.0; p = p * v + 1.0 / 720.0; p = p * v + 1.0 / 120.0; p = p * v + 1.0 / 24.0; p = p * v + 1.0 / 6.0; p = p * v + 0.5; p = p * v + 1.0; p = p * v + 1.0; return p;
}
__device__ __forceinline__ double exp_neg(double v) { double e = exp_small(v * 0.0625); e *= e; e *= e; e *= e; e *= e; return e; }
__device__ __forceinline__ void cpow_lam(double lrdt, double lidt, int d, double& re, double& im) {
    double m = (double)d * lrdt;
    double mag = 1.0;
    while (m < -8.0) { mag *= 3.3546262790251185e-4; m += 8.0; }
    while (m > 0.5) { mag *= 1.6487212707001282; m -= 0.5; }
    mag *= (m <= 0.0) ? exp_neg(m) : exp_small(m);
    double rev = (double)d * lidt * 0.15915494309189533577; rev -= __builtin_rint(rev);
    double s, c; sincos2pi(rev, s, c); re = mag * c; im = mag * s;
}

__device__ __forceinline__ void ssm_naive_phase(unsigned char* ws, int a, LAS unsigned char* lds, int wave, int lane) {
    if (wave >= 4) return;
    const float* sp = (const float*)(ws + WS_SP);
    const bf16_t* UA = (const bf16_t*)(ws + WS_UA); bf16_t* Y = (bf16_t*)(ws + WS_Y);
    LAS float* ul = (LAS float*)(lds + wave * 8192); LAS float* yl = ul + 1024;
    for (int task = blockIdx.x * 4 + wave; task < NB * SG; task += gridDim.x * 4) {
        const int b = task >> 6, g = task & 63, n = lane;
        float bbr[16], bbi[16], cr[16], ci[16];
        const int agn = (a * SG + g) * SN + n;
#pragma unroll
        for (int c4 = 0; c4 < 4; ++c4) { const f32x4 r4 = *(const f32x4*)(sp + SP_BBR + agn * SC + c4 * 4), i4 = *(const f32x4*)(sp + SP_BBI + agn * SC + c4 * 4);
#pragma unroll
            for (int e = 0; e < 4; ++e) { bbr[c4 * 4 + e] = r4[e]; bbi[c4 * 4 + e] = i4[e]; } }
#pragma unroll
        for (int c = 0; c < 16; ++c) { cr[c] = sp[SP_CRE + ((a * SG + g) * SC + c) * SN + n]; ci[c] = sp[SP_CIM + ((a * SG + g) * SC + c) * SN + n]; }
        const float ar = sp[SP_AR + agn], ai = sp[SP_AI + agn];
        const int cl = (lane >> 2) & 15; const float dl = sp[SP_SD + (a * SG + g) * SC + cl];
        float sr = 0.f, si = 0.f;
        for (int k = 0; k < 64; ++k) {
            { const bf16_t* src = UA + (size_t)g * UA_G + (size_t)(b * 64 + k) * UA_LD + 128 + lane * 16;
              const u32x4 p0 = *(const u32x4*)src, p1 = *(const u32x4*)(src + 8);
              LAS f32x4* d = (LAS f32x4*)(ul + lane * 16);
              d[0] = (f32x4){bf_lo(p0.x), bf_hi(p0.x), bf_lo(p0.y), bf_hi(p0.y)}; d[1] = (f32x4){bf_lo(p0.z), bf_hi(p0.z), bf_lo(p0.w), bf_hi(p0.w)};
              d[2] = (f32x4){bf_lo(p1.x), bf_hi(p1.x), bf_lo(p1.y), bf_hi(p1.y)}; d[3] = (f32x4){bf_lo(p1.z), bf_hi(p1.z), bf_lo(p1.w), bf_hi(p1.w)}; }
            asm volatile("s_waitcnt lgkmcnt(0)" ::: "memory");
#pragma unroll 2
            for (int j = 0; j < 64; ++j) {
                const LAS f32x4* up = (const LAS f32x4*)(ul + j * 16); const f32x4 u0 = up[0], u1 = up[1], u2 = up[2], u3 = up[3];
                const float uu[16] = {u0[0], u0[1], u0[2], u0[3], u1[0], u1[1], u1[2], u1[3], u2[0], u2[1], u2[2], u2[3], u3[0], u3[1], u3[2], u3[3]};
                float bur = 0.f, bui = 0.f;
#pragma unroll
                for (int c = 0; c < 16; ++c) { bur += bbr[c] * uu[c]; bui += bbi[c] * uu[c]; }
                const float nsr = ar * sr - ai * si + bur, nsi = ar * si + ai * sr + bui; sr = nsr; si = nsi;
                float v[16];
#pragma unroll
                for (int c = 0; c < 16; ++c) v[c] = sr * cr[c] - si * ci[c];
                float w8[8], w4[4], w2[2], w1;
                { const bool h = (lane & 32) != 0;
#pragma unroll
                  for (int i = 0; i < 8; ++i) { const float send = h ? v[i] : v[i + 8], keep = h ? v[i + 8] : v[i]; w8[i] = keep + __shfl_xor(send, 32); } }
                { const bool h = (lane & 16) != 0;
#pragma unroll
                  for (int i = 0; i < 4; ++i) { const float send = h ? w8[i] : w8[i + 4], keep = h ? w8[i + 4] : w8[i]; w4[i] = keep + __shfl_xor(send, 16); } }
                { const bool h = (lane & 8) != 0;
#pragma unroll
                  for (int i = 0; i < 2; ++i) { const float send = h ? w4[i] : w4[i + 2], keep = h ? w4[i + 2] : w4[i]; w2[i] = keep + __shfl_xor(send, 8); } }
                { const bool h = (lane & 4) != 0; const float send = h ? w2[0] : w2[1], keep = h ? w2[1] : w2[0]; w1 = keep + __shfl_xor(send, 4); }
                w1 += __shfl_xor(w1, 2); w1 += __shfl_xor(w1, 1);
                const float yv = gelu_tanh(w1 + dl * ul[j * 16 + cl]);
                if ((lane & 3) == 0) yl[j * 16 + cl] = yv;
            }
            asm volatile("s_waitcnt lgkmcnt(0)" ::: "memory");
            { const LAS f32x4* yp = (const LAS f32x4*)(yl + lane * 16); const f32x4 y0 = yp[0], y1 = yp[1], y2 = yp[2], y3 = yp[3];
              bf16_t* dst = Y + (size_t)(b * SEQ + k * 64 + lane) * DM + g * 16;
              st16(dst, pack8(y0, y1)); st16((dst + 8), pack8(y2, y3)); }
            asm volatile("s_waitcnt lgkmcnt(0)" ::: "memory");
        }
    }
}

__device__ __forceinline__ void attn_naive_phase(const bf16_t* Q, const bf16_t* K, const bf16_t* V, bf16_t* O) {
    for (int unit = blockIdx.x; unit < NB * NHEAD * (SEQ / 512); unit += gridDim.x) {
        const int bh = unit >> 3, tc = unit & 7, b = bh >> 4, h = bh & 15, t = tc * 512 + (int)threadIdx.x;
        const size_t row = (size_t)b * SEQ + t;
        float q[64], o[64];
        { const u32x4* qp = (const u32x4*)(Q + row * DM + h * 64);
#pragma unroll
          for (int i = 0; i < 8; ++i) { const u32x4 w = qp[i]; q[8 * i] = bf_lo(w.x); q[8 * i + 1] = bf_hi(w.x); q[8 * i + 2] = bf_lo(w.y); q[8 * i + 3] = bf_hi(w.y); q[8 * i + 4] = bf_lo(w.z); q[8 * i + 5] = bf_hi(w.z); q[8 * i + 6] = bf_lo(w.w); q[8 * i + 7] = bf_hi(w.w); } }
#pragma unroll
        for (int i = 0; i < 64; ++i) o[i] = 0.f;
        float R = 0.f;
        for (int s = t - 1; s >= 0; --s) {
            const u32x4* kp = (const u32x4*)(K + ((size_t)b * SEQ + s) * DM + h * 64);
            float z = 0.f;
#pragma unroll
            for (int i = 0; i < 8; ++i) { const u32x4 w = kp[i]; z += q[8 * i] * bf_lo(w.x) + q[8 * i + 1] * bf_hi(w.x) + q[8 * i + 2] * bf_lo(w.y) + q[8 * i + 3] * bf_hi(w.y) + q[8 * i + 4] * bf_lo(w.z) + q[8 * i + 5] * bf_hi(w.z) + q[8 * i + 6] * bf_lo(w.w) + q[8 * i + 7] * bf_hi(w.w); }
            const float sp = fmaxf(z, 0.f) + __logf(1.0f + __expf(-fabsf(z)));
            R -= sp;
            const float w = __expf(z + R);
            { const bf16_t* vt = V + (size_t)(h * 64) * MTOK + (size_t)b * SEQ + s;
#pragma unroll
              for (int i = 0; i < 64; ++i) o[i] += w * bf_lo((unsigned)vt[(size_t)i * MTOK]); }
            if (R < -40.f) break;
        }
        u32x4* op = (u32x4*)(O + row * DM + h * 64);
#pragma unroll
        for (int i = 0; i < 8; ++i) { u32x4 w; w.x = cvt_pk_bf16(o[8 * i], o[8 * i + 1]); w.y = cvt_pk_bf16(o[8 * i + 2], o[8 * i + 3]); w.z = cvt_pk_bf16(o[8 * i + 4], o[8 * i + 5]); w.w = cvt_pk_bf16(o[8 * i + 6], o[8 * i + 7]); op[i] = w; }
    }
}

typedef short bf16x8 __attribute__((ext_vector_type(8)));
typedef float f32x16 __attribute__((ext_vector_type(16)));
template <bool DIAG> __device__ __forceinline__ void sb_tile(const f32x16& st, float& R, int r32, int hi, u32x4& p0, u32x4& p1) {
    float L[16], gs[4], og[4], w[16];
#pragma unroll
    for (int r = 0; r < 16; ++r) { const float z = st[r]; const float lg = __builtin_amdgcn_logf(1.0f + __builtin_amdgcn_exp2f(-fabsf(z))); const float v = -(fmaxf(z, 0.f) + lg);
        if (DIAG) { const int kap = (r & 3) + 8 * (r >> 2) + 4 * hi; L[r] = (kap >= r32) ? 0.f : v; } else L[r] = v; }
#pragma unroll
    for (int g = 0; g < 4; ++g) { gs[g] = (L[4 * g] + L[4 * g + 1]) + (L[4 * g + 2] + L[4 * g + 3]); og[g] = __shfl_xor(gs[g], 32); }
    float above = 0.f;
#pragma unroll
    for (int g = 3; g >= 0; --g) {
        float run = R + above + (hi == 0 ? og[g] : 0.f);
#pragma unroll
        for (int e = 3; e >= 0; --e) { const int r = 4 * g + e; run += L[r]; const float wv = __builtin_amdgcn_exp2f(st[r] + run);
            if (DIAG) { const int kap = e + 8 * g + 4 * hi; w[r] = (kap >= r32) ? 0.f : wv; } else w[r] = wv; }
        above += gs[g] + og[g];
    }
    R += above;
    p0.x = cvt_pk_bf16(w[0], w[1]); p0.y = cvt_pk_bf16(w[2], w[3]); p0.z = cvt_pk_bf16(w[4], w[5]); p0.w = cvt_pk_bf16(w[6], w[7]);
    p1.x = cvt_pk_bf16(w[8], w[9]); p1.y = cvt_pk_bf16(w[10], w[11]); p1.z = cvt_pk_bf16(w[12], w[13]); p1.w = cvt_pk_bf16(w[14], w[15]);
}
__device__ __forceinline__ void attn_mfma_phase(const bf16_t* Q, const bf16_t* K, const bf16_t* VT, bf16_t* O, LAS unsigned char* lds, int gw, int NGW, int wave, int lane) {
    const int r32 = lane & 31, hi = lane >> 5;
    LAS bf16_t* stg = (LAS bf16_t*)(lds + wave * 16384);
    LAS unsigned char* kst = lds + wave * 16384 + 4096; LAS unsigned char* vst = kst + 32 * 144;
#define ATT_LOAD(KR, VR, RB, HH, S0) do { \
        _Pragma("unroll") for (int i = 0; i < 4; ++i) { KR[i] = *(const u32x4*)(K + ((RB) + (S0) + 8 * i + (lane >> 3)) * DM + (HH) * 64 + (lane & 7) * 8); \
            VR[i] = *(const u32x4*)(VT + (size_t)((HH) * 64 + 16 * i + (lane >> 2)) * MTOK + (RB) + (S0) + (lane & 3) * 8); } } while (0)
#define ATT_LOADQ(QF, RB, HH, T0) do { _Pragma("unroll") for (int d0 = 0; d0 < 4; ++d0) QF[d0] = *(const bf16x8*)(Q + ((RB) + (T0) + r32) * DM + (HH) * 64 + d0 * 16 + hi * 8); } while (0)
    const int NUNIT = NB * NHEAD * (SEQ / 32);
    bf16x8 qn[4]; u32x4 krn[4], vrn[4];
    if (gw < NUNIT) { const int bh_ = gw >> 7, t0_ = (gw & 127) * 32; const size_t rb_ = (size_t)(bh_ >> 4) * SEQ; ATT_LOADQ(qn, rb_, bh_ & 15, t0_); ATT_LOAD(krn, vrn, rb_, bh_ & 15, t0_); }
    for (int unit = gw; unit < NUNIT; unit += NGW) {
        const int qb = unit & 127, bh = unit >> 7, b = bh >> 4, h = bh & 15, t0 = qb * 32;
        const size_t rowb = (size_t)b * SEQ;
        bf16x8 qf[4]; u32x4 kr[4], vr[4];
#pragma unroll
        for (int i = 0; i < 4; ++i) { qf[i] = qn[i]; kr[i] = krn[i]; vr[i] = vrn[i]; }
        f32x16 o0, o1;
#pragma unroll
        for (int r = 0; r < 16; ++r) { o0[r] = 0.f; o1[r] = 0.f; }
        float R = 0.f;
        bool nxt_pending = (unit + NGW < NUNIT);
        for (int s0 = t0; s0 >= 0; s0 -= 32) {
            const bool more = s0 >= 32;
#pragma unroll
            for (int i = 0; i < 4; ++i) { *(LAS u32x4*)(kst + (8 * i + (lane >> 3)) * 144 + (lane & 7) * 16) = kr[i]; *(LAS u32x4*)(vst + (16 * i + (lane >> 2)) * 80 + (lane & 3) * 16) = vr[i]; }
            asm volatile("s_waitcnt lgkmcnt(0)" ::: "memory");
            if (more) ATT_LOAD(kr, vr, rowb, h, s0 - 32);
            if (nxt_pending) { nxt_pending = false; const int un_ = unit + NGW, bh_ = un_ >> 7, t0_ = (un_ & 127) * 32; const size_t rb_ = (size_t)(bh_ >> 4) * SEQ; ATT_LOADQ(qn, rb_, bh_ & 15, t0_); ATT_LOAD(krn, vrn, rb_, bh_ & 15, t0_); }
            bf16x8 kf[4], vf[2][2];
#pragma unroll
            for (int d0 = 0; d0 < 4; ++d0) kf[d0] = *(const LAS bf16x8*)(kst + r32 * 144 + d0 * 32 + hi * 16);
#pragma unroll
            for (int db = 0; db < 2; ++db)
#pragma unroll
                for (int ks = 0; ks < 2; ++ks) { const u32x2 lo_ = *(const LAS u32x2*)(vst + (r32 + 32 * db) * 80 + 32 * ks + 8 * hi), h8_ = *(const LAS u32x2*)(vst + (r32 + 32 * db) * 80 + 32 * ks + 8 * hi + 16);
                    const u32x4 v_ = {lo_.x, lo_.y, h8_.x, h8_.y}; vf[db][ks] = __builtin_bit_cast(bf16x8, v_); }
            asm volatile("s_waitcnt lgkmcnt(0)" ::: "memory");
            f32x16 st;
#pragma unroll
            for (int r = 0; r < 16; ++r) st[r] = 0.f;
#pragma unroll
            for (int d0 = 0; d0 < 4; ++d0) st = __builtin_amdgcn_mfma_f32_32x32x16_f16(__builtin_bit_cast(pg8::h16x8, kf[d0]), __builtin_bit_cast(pg8::h16x8, qf[d0]), st, 0, 0, 0);
            u32x4 p0, p1;
            if (s0 == t0) sb_tile<true>(st, R, r32, hi, p0, p1); else sb_tile<false>(st, R, r32, hi, p0, p1);
            const bf16x8 pa0 = __builtin_bit_cast(bf16x8, p0), pa1 = __builtin_bit_cast(bf16x8, p1);
            o0 = __builtin_amdgcn_mfma_f32_32x32x16_f16(__builtin_bit_cast(pg8::h16x8, pa0), __builtin_bit_cast(pg8::h16x8, vf[0][0]), o0, 0, 0, 0); o0 = __builtin_amdgcn_mfma_f32_32x32x16_f16(__builtin_bit_cast(pg8::h16x8, pa1), __builtin_bit_cast(pg8::h16x8, vf[0][1]), o0, 0, 0, 0);
            o1 = __builtin_amdgcn_mfma_f32_32x32x16_f16(__builtin_bit_cast(pg8::h16x8, pa0), __builtin_bit_cast(pg8::h16x8, vf[1][0]), o1, 0, 0, 0); o1 = __builtin_amdgcn_mfma_f32_32x32x16_f16(__builtin_bit_cast(pg8::h16x8, pa1), __builtin_bit_cast(pg8::h16x8, vf[1][1]), o1, 0, 0, 0);
            if (__all(R < -30.f)) break;
        }
#pragma unroll
        for (int r = 0; r < 16; ++r) { const int q = (r & 3) + 8 * (r >> 2) + 4 * hi; stg[q * 64 + r32] = (bf16_t)(cvt_pk_bf16(o0[r], 0.f) & 0xffffu); stg[q * 64 + 32 + r32] = (bf16_t)(cvt_pk_bf16(o1[r], 0.f) & 0xffffu); }
        asm volatile("s_waitcnt lgkmcnt(0)" ::: "memory");
#pragma unroll
        for (int i = 0; i < 4; ++i) { const int row = i * 8 + (lane >> 3), ch = lane & 7; const u32x4 v = *(const LAS u32x4*)(stg + row * 64 + ch * 8); *(u32x4*)(O + (rowb + t0 + row) * DM + h * 64 + ch * 8) = v; }
        asm volatile("s_waitcnt lgkmcnt(0)" ::: "memory");
    }
#undef ATT_LOAD
#undef ATT_LOADQ
}

__device__ __forceinline__ float bfly16(const float (&v)[16], int lane) {
    float w8[8], w4[4], w2[2], w1;
    { const bool h = (lane & 32) != 0;
#pragma unroll
      for (int i = 0; i < 8; ++i) { const float send = h ? v[i] : v[i + 8], keep = h ? v[i + 8] : v[i]; w8[i] = keep + __shfl_xor(send, 32); } }
    { const bool h = (lane & 16) != 0;
#pragma unroll
      for (int i = 0; i < 4; ++i) { const float send = h ? w8[i] : w8[i + 4], keep = h ? w8[i + 4] : w8[i]; w4[i] = keep + __shfl_xor(send, 16); } }
    { const bool h = (lane & 8) != 0;
#pragma unroll
      for (int i = 0; i < 2; ++i) { const float send = h ? w4[i] : w4[i + 2], keep = h ? w4[i + 2] : w4[i]; w2[i] = keep + __shfl_xor(send, 8); } }
    { const bool h = (lane & 4) != 0; const float send = h ? w2[0] : w2[1], keep = h ? w2[1] : w2[0]; w1 = keep + __shfl_xor(send, 4); }
    w1 += __shfl_xor(w1, 2); w1 += __shfl_xor(w1, 1); return w1;
}
__device__ __forceinline__ void ssm_expand_tables(unsigned char* ws, int a, int gt, int NGT) {
    const float* sp = (const float*)(ws + WS_SP); const float* PW = (const float*)(ws + WS_PW); const float* KD = (const float*)(ws + WS_KD);
    bf16_t* KQT = (bf16_t*)(ws + WS_KQT); bf16_t* PT = (bf16_t*)(ws + WS_PT);
#pragma unroll 4
    for (int idx = gt; idx < SG * 1024 * 128; idx += NGT) {
        const int cj = idx & 127, rowi = idx >> 7, g = rowi >> 10, n = rowi & 1023, l = n >> 4, c = n & 15, j = cj >> 1, c0 = (cj & 1) * 8, d = l - j, dc = d < 0 ? 0 : d;
        if (cj >= 32 * ((l >> 4) + 1)) continue;
        const float* kd = KD + ((size_t)((a * SG + g) * 64 + dc) * 16 + c) * 16 + c0; f32x4 v0 = *(const f32x4*)kd, v1 = *(const f32x4*)(kd + 4);
        if (d < 0) { v0 = (f32x4){0.f, 0.f, 0.f, 0.f}; v1 = v0; }
        st16((KQT + (size_t)rowi * UA_LD + 128 + cj * 8), pack8(v0, v1));
    }
#pragma unroll 2
    for (int idx = gt; idx < SG * 1024 * 16; idx += NGT) {
        const int ck = idx & 15, rowi = idx >> 4, g = rowi >> 10, n = rowi & 1023, l = n >> 4, c = n & 15, nb = (ck & 7) * 8; const bool imag = ck >= 8; f32x4 v0, v1;
        const float* cr = sp + SP_CRE + ((a * SG + g) * SC + c) * SN + nb; const float* ci = sp + SP_CIM + ((a * SG + g) * SC + c) * SN + nb; const float* pw = PW + ((size_t)((a * SG + g) * 65 + l + 1) * 64 + nb) * 2;
#pragma unroll
        for (int e = 0; e < 8; ++e) { const float Cr = cr[e], Ci = ci[e], pr = pw[2 * e], pi = pw[2 * e + 1]; const float val = imag ? -(Cr * pi + Ci * pr) : (Cr * pr - Ci * pi); if (e < 4) v0[e] = val; else v1[e - 4] = val; }
        st16((KQT + (size_t)rowi * UA_LD + ck * 8), pack8(v0, v1));
    }
#pragma unroll 2
    for (int idx = gt; idx < SG * 128 * 128; idx += NGT) {
        const int ck = idx & 127, rowi = idx >> 7, g = rowi >> 7, r = rowi & 127, np = r & 63, j = ck >> 1, c0 = (ck & 1) * 8; const bool imag = r >= 64;
        const float* pw = PW + ((size_t)((a * SG + g) * 65 + 63 - j) * 64 + np) * 2; const float pr = pw[0], pi = pw[1];
        const float* br = sp + SP_BBR + ((a * SG + g) * SN + np) * SC + c0; const float* bi = sp + SP_BBI + ((a * SG + g) * SN + np) * SC + c0; f32x4 v0, v1;
#pragma unroll
        for (int e = 0; e < 8; ++e) { const float val = imag ? (pr * bi[e] + pi * br[e]) : (pr * br[e] - pi * bi[e]); if (e < 4) v0[e] = val; else v1[e - 4] = val; }
        st16((PT + (size_t)rowi * 1024 + ck * 8), pack8(v0, v1));
    }
}
__device__ __forceinline__ void ssm_carry(unsigned char* ws, int a, int gt, int NGT) {
    const float* PW = (const float*)(ws + WS_PW); const float* SL = (const float*)(ws + WS_SLOC); bf16_t* UA = (bf16_t*)(ws + WS_UA);
    for (int idx = gt; idx < SG * NB * SN; idx += NGT) {
        const int n = idx & 63, b = (idx >> 6) & 15, g = idx >> 10;
        const float* pw = PW + ((size_t)((a * SG + g) * 65 + 64) * 64 + n) * 2; const float ar = pw[0], ai = pw[1];
        float sr = 0.f, si = 0.f;
#pragma unroll 8
        for (int k = 0; k < 64; ++k) { const int chunk = b * 64 + k; bf16_t* up = UA + (size_t)g * UA_G + (size_t)chunk * UA_LD; const float* sl = SL + ((size_t)g * 1024 + chunk) * 128;
            up[n] = (bf16_t)(cvt_pk_bf16(sr, 0.f) & 0xffffu); up[64 + n] = (bf16_t)(cvt_pk_bf16(si, 0.f) & 0xffffu);
            const float lr = sl[n], li = sl[64 + n]; const float nsr = ar * sr - ai * si + lr, nsi = ar * si + ai * sr + li; sr = nsr; si = nsi; }
    }
}
__device__ __forceinline__ void ssm_carry_unit(unsigned char* ws, int a, int g, int pm4, int t) {
    if (t >= 256) return;
    const float* PW = (const float*)(ws + WS_PW); const float* SL = (const float*)(ws + WS_SLOC); bf16_t* UA = (bf16_t*)(ws + WS_UA);
    const int n = t & 63, b = 4 * pm4 + (t >> 6);
    const float* pw = PW + ((size_t)((a * SG + g) * 65 + 64) * 64 + n) * 2; const float ar = pw[0], ai = pw[1];
    float sr = 0.f, si = 0.f;
#pragma unroll 8
    for (int k = 0; k < 64; ++k) { const int chunk = b * 64 + k; bf16_t* up = UA + (size_t)g * UA_G + (size_t)chunk * UA_LD; const float* sl = SL + ((size_t)g * 1024 + chunk) * 128;
        up[n] = (bf16_t)(cvt_pk_bf16(sr, 0.f) & 0xffffu); up[64 + n] = (bf16_t)(cvt_pk_bf16(si, 0.f) & 0xffffu);
        const float lr = sl[n], li = sl[64 + n]; const float nsr = ar * sr - ai * si + lr, nsi = ar * si + ai * sr + li; sr = nsr; si = nsi; }
}

#define GAS __attribute__((address_space(1)))
#define XB_TMO      128
#define XB_XCNT(j)  (256  + 64 * (j))
#define XB_XSUB(j)  (1280 + 64 * (j))
#define XB_XGEN(j)  (2304 + 64 * (j))
#define XB_TOP      3328
#define XB_TOPGEN   3392
#define XCD_BAR_WORDS 3456
#define XB_SPIN_CAP (1u << 18)

__device__ __forceinline__ unsigned xb_ld(unsigned* p)              { return __hip_atomic_load(p, __ATOMIC_RELAXED, __HIP_MEMORY_SCOPE_AGENT); }
__device__ __forceinline__ unsigned xb_add(unsigned* p, unsigned v) { return __hip_atomic_fetch_add(p, v, __ATOMIC_RELAXED, __HIP_MEMORY_SCOPE_AGENT); }
__device__ __forceinline__ unsigned xb_xcc_id() { return (unsigned)__builtin_amdgcn_s_getreg((3 << 11) | 20) & 0xFu; }
#define XB_SPIN(cond, bar) do { unsigned _sp = 0; while (cond) { __builtin_amdgcn_s_sleep(1); \
    if ((++_sp & 255u) == 0u) { if (xb_ld(&(bar)[XB_TMO])) break; if (_sp > XB_SPIN_CAP) { atomicAdd(&(bar)[XB_TMO], 1u); break; } } } } while (0)

struct XcdBarrier {
    unsigned* bar; unsigned x;
    volatile LAS unsigned* st;
};

__device__ __forceinline__ XcdBarrier xcd_barrier_post(unsigned* bar, volatile LAS unsigned* st) {
    XcdBarrier b; b.bar = bar; b.x = xb_xcc_id(); b.st = st;
    if (threadIdx.x == 0) (void)xb_add(&bar[XB_XCNT(b.x)], 1u);
    return b;
}
__device__ __forceinline__ void xcd_barrier_complete(unsigned* bar, unsigned x, unsigned& nloc, unsigned& nx) {
    const unsigned G = gridDim.x * gridDim.y * gridDim.z;
    unsigned sum, cnt, mine, sp = 0u;
    for (;;) {
        sum = 0u; cnt = 0u; mine = 0u;
#pragma unroll
        for (unsigned j = 0; j < 16; ++j) { const unsigned c = xb_ld(&bar[XB_XCNT(j)]); sum += c; cnt += (c > 0u) ? 1u : 0u; mine = (j == x) ? c : mine; }
        if (sum == G) break;
        __builtin_amdgcn_s_sleep(1);
        if ((++sp & 255u) == 0u) { if (xb_ld(&bar[XB_TMO])) break; if (sp > XB_SPIN_CAP) { atomicAdd(&bar[XB_TMO], 1u); break; } }
    }
    nloc = mine > 0u ? mine : 1u; nx = cnt > 0u ? cnt : 1u;
}

__device__ __forceinline__ void xcd_barrier(const XcdBarrier& b) {
    asm volatile("s_waitcnt vmcnt(0)" ::: "memory");
    __syncthreads();
    if (threadIdx.x == 0) {
        unsigned* bar = b.bar;
        __builtin_amdgcn_s_waitcnt(0);
        unsigned nloc = b.st[0], nx = b.st[1];
        if (nloc == 0u) { xcd_barrier_complete(bar, b.x, nloc, nx); b.st[0] = nloc; b.st[1] = nx; }
        const unsigned old = xb_add(&bar[XB_XSUB(b.x)], 1u);
        const unsigned gen = old / nloc;
        if (old + 1u == (gen + 1u) * nloc) {
            __builtin_amdgcn_fence(__ATOMIC_RELEASE, "agent");
            asm volatile("s_waitcnt vmcnt(0)" ::: "memory");
            const unsigned og = xb_add(&bar[XB_TOP], 1u);
            const unsigned tg = og / nx;
            if (og + 1u == (tg + 1u) * nx) xb_add(&bar[XB_TOPGEN], 1u);
            else XB_SPIN(xb_ld(&bar[XB_TOPGEN]) == tg, bar);
            __builtin_amdgcn_fence(__ATOMIC_ACQUIRE, "agent");
            xb_add(&bar[XB_XGEN(b.x)], 1u);
            asm volatile("s_waitcnt vmcnt(0)" ::: "memory");
        } else {
            XB_SPIN(xb_ld(&bar[XB_XGEN(b.x)]) == gen, bar);
            __builtin_amdgcn_fence(__ATOMIC_ACQUIRE, "agent");
            asm volatile("s_waitcnt vmcnt(0)" ::: "memory");
        }
    }
    __syncthreads();
}

constexpr int CW_GMASK = 4096, CW_GCNT = 4096 + 512;
__device__ __forceinline__ void group_barrier(unsigned* cnt) {
    asm volatile("s_waitcnt vmcnt(0)" ::: "memory");
    __syncthreads();
    if (threadIdx.x == 0) {
        const unsigned old = __hip_atomic_fetch_add(cnt, 1u, __ATOMIC_RELAXED, __HIP_MEMORY_SCOPE_AGENT), target = (old / 32u + 1u) * 32u; unsigned sp = 0u;
        while (__hip_atomic_load(cnt, __ATOMIC_RELAXED, __HIP_MEMORY_SCOPE_AGENT) < target) { __builtin_amdgcn_s_sleep(1); if (++sp > (1u << 22)) break; }
        __builtin_amdgcn_fence(__ATOMIC_ACQUIRE, "agent");
        asm volatile("s_waitcnt vmcnt(0)" ::: "memory");
    }
    __syncthreads();
}

constexpr int NS5 = 9, NMIX5 = 5, NAT = 7;
constexpr int NPH = 1 + 2 * NS5 + 2 * NAT;
template <class Op> __device__ __forceinline__ void run_gemm(LAS unsigned char* lds, const bf16_t* A, const bf16_t* Bt, int M, int N, int K, const Op& op) {
    pg8::Gemm g{A, Bt, M, N, K, K, K, 0, 0}; pg8::StaticOrder S; S.init(M, N, (int)gridDim.x, (int)blockIdx.x); EpiGen<Op> E{op, (LAS float*)(lds + RING_BYTES + 8192), -1};
    pg8::gemm_phase<EpiGen<Op>, pg8::StaticOrder, true, true>(lds, g, S, E);
}
template <class Op> __device__ __forceinline__ void run_gemm_n(LAS unsigned char* lds, const bf16_t* A, const bf16_t* Bt, int M, int N, int K, const Op& op) {
    pg8::Gemm g{A, Bt, M, N, K, K, K, 0, 0}; pg8::StaticOrder S; S.init(M, N, (int)gridDim.x, (int)blockIdx.x); EpiGen<Op> E{op, (LAS float*)(lds + RING_BYTES + 8192), -1};
    pg8::gemm_phase<EpiGen<Op>, pg8::StaticOrder, true, true>(lds, g, S, E);
}
__device__ __forceinline__ void run_gemm_fused(LAS unsigned char* lds, const bf16_t* A, const bf16_t* Bt, int K, const EpiFused& E) {
    pg8::Gemm g{A, Bt, MTOK, DM, K, K, K, 0, 0}; pg8::StaticOrder S; S.init(MTOK, DM, (int)gridDim.x, (int)blockIdx.x);
    pg8::gemm_phase<EpiFused, pg8::StaticOrder, true, true>(lds, g, S, E);
}
template <class Op> __device__ __forceinline__ void run_gemm_b(LAS unsigned char* lds, const bf16_t* A, const bf16_t* Bt, int M, int N, int K, int lda, int ldb, size_t sAz, size_t sBz, int nz, int tri, const Op& op) {
    pg8::Gemm g{A, Bt, M, N, K, lda, ldb, sAz, sBz}; pg8::BatchOrder S; S.init(M, N, nz, (int)gridDim.x, (int)blockIdx.x, tri); EpiGen<Op> E{op, (LAS float*)(lds + RING_BYTES + 8192), -1};
    pg8::gemm_phase<EpiGen<Op>, pg8::BatchOrder, true, true>(lds, g, S, E);
}
__global__ void __launch_bounds__(NWAVES * 64, 2) mk_fwd(Args A) {
    extern __shared__ __attribute__((aligned(16))) unsigned char lds_raw[];
    LAS unsigned char* lds = (LAS unsigned char*)lds_raw;
    const int tid = threadIdx.x, lane = tid & 63, wave = __builtin_amdgcn_readfirstlane(tid >> 6);
    const int gw = blockIdx.x * NWAVES + wave, NGW = gridDim.x * NWAVES;
    unsigned char* ws = A.ws;
    float* RS = (float*)(ws + WS_RS); bf16_t* Wb = (bf16_t*)(ws + WS_W); bf16_t* XB = (bf16_t*)(ws + WS_XB); bf16_t* HID = (bf16_t*)(ws + WS_HID);
    bf16_t* UA = (bf16_t*)(ws + WS_UA); bf16_t* Yb = (bf16_t*)(ws + WS_Y); bf16_t* Zb = (bf16_t*)(ws + WS_Z);
    bf16_t* Qb = (bf16_t*)A.out + (size_t)MTOK * DM; bf16_t* Ob = (bf16_t*)(ws + WS_O); bf16_t* Kb = (bf16_t*)(ws + WS_K); bf16_t* Vb = (bf16_t*)(ws + WS_V);
    float* X = A.out; const float* SP = (const float*)(ws + WS_SP); const float* NG = SP + SP_NG;
    volatile LAS unsigned* misc = (volatile LAS unsigned*)(lds + RING_BYTES + 64);
    if (tid < 4) misc[tid] = 0u;
    __syncthreads();
    if (tid == 0) __hip_atomic_fetch_or((unsigned*)A.ws + CW_GMASK + 64 * (blockIdx.x & 7), 1u << xb_xcc_id(), __ATOMIC_RELAXED, __HIP_MEMORY_SCOPE_AGENT);
    (void)xcd_barrier_post((unsigned*)A.ws, misc);
    int p0 = A.ph_lo;
    if (p0 == 0) {
        {
            LAS float* scr = (LAS float*)(lds + wave * 16384); int cstart = gw;
            const float* NGi = A.in[I_NG];
            for (int l = 0; l < 4; ++l) for (int j = 0; j < 2; ++j) { const int lj = l * 2 + j; bf16_t* wgu = Wb + WO_FFN + (size_t)lj * W_FFN; const float* gn = NGi + (l * 6 + (j ? 4 : 0)) * DM;
                CONV(A.in[I_WG] + (size_t)lj * DM * DFF, DM, DFF, gn, 1, wgu, 0); CONV(A.in[I_WU] + (size_t)lj * DM * DFF, DM, DFF, gn, 2, wgu, 0);
                CONV(A.in[I_WD] + (size_t)lj * DFF * DM, DFF, DM, (const float*)nullptr, 0, wgu + W_GU, 0); }
            for (int a = 0; a < 2; ++a) { bf16_t* w = Wb + WO_SSM + (size_t)a * 3 * W_SQ;
                CONV(A.in[I_SWIN] + (size_t)a * W_SQ, DM, DM, NGi + (a * 6 + 2) * DM, 0, w, 0); CONV(A.in[I_SWGLU] + (size_t)a * W_SQ, DM, DM, (const float*)nullptr, 0, w + W_SQ, 0);
                CONV(A.in[I_SWOUT] + (size_t)a * W_SQ, DM, DM, (const float*)nullptr, 0, w + 2 * W_SQ, 0); }
            CONV(A.in[I_WQ], DM, DM, NGi + (2 * 6 + 2) * DM, 0, Wb + WO_QKV, 0); CONV(A.in[I_WK], DM, DM, A.in[I_KVG], 0, Wb + WO_QKV, DM); CONV(A.in[I_WV], DM, DM, A.in[I_KVG], 0, Wb + WO_QKV, 2 * DM);
            CONV(A.in[I_WQ] + W_SQ, DM, DM, NGi + (3 * 6 + 2) * DM, 0, Wb + WO_Q1, 0);
            CONV(A.in[I_WO], DM, DM, (const float*)nullptr, 0, Wb + WO_O, 0); CONV(A.in[I_WO] + W_SQ, DM, DM, (const float*)nullptr, 0, Wb + WO_O + W_SQ, 0);
            float* spw = (float*)(ws + WS_SP); const int gt = blockIdx.x * (NWAVES * 64) + tid, NGT = gridDim.x * NWAVES * 64;
#define COPYP(idx, off, n) for (int i_ = gt; i_ < (n); i_ += NGT) spw[(off) + i_] = A.in[idx][i_]
            for (int i_ = gt; i_ < (int)((size_t)MTOK * 4 * 8 / 16); i_ += NGT) ((u32x4*)(ws + WS_XS1))[i_] = (u32x4){0u, 0u, 0u, 0u};
            COPYP(I_NG, SP_NG, 24576); COPYP(I_LRE, SP_LRE, 8192); COPYP(I_LIM, SP_LIM, 8192); COPYP(I_LDT, SP_LDT, 128); COPYP(I_BRE, SP_BRE, 131072); COPYP(I_BIM, SP_BIM, 131072);
            COPYP(I_CRE, SP_CRE, 131072); COPYP(I_CIM, SP_CIM, 131072); COPYP(I_SD, SP_SD, 2048);
            for (int i = gt; i < 2 * SG * SN; i += NGT) {
                const int ag = i >> 6;
                const double dt = (double)expf(A.in[I_LDT][ag]);
                const double lr = A.in[I_LRE][i], li = A.in[I_LIM][i];
                double are, aim; cpow_lam(lr * dt, li * dt, 1, are, aim);
                const double den = lr * lr + li * li, nr = are - 1.0, ni = aim;
                const double fre = (nr * lr + ni * li) / den, fim = (ni * lr - nr * li) / den;
                spw[SP_AR + i] = (float)are; spw[SP_AI + i] = (float)aim;
                for (int c = 0; c < 16; ++c) { const double br = A.in[I_BRE][(size_t)i * SC + c], bi = A.in[I_BIM][(size_t)i * SC + c];
                    spw[SP_BBR + i * SC + c] = (float)(fre * br - fim * bi); spw[SP_BBI + i * SC + c] = (float)(fre * bi + fim * br); }
            }
            {
                float* PWw = (float*)(ws + WS_PW); float* KDw = (float*)(ws + WS_KD);
                for (int i = gt; i < 2 * SG * 65 * SN; i += NGT) { const int n = i & 63, d = (i >> 6) % 65, ag = (i >> 6) / 65;
                    const double dt = (double)expf(A.in[I_LDT][ag]); const double lr = A.in[I_LRE][ag * SN + n], li = A.in[I_LIM][ag * SN + n];
                    double pr, pi; cpow_lam(lr * dt, li * dt, d, pr, pi); PWw[2 * (size_t)i] = (float)pr; PWw[2 * (size_t)i + 1] = (float)pi; }
                for (int task = gw; task < 2 * SG * 64; task += NGW) { const int ag = task >> 6, d = task & 63, n = lane, i = ag * SN + n;
                    const double dt = (double)expf(A.in[I_LDT][ag]); const double lr = A.in[I_LRE][i], li = A.in[I_LIM][i];
                    double are, aim, pr, pi; cpow_lam(lr * dt, li * dt, 1, are, aim); cpow_lam(lr * dt, li * dt, d, pr, pi);
                    const double den = lr * lr + li * li, nr = are - 1.0, ni = aim; const double fre = (nr * lr + ni * li) / den, fim = (ni * lr - nr * li) / den;
                    float tre[16], tim[16];
#pragma unroll
                    for (int c = 0; c < 16; ++c) { const double br = A.in[I_BRE][(size_t)i * SC + c], bi = A.in[I_BIM][(size_t)i * SC + c]; const double bbr = fre * br - fim * bi, bbi = fre * bi + fim * br;
                        tre[c] = (float)(pr * bbr - pi * bbi); tim[c] = (float)(pr * bbi + pi * bbr); }
                    const int cl = (lane >> 2) & 15;
                    for (int c = 0; c < 16; ++c) { const float Cr = A.in[I_CRE][((size_t)ag * SC + c) * SN + n], Ci = A.in[I_CIM][((size_t)ag * SC + c) * SN + n]; float v[16];
#pragma unroll
                        for (int e = 0; e < 16; ++e) v[e] = Cr * tre[e] - Ci * tim[e];
                        const float tot = bfly16(v, lane); if ((lane & 3) == 0) KDw[((size_t)task * 16 + c) * 16 + cl] = tot; }
                }
            }
            row_update<0, 4>(A.in[I_X], XB, nullptr, RS, nullptr, 0.f, nullptr, gw, NGW, lane); PROBE_RU_X
        }
        p0 = 1;
        if (A.ph_hi > 1) { cg::this_grid().sync(); }
        if (tid == 0) {
            unsigned ok = (gridDim.x == 256u) ? 1u : 0u;
            for (int x = 0; x < 8; ++x) { const unsigned m = __hip_atomic_load((unsigned*)A.ws + CW_GMASK + 64 * x, __ATOMIC_RELAXED, __HIP_MEMORY_SCOPE_AGENT); if (__builtin_popcount(m) != 1) ok = 0u; }
            misc[2] = ok; }
        __syncthreads();
    }
    for (int p = p0; p < A.ph_hi; ++p) {
        {
            unsigned char* ws = A.ws; asm volatile("" : "+s"(ws));
            int lane_p = lane, gw_p = gw; asm volatile("" : "+v"(lane_p)); asm volatile("" : "+s"(gw_p));
            float* RS = (float*)(ws + WS_RS); bf16_t* Wb = (bf16_t*)(ws + WS_W); bf16_t* XB = (bf16_t*)(ws + WS_XB); bf16_t* HID = (bf16_t*)(ws + WS_HID);
            bf16_t* UA = (bf16_t*)(ws + WS_UA); bf16_t* Yb = (bf16_t*)(ws + WS_Y); bf16_t* Zb = (bf16_t*)(ws + WS_Z);
            bf16_t* Qb = (bf16_t*)A.out + (size_t)MTOK * DM; bf16_t* Ob = (bf16_t*)(ws + WS_O); bf16_t* Kb = (bf16_t*)(ws + WS_K); bf16_t* Vb = (bf16_t*)(ws + WS_V);
            float* X = A.out; const float* SP = (const float*)(ws + WS_SP); const float* NG = SP + SP_NG;
            const int q = p - 1, layer = q < 2 * NS5 ? q / NS5 : 2 + (q - 2 * NS5) / NAT, s = q < 2 * NS5 ? q % NS5 : (q - 2 * NS5) % NAT;
            const int nmix = layer < 2 ? NMIX5 : 3;
            const int sub = (s < 2) ? 0 : (s < 2 + nmix ? 1 : 2);
            EpiFused EF; EF.x16 = XB; EF.g = NG + (layer * 6 + (sub == 0 ? 1 : (sub == 1 ? 3 : 5))) * DM; EF.alpha = (sub == 1) ? 1.0f : 0.5f; EF.outf = (layer == 3 && sub == 2) ? X : nullptr;
            EF.xs1 = (float*)(ws + WS_XS1); EF.ssq2 = RS; EF.cnt = (unsigned*)ws + CW_PCNT; EF.want = 32u * (unsigned)(layer * 3 + sub + 1); EF.xl = lds + RING_BYTES + 1024; EF.cpn = -1;
            if (s < 2 || s >= 2 + nmix) {
                const int j = s < 2 ? 0 : 1, st = s < 2 ? s : s - 2 - nmix; const bf16_t* wgu = Wb + WO_FFN + (size_t)(layer * 2 + j) * W_FFN;
                if (st == 0) run_gemm(lds, XB, wgu, MTOK, 2 * DFF, DM, OpSwiglu{RS, HID});
                else run_gemm_fused(lds, HID, wgu + W_GU, DFF, EF);
            } else if (layer < 2) {
                const bf16_t* w = Wb + WO_SSM + (size_t)layer * 3 * W_SQ; const int st = s - 2;
                if (st == 0) { run_gemm(lds, XB, w, MTOK, DM, DM, OpUA{UA, RS}); int tid_p = tid; asm volatile("" : "+v"(tid_p)); const int gt_l = blockIdx.x * (NWAVES * 64) + tid_p; ssm_expand_tables(ws, layer, gt_l, (int)gridDim.x * NWAVES * 64); }
                else if (st == 1) {
                    run_gemm_b(lds, UA + 128, (const bf16_t*)(ws + WS_PT), 1024, 256, 1024, UA_LD, 1024, UA_G, (size_t)128 * 1024, SG, 0, OpSloc{(float*)(ws + WS_SLOC)});
                    asm volatile("s_waitcnt vmcnt(0)" ::: "memory"); __syncthreads();
                    int tid_p = tid; asm volatile("" : "+v"(tid_p));
                    for (int L = blockIdx.x; L < SG * 4; L += gridDim.x) ssm_carry_unit(ws, layer, L >> 2, L & 3, tid_p); }
                else if (st == 2) run_gemm_b(lds, UA, (const bf16_t*)(ws + WS_KQT), 1024, 1024, UA_LD, UA_LD, UA_LD, UA_G, (size_t)1024 * UA_LD, SG, 1, OpY{UA, Yb, SP + SP_SD + layer * SG * SC});
                else if (st == 3) run_gemm(lds, Yb, w + W_SQ, MTOK, DM, DM, OpGLU{Yb, Zb});
                else run_gemm_fused(lds, Zb, w + 2 * W_SQ, DM, EF);
            } else {
                const int bl = layer - 2, st = s - 2;
                if (st == 0) { if (bl == 0) { run_gemm(lds, XB, Wb + WO_QKV, MTOK, 2 * DM, DM, OpQKV{Qb, ws, RS}); run_gemm_n(lds, Wb + WO_QKV + 2 * W_SQ, XB, DM, MTOK, DM, OpVT{Vb, RS}); } else run_gemm(lds, XB, Wb + WO_Q1, MTOK, DM, DM, OpQKV{Qb, ws, RS}); }
                else if (st == 1) { ATTN_CALL; }
                else run_gemm_fused(lds, Ob, Wb + WO_O + (size_t)bl * W_SQ, DM, EF);
            }
            (void)lane_p; (void)gw_p; (void)Kb;
        }
        if (p + 1 < A.ph_hi) {
            const int q_ = p - 1, s_ = q_ < 2 * NS5 ? q_ % NS5 : (q_ - 2 * NS5) % NAT; const bool s5_ = q_ < 2 * NS5;
            const bool seam = s5_ ? (s_ >= 2 && s_ <= 4) || s_ == 6 : (s_ >= 2 && s_ <= 4);
            const bool fast = misc[2] != 0u;
            if (seam || !fast) { XcdBarrier xb_; xb_.bar = (unsigned*)A.ws; xb_.x = xb_xcc_id(); xb_.st = (volatile LAS unsigned*)(lds + RING_BYTES + 64); xcd_barrier(xb_); }
            else group_barrier((unsigned*)A.ws + CW_GCNT + 64 * (blockIdx.x & 7));
        }
    }
}

extern "C" void kernel_launch(void* const* d_in, const int* in_sizes, int n_in, void* d_out, int out_size, void* d_ws, size_t ws_size, hipStream_t stream) {
    static int grid = 0;
    if (grid == 0) {
        if (n_in != 21 || out_size != MTOK * DM || ws_size < WS_END) { fprintf(stderr, "kernel_launch: unexpected shapes (n_in %d out %d ws %zu)\n", n_in, out_size, ws_size); grid = -1; return; }
        int dev = 0, cus = 0, per_cu = 0;
        hipGetDevice(&dev); hipDeviceGetAttribute(&cus, hipDeviceAttributeMultiprocessorCount, dev);
        if (hipFuncSetAttribute((const void*)mk_fwd, hipFuncAttributeMaxDynamicSharedMemorySize, LDS_BYTES) != hipSuccess) { fprintf(stderr, "kernel_launch: hipFuncSetAttribute failed\n"); grid = -1; return; }
        hipOccupancyMaxActiveBlocksPerMultiprocessor(&per_cu, (const void*)mk_fwd, NWAVES * 64, LDS_BYTES);
        (void)hipGetLastError();
        if (per_cu < 1) per_cu = 1;
        grid = cus * 1;
        if (grid <= 0) grid = 256;
    }
    if (grid < 0) return;
    if (hipMemsetAsync(d_ws, 0, 24576, stream) != hipSuccess) { fprintf(stderr, "kernel_launch: memset of the barrier words failed\n"); return; }
    Args a{};
    for (int i = 0; i < 21; ++i) a.in[i] = (const float*)d_in[i];
    a.out = (float*)d_out; a.ws = (unsigned char*)d_ws;
#if MK_MULTI
    for (int p = 0; p < NPH; ++p) { a.ph_lo = p; a.ph_hi = p + 1; hipLaunchKernelGGL(mk_fwd, dim3(grid), dim3(NWAVES * 64), LDS_BYTES, stream, a); }
#else
    a.ph_lo = 0; a.ph_hi = NPH;
    void* args[] = {&a};
    hipError_t e = hipLaunchCooperativeKernel((const void*)mk_fwd, dim3(grid), dim3(NWAVES * 64), args, LDS_BYTES, stream);
    if (e != hipSuccess) fprintf(stderr, "cooperative launch failed: %s (grid %d)\n", hipGetErrorString(e), grid);
#endif
}
```

```cpp
#include <hip/hip_runtime.h>
#include <hip/hip_cooperative_groups.h>
#include <cstdio>
#include <cstdint>
namespace cg = cooperative_groups;
#ifndef MK_MULTI
#define MK_MULTI 0
#endif
#ifndef NO_SSM
#define SSM_CALL do { int lane_l = lane, wave_l = wave; asm volatile("" : "+v"(lane_l)); asm volatile("" : "+s"(wave_l)); ssm_naive_phase(ws, layer, lds, wave_l, lane_l); PROBE_SSM2 } while (0)
#else
#define SSM_CALL
#endif
#ifndef NO_ATTN
#ifdef ATTN_NAIVE
#define ATTN_CALL do { attn_naive_phase(Qb, Kb, Vb, Ob); PROBE_ATTN2 } while (0)
#else
#define ATTN_CALL do { int lane_l = lane; asm volatile("" : "+v"(lane_l)); attn_mfma_phase(Qb, Kb, Vb, Ob, lds, gw, NGW, wave, lane_l); } while (0)
#endif
#else
#define ATTN_CALL
#endif
#ifdef PROBE_SSM
#define PROBE_SSM2 asm volatile("" : "+v"(lane_l)); ssm_naive_phase(ws, layer, lds, wave_l, lane_l);
#else
#define PROBE_SSM2
#endif
#ifdef PROBE_ATTN
#define PROBE_ATTN2 asm volatile("" ::: "memory"); attn_naive_phase(Qb, Kb, Vb, Ob);
#else
#define PROBE_ATTN2
#endif
#ifdef PROBE_F1
#define PROBE_F1_X asm volatile("" ::: "memory"); run_gemm(lds, XB, wgu, MTOK, 2 * DFF, DM, OpSwiglu{RS, HID});
#else
#define PROBE_F1_X
#endif
#ifdef PROBE_F2
#define PROBE_F2_X asm volatile("" ::: "memory"); run_gemm(lds, HID, wgu + W_GU, MTOK, DM, DFF, OpStore{XB, DM, nullptr, 1.0f});
#else
#define PROBE_F2_X
#endif
#ifdef PROBE_RU
#define PROBE_RU_X asm volatile("" ::: "memory"); for (int rep_ = 0; rep_ < 4; ++rep_) { asm volatile("" ::: "memory"); row_update<0, 4>(A.in[I_X], X, XB, RS, nullptr, 0.f, gw, NGW, lane); }
#else
#define PROBE_RU_X
#endif
namespace pg8 {
#define PG8_LAS __attribute__((address_space(3)))
typedef unsigned short bf16_t;
typedef short bf16x8 __attribute__((ext_vector_type(8)));
typedef float f32x4 __attribute__((ext_vector_type(4)));
typedef unsigned u32x4 __attribute__((ext_vector_type(4)));
constexpr int BM = 256, BK = 64, HALF = 128, HTB = HALF * BK * 2  , STAGE_BYTES = 8 * HTB, NXCD = 8, WGM = 8;

__host__ __device__ __forceinline__ int lds_byte(int r, int c) { const int st = (r >> 4) * 2 + (c >> 5), rr = r & 15, cc = c & 31, ob = rr * 64 + cc * 2; return st * 1024 + (ob ^ (((ob >> 9) & 1) << 5)); }
__host__ __device__ __forceinline__ void stage_rc(int b, int& R, int& C) { const int st = b / 1024, sb = b % 1024, swz = sb ^ (((sb >> 9) & 1) << 5); R = (st >> 1) * 16 + swz / 64; C = (st & 1) * 32 + (swz % 64) / 2; }
__host__ __device__ __forceinline__ int perm32(int rho) { const int n = rho >> 4, i = rho & 15; return 8 * (i >> 2) + 4 * n + (i & 3); }

struct Unit { int pm, pn, z; };
struct Gemm { const bf16_t* A; const bf16_t* Bt; int M, N, K; int lda, ldb; size_t sAz, sBz; };

struct StaticOrder {
    int nM, nN, nwg, G, c;
    __host__ __device__ void init(int M, int N, int G_, int c_) { nM = M / BM; nN = N / BM; nwg = nM * nN; G = G_; c = c_; }
    __host__ __device__ bool next(int i, Unit& u) const {
        const long L = (long)i * G + c; if (L >= nwg) return false;
        int wgid = (int)L; { const int q = nwg / NXCD, r = nwg % NXCD, xcd = wgid % NXCD, off = wgid / NXCD; wgid = (xcd < r ? xcd * (q + 1) : r * (q + 1) + (xcd - r) * q) + off; }
        const int nig = WGM * nN, gid = wgid / nig, fm = gid * WGM, gsz = (nM - fm) < WGM ? (nM - fm) : WGM;
        u.pm = fm + ((wgid % nig) % gsz); u.pn = (wgid % nig) / gsz; u.z = 0; return true;
    }
    __device__ __forceinline__ void a_ready(const Unit&) const {}
    __device__ __forceinline__ void done(const Unit&) const {}
    __device__ __forceinline__ int unit_nt(const Unit&, int ntd) const { return ntd; }
};

struct PanelOrder {
    int nM, nN, G, c;
    __host__ __device__ void init(int M, int N, int G_, int c_) { nM = M / BM; nN = N / BM; G = G_; c = c_; }
    __host__ __device__ bool next(int i, Unit& u) const { const int k = i / nN; const long pm = (long)k * G + c; if (pm >= nM) return false; u.pm = (int)pm; u.pn = i - k * nN; u.z = 0; return true; }
    __device__ __forceinline__ void a_ready(const Unit&) const {}
    __device__ __forceinline__ void done(const Unit&) const {}
    __device__ __forceinline__ int unit_nt(const Unit&, int ntd) const { return ntd; }
};
struct PanelOrderN {
    int nM, nN, G, c;
    __host__ __device__ void init(int M, int N, int G_, int c_) { nM = M / BM; nN = N / BM; G = G_; c = c_; }
    __host__ __device__ bool next(int i, Unit& u) const { const int k = i / nM; const long pn = (long)k * G + c; if (pn >= nN) return false; u.pn = (int)pn; u.pm = i - k * nM; u.z = 0; return true; }
    __device__ __forceinline__ void a_ready(const Unit&) const {}
    __device__ __forceinline__ void done(const Unit&) const {}
    __device__ __forceinline__ int unit_nt(const Unit&, int ntd) const { return ntd; }
};
struct BatchOrder {
    int nM, nN, nwg, G, c, tri;
    __host__ __device__ void init(int M, int N, int nz, int G_, int c_, int tri_) { nM = M / BM; nN = N / BM; nwg = nz * nM * nN; G = G_; c = c_; tri = tri_; }
    __host__ __device__ bool next(int i, Unit& u) const { const long L = (long)i * G + c; if (L >= nwg) return false; const int per = nM * nN, l = (int)L; u.z = l / per; const int rem = l % per; u.pm = rem / nN; u.pn = tri ? (rem + i) % nN : rem % nN; return true; }
    __device__ __forceinline__ void a_ready(const Unit&) const {}
    __device__ __forceinline__ void done(const Unit&) const {}
    __device__ __forceinline__ int unit_nt(const Unit& u, int ntd) const { return tri ? 4 * u.pn + 6 : ntd; }
};
typedef float f32x2_c __attribute__((ext_vector_type(2))); typedef _Float16 h16x2_c __attribute__((ext_vector_type(2))); typedef _Float16 h16x8 __attribute__((ext_vector_type(8)));
__device__ __forceinline__ unsigned cvt_pk_bf16(float lo, float hi) { f32x2_c v = {lo, hi}; h16x2_c b = __builtin_convertvector(v, h16x2_c); return __builtin_bit_cast(unsigned, b); }
typedef float f32x2 __attribute__((ext_vector_type(2)));
template <class Epi, class Sched, bool ALIGN_EPI = false, bool SP2 = false>
__device__ __forceinline__ void gemm_phase(PG8_LAS unsigned char* lds, const Gemm g, const Sched& S, const Epi& E) {
    int tid_l = threadIdx.x; asm volatile("" : "+v"(tid_l)); const int tid = tid_l, wid = __builtin_amdgcn_readfirstlane(tid >> 6), lane = tid & 63, wr = wid >> 2, wc = wid & 3, fr = lane & 15, fq = lane >> 4;
    const int K = g.K, ntd = K / BK;
    unsigned voffA[2], voffB[2];
#pragma unroll
    for (int i = 0; i < 2; ++i) { int R, C; stage_rc(tid * 16 + i * 8192, R, C); const int Rb = Epi::PERM ? ((R & ~31) + perm32(R & 31)) : R;
        voffA[i] = (unsigned)(R * g.lda + C) * 2u; voffB[i] = (unsigned)(Rb * g.ldb + C) * 2u; }
    const size_t kstep = (size_t)(BK * 2);
    const size_t hstepA = (size_t)HALF * g.lda * 2, hstepB = (size_t)HALF * g.ldb * 2;
    const size_t tstepA = 2 * hstepA, tstepB = 2 * hstepB;
    const unsigned ldsw = (unsigned)wid * 1024u;
    const int aoff = lds_byte(wr * 64 + fr, fq * 8), boff = lds_byte(wc * 32 + fr, fq * 8);
#define PG8_SA(b, h) (((b) * 2 + (h)) * HTB)
#define PG8_SB(b, h) ((4 + (b) * 2 + (h)) * HTB)
#define PG8_STAGE(bufoff, gbase, voff) do { _Pragma("unroll") for (int _i = 0; _i < 2; ++_i) \
        __builtin_amdgcn_global_load_lds((const unsigned*)((const char*)(gbase) + (voff)[_i]), (PG8_LAS unsigned*)(lds + (bufoff) + ldsw + _i * 8192), 16, 0, 0); } while (0)
#define PG8_LDA(dst, b, h) do { _Pragma("unroll") for (int m = 0; m < 4; ++m) _Pragma("unroll") for (int k = 0; k < 2; ++k) dst[m][k] = *(const PG8_LAS bf16x8*)(lds + PG8_SA(b, h) + aoff + m * 2048 + k * 1024); } while (0)
#define PG8_LDB(dst, b, h) do { _Pragma("unroll") for (int n = 0; n < 2; ++n) _Pragma("unroll") for (int k = 0; k < 2; ++k) dst[n][k] = *(const PG8_LAS bf16x8*)(lds + PG8_SB(b, h) + boff + n * 2048 + k * 1024); } while (0)
#define PG8_MMA(ai, bj, At, Bt) do { __builtin_amdgcn_s_setprio(1); _Pragma("unroll") for (int m = 0; m < 4; ++m) _Pragma("unroll") for (int n = 0; n < 2; ++n) _Pragma("unroll") for (int k = 0; k < 2; ++k) \
        acc[ai][bj][m][n] = __builtin_amdgcn_mfma_f32_16x16x32_f16(__builtin_bit_cast(h16x8, Bt[n][k]), __builtin_bit_cast(h16x8, At[m][k]), acc[ai][bj][m][n], 0, 0, 0); __builtin_amdgcn_s_setprio(0); } while (0)
#define PG8_WAIT_V(n) asm volatile("s_waitcnt vmcnt(" #n ")" ::: "memory")
#define PG8_WAIT_L(n) asm volatile("s_waitcnt lgkmcnt(" #n ")" ::: "memory")
#define PG8_BAR __builtin_amdgcn_s_barrier()
#define PG8_SCHED __builtin_amdgcn_sched_barrier(0)
    Unit cur, nxt; int ui = 0;
    if (!S.next(0, cur)) return;
    int nt = S.unit_nt(cur, ntd);
    f32x4 acc[2][2][4][2];
#pragma unroll
    for (int a = 0; a < 2; ++a)
#pragma unroll
        for (int b = 0; b < 2; ++b)
#pragma unroll
            for (int m = 0; m < 4; ++m)
#pragma unroll
                for (int n = 0; n < 2; ++n) acc[a][b][m][n] = (f32x4){0.f, 0.f, 0.f, 0.f};
    bf16x8 At[4][2], B0[2][2], B1[2][2];
    const char* cA = (const char*)g.A + (size_t)cur.z * g.sAz * 2 + (size_t)cur.pm * tstepA; const char* cB = (const char*)g.Bt + (size_t)cur.z * g.sBz * 2 + (size_t)cur.pn * tstepB;
    S.a_ready(cur);
    if constexpr (SP2) {
        PG8_STAGE(PG8_SB(0, 0), cB, voffB); PG8_STAGE(PG8_SB(0, 1), cB + hstepB, voffB); PG8_STAGE(PG8_SA(0, 0), cA, voffA); PG8_STAGE(PG8_SA(0, 1), cA + hstepA, voffA);
        if (wr == 1) PG8_BAR;
        PG8_WAIT_V(2); PG8_BAR;
        PG8_STAGE(PG8_SB(1, 0), cB + kstep, voffB); PG8_STAGE(PG8_SA(1, 0), cA + kstep, voffA); PG8_STAGE(PG8_SB(1, 1), cB + hstepB + kstep, voffB);
        PG8_WAIT_V(6); PG8_BAR;
    } else {
        PG8_STAGE(PG8_SB(0, 0), cB, voffB); PG8_STAGE(PG8_SA(0, 0), cA, voffA); PG8_STAGE(PG8_SB(0, 1), cB + hstepB, voffB); PG8_STAGE(PG8_SA(0, 1), cA + hstepA, voffA);
        if (wr == 1) PG8_BAR;
        PG8_WAIT_V(4); PG8_BAR;
        PG8_STAGE(PG8_SB(1, 0), cB + kstep, voffB); PG8_STAGE(PG8_SA(1, 0), cA + kstep, voffA); PG8_STAGE(PG8_SB(1, 1), cB + hstepB + kstep, voffB);
        PG8_WAIT_V(6); PG8_BAR;
    }
    for (;;) {
        const bool has_next = S.next(ui + 1, nxt);
        const char* nA = has_next ? (const char*)g.A + (size_t)nxt.z * g.sAz * 2 + (size_t)nxt.pm * tstepA : cA; const char* nB = has_next ? (const char*)g.Bt + (size_t)nxt.z * g.sBz * 2 + (size_t)nxt.pn * tstepB : cB;
        for (int t = 0; t < nt; t += 2) {
            const bool last = (t == nt - 2);
            const char* a1 = cA + (size_t)(t + 1) * kstep;
            const char* a2 = last ? nA : cA + (size_t)(t + 2) * kstep; const char* b2 = last ? nB : cB + (size_t)(t + 2) * kstep;
            const char* a3 = a2 + kstep; const char* b3 = b2 + kstep;
            if (last && has_next) S.a_ready(nxt);
            if constexpr (SP2) {
            PG8_LDB(B0, 0, 0); PG8_LDB(B1, 0, 1); PG8_SCHED; PG8_LDA(At, 0, 0); PG8_STAGE(PG8_SA(1, 1), a1 + hstepA, voffA);
            PG8_WAIT_V(8); PG8_WAIT_L(0); PG8_BAR; PG8_MMA(0, 0, At, B0); PG8_MMA(0, 1, At, B1); PG8_BAR; PG8_SCHED;
            PG8_LDA(At, 0, 1); PG8_STAGE(PG8_SB(0, 0), b2, voffB); PG8_STAGE(PG8_SB(0, 1), b2 + hstepB, voffB); PG8_STAGE(PG8_SA(0, 0), a2, voffA);
            PG8_WAIT_V(8); PG8_WAIT_L(0); PG8_BAR; PG8_MMA(1, 0, At, B0); PG8_MMA(1, 1, At, B1); PG8_BAR; PG8_SCHED;
            PG8_LDB(B0, 1, 0); PG8_LDB(B1, 1, 1); PG8_SCHED; PG8_LDA(At, 1, 0); PG8_STAGE(PG8_SA(0, 1), a2 + hstepA, voffA);
            PG8_WAIT_V(8); PG8_WAIT_L(0); PG8_BAR; PG8_MMA(0, 0, At, B0); PG8_MMA(0, 1, At, B1); PG8_BAR; PG8_SCHED;
            PG8_LDA(At, 1, 1); PG8_STAGE(PG8_SB(1, 0), b3, voffB); PG8_STAGE(PG8_SB(1, 1), b3 + hstepB, voffB); PG8_STAGE(PG8_SA(1, 0), a3, voffA);
            PG8_WAIT_V(8); PG8_WAIT_L(0); PG8_BAR; PG8_MMA(1, 0, At, B0); PG8_MMA(1, 1, At, B1); PG8_BAR; PG8_SCHED;
            } else {
            PG8_LDB(B0, 0, 0); PG8_SCHED; PG8_LDA(At, 0, 0); PG8_STAGE(PG8_SA(1, 1), a1 + hstepA, voffA);
            PG8_WAIT_L(8); PG8_BAR; PG8_WAIT_L(0); PG8_MMA(0, 0, At, B0); PG8_BAR; PG8_SCHED;
            PG8_LDB(B1, 0, 1); PG8_STAGE(PG8_SB(0, 0), b2, voffB);
            PG8_BAR; PG8_WAIT_L(0); PG8_MMA(0, 1, At, B1); PG8_BAR;
            PG8_LDA(At, 0, 1); PG8_STAGE(PG8_SA(0, 0), a2, voffA);
            PG8_BAR; PG8_WAIT_L(0); PG8_MMA(1, 0, At, B0); PG8_BAR; PG8_SCHED;
            PG8_STAGE(PG8_SB(0, 1), b2 + hstepB, voffB);
            PG8_WAIT_V(6); PG8_BAR; PG8_MMA(1, 1, At, B1); PG8_BAR;
            PG8_LDB(B0, 1, 0); PG8_SCHED; PG8_LDA(At, 1, 0); PG8_STAGE(PG8_SA(0, 1), a2 + hstepA, voffA);
            PG8_WAIT_L(8); PG8_BAR; PG8_WAIT_L(0); PG8_MMA(0, 0, At, B0); PG8_BAR; PG8_SCHED;
            PG8_LDB(B1, 1, 1); PG8_STAGE(PG8_SB(1, 0), b3, voffB);
            PG8_BAR; PG8_WAIT_L(0); PG8_MMA(0, 1, At, B1); PG8_BAR;
            PG8_LDA(At, 1, 1); PG8_STAGE(PG8_SA(1, 0), a3, voffA);
            PG8_BAR; PG8_WAIT_L(0); PG8_MMA(1, 0, At, B0); PG8_BAR; PG8_SCHED;
            PG8_STAGE(PG8_SB(1, 1), b3 + hstepB, voffB);
            PG8_WAIT_V(6); PG8_BAR; PG8_MMA(1, 1, At, B1); PG8_BAR;
            }
        }
        if constexpr (ALIGN_EPI) { if (wr == 0) PG8_BAR; }
        if constexpr (!Epi::AFTER_DRAIN) { E(acc, cur, wr, wc, fr, fq); S.done(cur); }
        if (!has_next) break;
#pragma unroll
        for (int a = 0; a < 2; ++a)
#pragma unroll
            for (int b = 0; b < 2; ++b)
#pragma unroll
                for (int m = 0; m < 4; ++m)
#pragma unroll
                    for (int n = 0; n < 2; ++n) acc[a][b][m][n] = (f32x4){0.f, 0.f, 0.f, 0.f};
        cur = nxt; cA = nA; cB = nB; ++ui; nt = S.unit_nt(cur, ntd);
        if constexpr (ALIGN_EPI) { if (wr == 1) PG8_BAR; }
    }
    PG8_WAIT_V(0);
    if constexpr (!ALIGN_EPI) { if (wr == 0) PG8_BAR; }
    PG8_BAR;
    if constexpr (Epi::AFTER_DRAIN) { E.fused(acc, cur, wr, wc, fr, fq, lds, wid, lane); S.done(cur); }
#undef PG8_SA
#undef PG8_SB
#undef PG8_STAGE
#undef PG8_LDA
#undef PG8_LDB
#undef PG8_MMA
#undef PG8_WAIT_V
#undef PG8_WAIT_L
#undef PG8_BAR
#undef PG8_SCHED
}
}
typedef unsigned short bf16_t;
typedef float f32x4 __attribute__((ext_vector_type(4)));
typedef unsigned u32x4 __attribute__((ext_vector_type(4)));
typedef unsigned u32x2 __attribute__((ext_vector_type(2)));
constexpr int DM = 1024, NB = 16, SEQ = 4096, MTOK = NB * SEQ, DFF = 2816, NHEAD = 16, HDIM = 64;
constexpr int SG = 64, SC = 16, SN = 64;
constexpr float NORM_EPS = 1e-6f;
constexpr int UA_LD = 1152;
constexpr size_t UA_G = (size_t)1024 * UA_LD;
constexpr size_t MiB = 1u << 20;
constexpr size_t WS_RS = 1 * MiB;
constexpr size_t WS_XS1 = 158 * MiB;
constexpr int CW_PCNT = 16384;
constexpr size_t WS_W = 2 * MiB;
constexpr size_t W_GU = (size_t)2 * DFF * DM;
constexpr size_t W_DN = (size_t)DM * DFF;
constexpr size_t W_FFN = W_GU + W_DN;
constexpr size_t W_SQ = (size_t)DM * DM;
constexpr size_t WO_FFN = 0, WO_SSM = 8 * W_FFN, WO_QKV = WO_SSM + 6 * W_SQ, WO_Q1 = WO_QKV + 3 * W_SQ, WO_O = WO_Q1 + W_SQ, WO_END = WO_O + 2 * W_SQ;
static_assert(WS_W + WO_END * 2 <= 160 * MiB, "weights fit");
constexpr size_t WS_XB = 160 * MiB;
constexpr size_t WS_HID = 288 * MiB;
constexpr size_t WS_Y = WS_HID, WS_Z = WS_HID + 128 * MiB, WS_O = WS_HID + 128 * MiB;
constexpr size_t WS_K = 640 * MiB, WS_V = 768 * MiB;
constexpr size_t WS_UA = 832 * MiB;
constexpr size_t WS_SP = 976 * MiB, WS_TAB = 980 * MiB, WS_END = 996 * MiB;
constexpr int SP_NG = 0, SP_LRE = 24576, SP_LIM = SP_LRE + 8192, SP_LDT = SP_LIM + 8192, SP_BRE = SP_LDT + 128, SP_BIM = SP_BRE + 131072, SP_CRE = SP_BIM + 131072, SP_CIM = SP_CRE + 131072, SP_SD = SP_CIM + 131072, SP_AR = SP_SD + 2048, SP_AI = SP_AR + 8192, SP_BBR = SP_AI + 8192, SP_BBI = SP_BBR + 131072, SP_END = SP_BBI + 131072;
static_assert((size_t)SP_END * 4 <= 4 * MiB, "SP fits");
constexpr size_t WS_KQT = WS_K, WS_PT = WS_K + 144 * MiB, WS_SLOC = WS_K + 160 * MiB;
constexpr size_t WS_PW = WS_TAB, WS_KD = WS_TAB + 5 * MiB;
static_assert((size_t)2 * 64 * 65 * 64 * 8 <= 5 * MiB && WS_SLOC + (size_t)64 * 1024 * 128 * 4 <= WS_UA && WS_UA + UA_G * 64 * 2 <= WS_SP, "tables fit");
static_assert(WS_HID + (size_t)MTOK * DFF * 2 <= WS_K, "hid fits");

typedef _Float16 h16x2 __attribute__((ext_vector_type(2)));
__device__ __forceinline__ float bf_lo(unsigned w) { return (float)__builtin_bit_cast(h16x2, w)[0]; }
__device__ __forceinline__ float bf_hi(unsigned w) { return (float)__builtin_bit_cast(h16x2, w)[1]; }
__device__ __forceinline__ float wave_sum(float v) {
#pragma unroll
    for (int o = 1; o < 64; o <<= 1) v += __shfl_xor(v, o);
    return v;
}
__device__ __forceinline__ float sigmoidf_(float v) { return __builtin_amdgcn_rcpf(1.0f + __builtin_amdgcn_exp2f(v * -1.4426950408889634f)); }
__device__ __forceinline__ float gelu_tanh(float x) { const float v = 1.5957691216057308f * (x + 0.044715f * x * x * x); return x * sigmoidf_(v); }
using pg8::Unit; using pg8::cvt_pk_bf16;
__device__ __forceinline__ float rs4(const float* ssq, int row) { const f32x4 q = *(const f32x4*)(ssq + (size_t)row * 4); return rsqrtf(((q[0] + q[1]) + (q[2] + q[3])) * (1.0f / DM) + NORM_EPS); }

#define LAS __attribute__((address_space(3)))
template <class Op> struct EpiGen {
    static constexpr bool PERM = true, AFTER_DRAIN = false;
    Op op; LAS float* rsl; mutable int cpm;
    __device__ __forceinline__ void operator()(const f32x4 (&acc)[2][2][4][2], const Unit& u, int wr, int wc, int fr, int fq) const {
        const int row0 = u.pm * 256 + wr * 64 + fr, cin = wc * 32 + 8 * fq;
        if constexpr (Op::ROW_RS) {
            if (u.pm != cpm) {
                const int t = (wr * 4 + wc) * 64 + fq * 16 + fr;
                __builtin_amdgcn_s_barrier();
                if (t < 256) rsl[t] = rs4(op.rs, u.pm * 256 + t);
                asm volatile("s_waitcnt lgkmcnt(0)" ::: "memory"); __builtin_amdgcn_s_barrier(); asm volatile("" ::: "memory");
                cpm = u.pm;
            }
        }
        if constexpr (Op::HAS_UNIT) op.unit_init(u, cin);
#pragma unroll
        for (int ai = 0; ai < 2; ++ai) {
            float rsc[4];
#pragma unroll
            for (int m = 0; m < 4; ++m) { if constexpr (Op::ROW_RS) rsc[m] = rsl[wr * 64 + fr + ai * 128 + m * 16] * op.factor(u); else rsc[m] = op.scale(u, row0 + ai * 128 + m * 16); }
            if constexpr (Op::HAS_PRE) {
                u32x4 pa[4], pb[4];
#pragma unroll
                for (int m = 0; m < 4; ++m) op.pre(u, row0 + ai * 128 + m * 16, cin, pa[m], pb[m]);
#pragma unroll
                for (int m = 0; m < 4; ++m) { op.run(u, row0 + ai * 128 + m * 16, cin, rsc[m], acc[ai][0][m][0], acc[ai][0][m][1], acc[ai][1][m][0], acc[ai][1][m][1], pa[m], pb[m]); asm volatile("" ::: "memory"); }
            } else {
#pragma unroll
                for (int m = 0; m < 4; ++m) { op(u, row0 + ai * 128 + m * 16, cin, rsc[m], acc[ai][0][m][0], acc[ai][0][m][1], acc[ai][1][m][0], acc[ai][1][m][1]); asm volatile("" ::: "memory"); }
            }
        }
    }
};
#ifndef ST_WT
#define ST_WT 0
#endif
#ifndef ST_NT
#define ST_NT 0
#endif
__device__ __forceinline__ void st16(void* p, u32x4 v) {
#if ST_WT
    asm volatile("global_store_dwordx4 %0, %1, off sc1\n\ts_nop 1" :: "v"(p), "v"(v) : "memory");
#elif ST_NT
    __builtin_nontemporal_store(v, (u32x4*)p);
#else
    *(u32x4*)p = v;
#endif
}
__device__ __forceinline__ u32x4 pack8(f32x4 a, f32x4 b) { u32x4 w; w.x = cvt_pk_bf16(a[0], a[1]); w.y = cvt_pk_bf16(a[2], a[3]); w.z = cvt_pk_bf16(b[0], b[1]); w.w = cvt_pk_bf16(b[2], b[3]); return w; }
struct OpSwiglu { const float* rs; bf16_t* H;
    static constexpr bool ROW_RS = true, HAS_PRE = false, HAS_UNIT = false;
    __device__ __forceinline__ float factor(const Unit& u) const { return 1.0f; }
    __device__ __forceinline__ float scale(const Unit&, int row) const { return rs4(rs, row); }
    __device__ __forceinline__ void operator()(const Unit& u, int row, int cin, float r, f32x4 g0, f32x4 g1, f32x4 u0, f32x4 u1) const {
        f32x4 h0, h1; const float r2 = r * r, rn = r * -1.4426950408889634f;
#pragma unroll
        for (int i = 0; i < 4; ++i) {
            const float ea = __builtin_amdgcn_exp2f(g0[i] * rn), eb = __builtin_amdgcn_exp2f(g1[i] * rn);
            h0[i] = (g0[i] * u0[i]) * (r2 * __builtin_amdgcn_rcpf(1.0f + ea)); h1[i] = (g1[i] * u1[i]) * (r2 * __builtin_amdgcn_rcpf(1.0f + eb)); }
        st16((H + (size_t)row * DFF + u.pn * 128 + cin), pack8(h0, h1));
    } };
struct OpStore { bf16_t* O; int ldc; const float* rs; float sc;
    static constexpr bool ROW_RS = false, HAS_PRE = false, HAS_UNIT = false;
    __device__ __forceinline__ float scale(const Unit&, int row) const { return rs ? rs4(rs, row) * sc : sc; }
    __device__ __forceinline__ void operator()(const Unit& u, int row, int cin, float r, f32x4 a0, f32x4 a1, f32x4 b0, f32x4 b1) const {
        bf16_t* p = O + (size_t)row * ldc + u.pn * 256 + cin;
        st16(p, pack8(a0 * r, a1 * r)); st16((p + 128), pack8(b0 * r, b1 * r));
    } };
struct OpQKV { bf16_t* Q; unsigned char* ws; const float* rs;
    static constexpr bool ROW_RS = true, HAS_PRE = false, HAS_UNIT = false;
    __device__ __forceinline__ float factor(const Unit& u) const { return ((u.pn >> 2) == 0 ? 0.18033688011112042f : 1.0f); }
    __device__ __forceinline__ float scale(const Unit& u, int row) const { return rs4(rs, row) * ((u.pn >> 2) == 0 ? 0.18033688011112042f : 1.0f); }
    __device__ __forceinline__ void operator()(const Unit& u, int row, int cin, float r, f32x4 a0, f32x4 a1, f32x4 b0, f32x4 b1) const {
        const int t = u.pn >> 2; bf16_t* base = (t == 0) ? Q : (bf16_t*)(ws + WS_K);
        bf16_t* p = base + (size_t)row * DM + (u.pn & 3) * 256 + cin;
        st16(p, pack8(a0 * r, a1 * r)); st16((p + 128), pack8(b0 * r, b1 * r));
    } };
struct OpUA { bf16_t* UA; const float* rs;
    static constexpr bool ROW_RS = true, HAS_PRE = false, HAS_UNIT = false;
    __device__ __forceinline__ float factor(const Unit& u) const { return 1.0f; }
    __device__ __forceinline__ float scale(const Unit&, int row) const { return rs4(rs, row); }
    __device__ __forceinline__ void operator()(const Unit& u, int row, int cin, float r, f32x4 a0, f32x4 a1, f32x4 b0, f32x4 b1) const {
        const int col = u.pn * 256 + cin; const size_t ro = (size_t)(row >> 6) * UA_LD + 128 + (row & 63) * 16 + (col & 15);
        st16((UA + (size_t)(col >> 4) * UA_G + ro), pack8(a0 * r, a1 * r));
        st16((UA + (size_t)((col + 128) >> 4) * UA_G + ro), pack8(b0 * r, b1 * r));
    } };
struct OpGLU { const bf16_t* Y; bf16_t* Z;
    static constexpr bool ROW_RS = false, HAS_PRE = true, HAS_UNIT = false;
    __device__ __forceinline__ float scale(const Unit&, int) const { return 1.0f; }
    __device__ __forceinline__ void pre(const Unit& u, int row, int cin, u32x4& pa, u32x4& pb) const { const size_t off = (size_t)row * DM + u.pn * 256 + cin; pa = *(const u32x4*)(Y + off); pb = *(const u32x4*)(Y + off + 128); }
    __device__ __forceinline__ void run(const Unit& u, int row, int cin, float, f32x4 a0, f32x4 a1, f32x4 b0, f32x4 b1, u32x4 pa, u32x4 pb) const {
        const size_t off = (size_t)row * DM + u.pn * 256 + cin;
#pragma unroll
        for (int hb = 0; hb < 2; ++hb) { const u32x4 y = hb ? pb : pa; const f32x4 c0 = hb ? b0 : a0, c1 = hb ? b1 : a1; f32x4 z0, z1;
            z0[0] = bf_lo(y.x) * sigmoidf_(c0[0]); z0[1] = bf_hi(y.x) * sigmoidf_(c0[1]); z0[2] = bf_lo(y.y) * sigmoidf_(c0[2]); z0[3] = bf_hi(y.y) * sigmoidf_(c0[3]);
            z1[0] = bf_lo(y.z) * sigmoidf_(c1[0]); z1[1] = bf_hi(y.z) * sigmoidf_(c1[1]); z1[2] = bf_lo(y.w) * sigmoidf_(c1[2]); z1[3] = bf_hi(y.w) * sigmoidf_(c1[3]);
            st16((Z + off + hb * 128), pack8(z0, z1)); }
    } };
struct OpVT { bf16_t* VT; const float* rs; mutable f32x4 r0, r1, r2, r3;
    static constexpr bool ROW_RS = false, HAS_PRE = false, HAS_UNIT = true;
    __device__ __forceinline__ float scale(const Unit&, int) const { return 1.0f; }
    __device__ __forceinline__ void unit_init(const Unit& u, int cin) const { const int col = u.pn * 256 + cin;
#pragma unroll
        for (int e = 0; e < 4; ++e) { r0[e] = rs4(rs, col + e); r1[e] = rs4(rs, col + 4 + e); r2[e] = rs4(rs, col + 128 + e); r3[e] = rs4(rs, col + 132 + e); } }
    __device__ __forceinline__ void operator()(const Unit& u, int row, int cin, float, f32x4 a0, f32x4 a1, f32x4 b0, f32x4 b1) const {
        const int col = u.pn * 256 + cin; bf16_t* p = VT + (size_t)row * MTOK + col;
        st16(p, pack8(a0 * r0, a1 * r1)); st16((p + 128), pack8(b0 * r2, b1 * r3));
    } };
struct OpSloc { float* SL;
    static constexpr bool ROW_RS = false, HAS_PRE = false, HAS_UNIT = false;
    __device__ __forceinline__ float scale(const Unit&, int) const { return 1.0f; }
    __device__ __forceinline__ void operator()(const Unit& u, int row, int cin, float, f32x4 a0, f32x4 a1, f32x4 b0, f32x4 b1) const {
        float* p = SL + ((size_t)u.z * 1024 + row) * 128 + cin; *(f32x4*)p = a0; *(f32x4*)(p + 4) = a1; (void)b0; (void)b1;
    } };
struct OpY { const bf16_t* UA; bf16_t* Y; const float* dsk; mutable f32x4 da0, da1, db0, db1;
    static constexpr bool ROW_RS = false, HAS_PRE = true, HAS_UNIT = true;
    __device__ __forceinline__ float scale(const Unit&, int) const { return 1.0f; }
    __device__ __forceinline__ void unit_init(const Unit& u, int cin) const { const int c0 = cin & 15; const float* d = dsk + u.z * 16 + c0; da0 = *(const f32x4*)d; da1 = *(const f32x4*)(d + 4); db0 = da0; db1 = da1; }
    __device__ __forceinline__ void pre(const Unit& u, int row, int cin, u32x4& pa, u32x4& pb) const { const bf16_t* p = UA + (size_t)u.z * UA_G + (size_t)row * UA_LD + 128 + u.pn * 256 + cin; pa = *(const u32x4*)p; pb = *(const u32x4*)(p + 128); }
    __device__ __forceinline__ void run(const Unit& u, int row, int cin, float, f32x4 a0, f32x4 a1, f32x4 b0, f32x4 b1, u32x4 pa, u32x4 pb) const {
#pragma unroll
        for (int hb = 0; hb < 2; ++hb) { const int n = u.pn * 256 + hb * 128 + cin, l = n >> 4, c0 = n & 15; const f32x4 v0 = hb ? b0 : a0, v1 = hb ? b1 : a1; const u32x4 uu = hb ? pb : pa;
            const f32x4 d0 = hb ? db0 : da0, d1 = hb ? db1 : da1; f32x4 y0, y1;
            y0[0] = gelu_tanh(v0[0] + d0[0] * bf_lo(uu.x)); y0[1] = gelu_tanh(v0[1] + d0[1] * bf_hi(uu.x)); y0[2] = gelu_tanh(v0[2] + d0[2] * bf_lo(uu.y)); y0[3] = gelu_tanh(v0[3] + d0[3] * bf_hi(uu.y));
            y1[0] = gelu_tanh(v1[0] + d1[0] * bf_lo(uu.z)); y1[1] = gelu_tanh(v1[1] + d1[1] * bf_hi(uu.z)); y1[2] = gelu_tanh(v1[2] + d1[2] * bf_lo(uu.w)); y1[3] = gelu_tanh(v1[3] + d1[3] * bf_hi(uu.w));
            st16((Y + ((size_t)row * 64 + l) * DM + u.z * 16 + c0), pack8(y0, y1)); }
    } };
struct EpiFused {
    static constexpr bool PERM = true, AFTER_DRAIN = false;
    bf16_t* x16; const float* g; float alpha; float* outf; float* xs1; float* ssq2; unsigned* cnt; unsigned want; LAS unsigned char* xl;
    mutable int cpn;
    __device__ __forceinline__ void operator()(const f32x4 (&acc)[2][2][4][2], const Unit& u, int wr, int wc, int fr, int fq) const {
        LAS float* P = (LAS float*)xl; LAS float* S = P + 1024;
        const int wid = wr * 4 + wc, lane = fq * 16 + fr, prow0 = u.pm * 256;
        const int col0 = u.pn * 256 + wc * 32 + 8 * fq;
        u32x4 xpa[4], xpb[4];
#pragma unroll
        for (int i = 0; i < 4; ++i) { const size_t off = (size_t)(prow0 + wr * 64 + i * 16 + fr) * DM + col0; xpa[i] = *(const u32x4*)(x16 + off); xpb[i] = *(const u32x4*)(x16 + off + 128); }
#pragma unroll
        for (int ai = 0; ai < 2; ++ai)
#pragma unroll
            for (int m = 0; m < 4; ++m) { float sq = 0.f;
#pragma unroll
                for (int bj = 0; bj < 2; ++bj)
#pragma unroll
                    for (int n = 0; n < 2; ++n) { const f32x4 v = acc[ai][bj][m][n]; sq += (v[0] * v[0] + v[1] * v[1]) + (v[2] * v[2] + v[3] * v[3]); }
                sq += __shfl_xor(sq, 16); sq += __shfl_xor(sq, 32);
                if (fq == 0) P[(ai * 128 + wr * 64 + m * 16 + fr) * 4 + wc] = sq; }
        asm volatile("s_waitcnt lgkmcnt(0)" ::: "memory"); __builtin_amdgcn_s_barrier(); asm volatile("" ::: "memory");
        const int row = wid * 32 + (lane & 31);
        unsigned long long* sl64 = (unsigned long long*)xs1 + (size_t)(prow0 + row) * 4;
        if (lane < 32) { const float t = (P[row * 4 + 0] + P[row * 4 + 1]) + (P[row * 4 + 2] + P[row * 4 + 3]);
            __hip_atomic_store(sl64 + u.pn, ((unsigned long long)want << 32) | (unsigned long long)__float_as_uint(t), __ATOMIC_RELAXED, __HIP_MEMORY_SCOPE_AGENT); }
        { unsigned sp = 0u; unsigned long long v0, v1, v2, v3;
            for (;;) {
                v0 = __hip_atomic_load(sl64 + 0, __ATOMIC_RELAXED, __HIP_MEMORY_SCOPE_AGENT); v1 = __hip_atomic_load(sl64 + 1, __ATOMIC_RELAXED, __HIP_MEMORY_SCOPE_AGENT);
                v2 = __hip_atomic_load(sl64 + 2, __ATOMIC_RELAXED, __HIP_MEMORY_SCOPE_AGENT); v3 = __hip_atomic_load(sl64 + 3, __ATOMIC_RELAXED, __HIP_MEMORY_SCOPE_AGENT);
                const bool ok = ((unsigned)(v0 >> 32) == want) && ((unsigned)(v1 >> 32) == want) && ((unsigned)(v2 >> 32) == want) && ((unsigned)(v3 >> 32) == want);
                if (__all(ok) || ++sp > (1u << 20)) break;
                __builtin_amdgcn_s_sleep(1);
            }
            if (lane < 32) { const float t0 = __uint_as_float((unsigned)v0), t1 = __uint_as_float((unsigned)v1), t2 = __uint_as_float((unsigned)v2), t3 = __uint_as_float((unsigned)v3);
                S[row] = alpha * rsqrtf(((t0 + t1) + (t2 + t3)) * (1.0f / DM) + NORM_EPS); } }
        asm volatile("s_waitcnt vmcnt(0) lgkmcnt(0)" ::: "memory"); __builtin_amdgcn_s_barrier(); asm volatile("" ::: "memory");
        LAS float* gl = (LAS float*)(xl + 5632);
        if (u.pn != cpn) { const int t_ = wid * 64 + lane; __builtin_amdgcn_s_barrier(); if (t_ < 256) gl[t_] = g[u.pn * 256 + t_]; asm volatile("s_waitcnt vmcnt(0) lgkmcnt(0)" ::: "memory"); __builtin_amdgcn_s_barrier(); asm volatile("" ::: "memory"); cpn = u.pn; }
        const f32x4 ga0 = *(const LAS f32x4*)(gl + wc * 32 + 8 * fq), ga1 = *(const LAS f32x4*)(gl + wc * 32 + 8 * fq + 4), gb0 = *(const LAS f32x4*)(gl + 128 + wc * 32 + 8 * fq), gb1 = *(const LAS f32x4*)(gl + 128 + wc * 32 + 8 * fq + 4);
#pragma unroll
        for (int ai = 0; ai < 2; ++ai) {
            if (ai == 1) {
#pragma unroll
                for (int i = 0; i < 4; ++i) { const size_t off = (size_t)(prow0 + 128 + wr * 64 + i * 16 + fr) * DM + col0; xpa[i] = *(const u32x4*)(x16 + off); xpb[i] = *(const u32x4*)(x16 + off + 128); }
            }
#pragma unroll
            for (int m = 0; m < 4; ++m) { const int rl = ai * 128 + wr * 64 + m * 16 + fr; const float r = S[rl]; const size_t off = (size_t)(prow0 + rl) * DM + col0;
                const u32x4 xa = xpa[m], xb = xpb[m];
                f32x4 a0 = {bf_lo(xa.x), bf_hi(xa.x), bf_lo(xa.y), bf_hi(xa.y)}, a1 = {bf_lo(xa.z), bf_hi(xa.z), bf_lo(xa.w), bf_hi(xa.w)}, b0 = {bf_lo(xb.x), bf_hi(xb.x), bf_lo(xb.y), bf_hi(xb.y)}, b1 = {bf_lo(xb.z), bf_hi(xb.z), bf_lo(xb.w), bf_hi(xb.w)};
                a0 += acc[ai][0][m][0] * r * ga0; a1 += acc[ai][0][m][1] * r * ga1; b0 += acc[ai][1][m][0] * r * gb0; b1 += acc[ai][1][m][1] * r * gb1;
                float sq = ((a0[0] * a0[0] + a0[1] * a0[1]) + (a0[2] * a0[2] + a0[3] * a0[3])) + ((a1[0] * a1[0] + a1[1] * a1[1]) + (a1[2] * a1[2] + a1[3] * a1[3]));
                sq += ((b0[0] * b0[0] + b0[1] * b0[1]) + (b0[2] * b0[2] + b0[3] * b0[3])) + ((b1[0] * b1[0] + b1[1] * b1[1]) + (b1[2] * b1[2] + b1[3] * b1[3]));
                if (outf) { float* o = outf + off; *(f32x4*)o = a0; *(f32x4*)(o + 4) = a1; *(f32x4*)(o + 128) = b0; *(f32x4*)(o + 132) = b1; }
                else { st16(x16 + off, pack8(a0, a1)); st16(x16 + off + 128, pack8(b0, b1)); }
                sq += __shfl_xor(sq, 16); sq += __shfl_xor(sq, 32);
                if (fq == 0) P[rl * 4 + wc] = sq;
                asm volatile("" ::: "memory"); }
        }
        asm volatile("s_waitcnt lgkmcnt(0)" ::: "memory"); __builtin_amdgcn_s_barrier(); asm volatile("" ::: "memory");
        if (lane < 32) ssq2[(size_t)(prow0 + row) * 4 + u.pn] = (P[row * 4 + 0] + P[row * 4 + 1]) + (P[row * 4 + 2] + P[row * 4 + 3]);
        asm volatile("s_waitcnt lgkmcnt(0)" ::: "memory"); __builtin_amdgcn_s_barrier(); asm volatile("" ::: "memory");
    }
};
constexpr int NWAVES = 8, LDS_BYTES = 147456, RING_BYTES = 131072;
struct Args { const float* in[21]; float* out; unsigned char* ws; int ph_lo, ph_hi; };
enum { I_X = 0, I_NG, I_WG, I_WU, I_WD, I_SWIN, I_LRE, I_LIM, I_LDT, I_BRE, I_BIM, I_CRE, I_CIM, I_SD, I_SWGLU, I_SWOUT, I_KVG, I_WK, I_WV, I_WQ, I_WO };

__device__ __forceinline__ unsigned pk2(float lo, float hi) { return cvt_pk_bf16(lo, hi); }
#define TR_LOAD(V, G, ITEM) do { const int kb_ = (ITEM) / nblk_, nb_ = (ITEM) % nblk_; \
    _Pragma("unroll") for (int i = 0; i < 8; ++i) { const int kk = 8 * i + (lane >> 3); V[i] = *(const f32x4*)(W + (size_t)(64 * kb_ + kk) * N + 32 * nb_ + (lane & 7) * 4); G[i] = gain ? gain[64 * kb_ + kk] : 1.0f; } } while (0)
#define TR_STORE(V, G, ITEM) do { const int kb_ = (ITEM) / nblk_, nb_ = (ITEM) % nblk_, k0 = 64 * kb_, n0 = 32 * nb_; \
    _Pragma("unroll") for (int i = 0; i < 8; ++i) { const int kk = 8 * i + (lane >> 3), nn = (lane & 7) * 4; const f32x4 v = V[i] * G[i]; \
        scr[kk * 33 + nn] = v[0]; scr[kk * 33 + nn + 1] = v[1]; scr[kk * 33 + nn + 2] = v[2]; scr[kk * 33 + nn + 3] = v[3]; } \
    asm volatile("s_waitcnt lgkmcnt(0)" ::: "memory"); \
    const int c = lane & 7; const int r0 = mode == 0 ? row_off + n0 : (256 * (n0 >> 7) + (n0 & 127) + (mode == 2 ? 128 : 0)); \
    _Pragma("unroll") for (int j = 0; j < 4; ++j) { const int n = (lane >> 3) + 8 * j; const LAS float* s = scr + (8 * c) * 33 + n; \
        u32x4 o; o.x = pk2(s[0 * 33], s[1 * 33]); o.y = pk2(s[2 * 33], s[3 * 33]); o.z = pk2(s[4 * 33], s[5 * 33]); o.w = pk2(s[6 * 33], s[7 * 33]); \
        *(u32x4*)(WT + (size_t)(r0 + n) * K + k0 + 8 * c) = o; } \
    asm volatile("s_waitcnt lgkmcnt(0)" ::: "memory"); } while (0)
__device__ __forceinline__ int conv_matrix(const float* W, int K, int N, const float* gain, int mode, bf16_t* WT, int row_off, LAS float* scr, int cstart, int NGW, int lane) {
    const int n_items = (K / 64) * (N / 32), nblk_ = N / 32; int it = cstart;
    f32x4 va[8], vb[8]; float ga[8], gb[8];
    if (it < n_items) TR_LOAD(va, ga, it);
    while (it < n_items) {
        if (it + NGW < n_items) TR_LOAD(vb, gb, it + NGW);
        TR_STORE(va, ga, it); it += NGW;
        if (it >= n_items) break;
        if (it + NGW < n_items) TR_LOAD(va, ga, it + NGW);
        TR_STORE(vb, gb, it); it += NGW;
    }
    return it - n_items;
}
#undef TR_LOAD
#undef TR_STORE
#define CONV(Wp, K_, N_, gain_, mode_, dst_, roff_) cstart = conv_matrix((Wp), (K_), (N_), (gain_), (mode_), (dst_), (roff_), scr, cstart, NGW, lane)

template <int MODE, int RR> __device__ __forceinline__ void row_update(const float* xin, bf16_t* x16, const bf16_t* T, float* rs, const float* g, float alpha, float* outf, int gw, int NGW, int lane) {
    f32x4 gv[4];
    if (MODE == 1) {
#pragma unroll
        for (int h = 0; h < 2; ++h) { gv[2 * h] = *(const f32x4*)(g + h * 512 + lane * 8); gv[2 * h + 1] = *(const f32x4*)(g + h * 512 + lane * 8 + 4); }
    }
    const int nblk_ = NGW / NWAVES, blk_ = gw / NWAVES; const bool g256_ = (nblk_ == 256);
    for (int it = 0; it < (MTOK / 256 + nblk_ - 1) / nblk_ * (32 / RR); ++it) {
        const int k_ = it / (32 / RR); const int pmi = g256_ ? ((blk_ & 7) * 32 + (blk_ >> 3)) : (blk_ + k_ * nblk_); if (pmi >= MTOK / 256) break;
        const int base = pmi * 256 + (gw % NWAVES) * 32 + (it % (32 / RR)) * RR;
        f32x4 xv[RR][4]; u32x4 tw[RR][2]; float red[RR];
#pragma unroll
        for (int rr = 0; rr < RR; ++rr) { const bf16_t* br = x16 + (size_t)(base + rr) * DM;
#pragma unroll
            for (int h = 0; h < 2; ++h) {
                if (MODE == 0) { const float* xr = xin + (size_t)(base + rr) * DM; xv[rr][2 * h] = *(const f32x4*)(xr + h * 512 + lane * 8); xv[rr][2 * h + 1] = *(const f32x4*)(xr + h * 512 + lane * 8 + 4); }
                else { const u32x4 xw = *(const u32x4*)(br + h * 512 + lane * 8); tw[rr][h] = *(const u32x4*)(T + (size_t)(base + rr) * DM + h * 512 + lane * 8);
                    xv[rr][2 * h] = (f32x4){bf_lo(xw.x), bf_hi(xw.x), bf_lo(xw.y), bf_hi(xw.y)}; xv[rr][2 * h + 1] = (f32x4){bf_lo(xw.z), bf_hi(xw.z), bf_lo(xw.w), bf_hi(xw.w)}; } } }
        if (MODE == 1) {
            float tv[RR][16];
#pragma unroll
            for (int rr = 0; rr < RR; ++rr) { float ss = 0.f;
#pragma unroll
                for (int h = 0; h < 2; ++h) { const u32x4 t = tw[rr][h];
                    tv[rr][8 * h + 0] = bf_lo(t.x); tv[rr][8 * h + 1] = bf_hi(t.x); tv[rr][8 * h + 2] = bf_lo(t.y); tv[rr][8 * h + 3] = bf_hi(t.y); tv[rr][8 * h + 4] = bf_lo(t.z); tv[rr][8 * h + 5] = bf_hi(t.z); tv[rr][8 * h + 6] = bf_lo(t.w); tv[rr][8 * h + 7] = bf_hi(t.w); }
#pragma unroll
                for (int i = 0; i < 16; ++i) ss += tv[rr][i] * tv[rr][i];
                red[rr] = ss; }
#pragma unroll
            for (int o = 1; o < 64; o <<= 1) {
#pragma unroll
                for (int rr = 0; rr < RR; ++rr) red[rr] += __shfl_xor(red[rr], o); }
#pragma unroll
            for (int rr = 0; rr < RR; ++rr) { const float r = alpha * rsqrtf(red[rr] * (1.0f / DM) + NORM_EPS);
#pragma unroll
                for (int h = 0; h < 2; ++h)
#pragma unroll
                    for (int i = 0; i < 4; ++i) { xv[rr][2 * h][i] += tv[rr][8 * h + i] * r * gv[2 * h][i]; xv[rr][2 * h + 1][i] += tv[rr][8 * h + 4 + i] * r * gv[2 * h + 1][i]; } }
        }
        if (MODE == 1 && outf != nullptr) {
#pragma unroll
            for (int rr = 0; rr < RR; ++rr) { float* xo = outf + (size_t)(base + rr) * DM;
#pragma unroll
                for (int h = 0; h < 2; ++h) { *(f32x4*)(xo + h * 512 + lane * 8) = xv[rr][2 * h]; *(f32x4*)(xo + h * 512 + lane * 8 + 4) = xv[rr][2 * h + 1]; } }
            continue;
        }
#pragma unroll
        for (int rr = 0; rr < RR; ++rr) { float s2 = 0.f;
#pragma unroll
            for (int j = 0; j < 4; ++j) s2 += (xv[rr][j][0] * xv[rr][j][0] + xv[rr][j][1] * xv[rr][j][1]) + (xv[rr][j][2] * xv[rr][j][2] + xv[rr][j][3] * xv[rr][j][3]);
            red[rr] = s2; }
#pragma unroll
        for (int o = 1; o < 64; o <<= 1) {
#pragma unroll
            for (int rr = 0; rr < RR; ++rr) red[rr] += __shfl_xor(red[rr], o); }
#pragma unroll
        for (int rr = 0; rr < RR; ++rr) {
            if (lane == 0) { if (MODE == 0) *(f32x4*)(rs + (size_t)(base + rr) * 4) = (f32x4){red[rr], 0.f, 0.f, 0.f}; else rs[base + rr] = rsqrtf(red[rr] * (1.0f / DM) + NORM_EPS); }
            bf16_t* br = x16 + (size_t)(base + rr) * DM;
#pragma unroll
            for (int h = 0; h < 2; ++h) st16((br + h * 512 + lane * 8), pack8(xv[rr][2 * h], xv[rr][2 * h + 1]));
        }
    }
}

__device__ __forceinline__ void sincos2pi(double r, double& s, double& c) {
    const double x = r * 6.283185307179586476925, x2 = x * x;
    double ts = 1.0 / 121645100408832000.0 * -1.0;
    double ps = -1.0 / 25852016738884976640000.0;
    ps = ps * x2 + 1.0 / 51090942171709440000.0;
    ps = ps * x2 - 1.0 / 121645100408832000.0;
    ps = ps * x2 + 1.0 / 355687428096000.0;
    ps = ps * x2 - 1.0 / 1307674368000.0;
    ps = ps * x2 + 1.0 / 6227020800.0;
    ps = ps * x2 - 1.0 / 39916800.0;
    ps = ps * x2 + 1.0 / 362880.0;
    ps = ps * x2 - 1.0 / 5040.0;
    ps = ps * x2 + 1.0 / 120.0;
    ps = ps * x2 - 1.0 / 6.0;
    ps = ps * x2 + 1.0;
    s = ps * x; (void)ts;
    double pc = 1.0 / 620448401733239439360000.0;
    pc = pc * x2 - 1.0 / 1124000727777607680000.0;
    pc = pc * x2 + 1.0 / 2432902008176640000.0;
    pc = pc * x2 - 1.0 / 6402373705728000.0;
    pc = pc * x2 + 1.0 / 20922789888000.0;
    pc = pc * x2 - 1.0 / 87178291200.0;
    pc = pc * x2 + 1.0 / 479001600.0;
    pc = pc * x2 - 1.0 / 3628800.0;
    pc = pc * x2 + 1.0 / 40320.0;
    pc = pc * x2 - 1.0 / 720.0;
    pc = pc * x2 + 1.0 / 24.0;
    pc = pc * x2 - 0.5;
    c = pc * x2 + 1.0;
}
__device__ __forceinline__ double exp_small(double v) {
    double p = 1.0 / 87178291200.0;
    p = p * v + 1.0 / 6227020800.0; p = p * v + 1.0 / 479001600.0; p = p * v + 1.0 / 39916800.0; p = p * v + 1.0 / 3628800.0; p = p * v + 1.0 / 362880.0; p = p * v + 1.0 / 40320.0;
    p = p * v + 1.0 / 5040.0; p = p * v + 1.0 / 720.0; p = p * v + 1.0 / 120.0; p = p * v + 1.0 / 24.0; p = p * v + 1.0 / 6.0; p = p * v + 0.5; p = p * v + 1.0; p = p * v + 1.0; return p;
}
__device__ __forceinline__ double exp_neg(double v) { double e = exp_small(v * 0.0625); e *= e; e *= e; e *= e; e *= e; return e; }
__device__ __forceinline__ void cpow_lam(double lrdt, double lidt, int d, double& re, double& im) {
    double m = (double)d * lrdt;
    double mag = 1.0;
    while (m < -8.0) { mag *= 3.3546262790251185e-4; m += 8.0; }
    while (m > 0.5) { mag *= 1.6487212707001282; m -= 0.5; }
    mag *= (m <= 0.0) ? exp_neg(m) : exp_small(m);
    double rev = (double)d * lidt * 0.15915494309189533577; rev -= __builtin_rint(rev);
    double s, c; sincos2pi(rev, s, c); re = mag * c; im = mag * s;
}

__device__ __forceinline__ void ssm_naive_phase(unsigned char* ws, int a, LAS unsigned char* lds, int wave, int lane) {
    if (wave >= 4) return;
    const float* sp = (const float*)(ws + WS_SP);
    const bf16_t* UA = (const bf16_t*)(ws + WS_UA); bf16_t* Y = (bf16_t*)(ws + WS_Y);
    LAS float* ul = (LAS float*)(lds + wave * 8192); LAS float* yl = ul + 1024;
    for (int task = blockIdx.x * 4 + wave; task < NB * SG; task += gridDim.x * 4) {
        const int b = task >> 6, g = task & 63, n = lane;
        float bbr[16], bbi[16], cr[16], ci[16];
        const int agn = (a * SG + g) * SN + n;
#pragma unroll
        for (int c4 = 0; c4 < 4; ++c4) { const f32x4 r4 = *(const f32x4*)(sp + SP_BBR + agn * SC + c4 * 4), i4 = *(const f32x4*)(sp + SP_BBI + agn * SC + c4 * 4);
#pragma unroll
            for (int e = 0; e < 4; ++e) { bbr[c4 * 4 + e] = r4[e]; bbi[c4 * 4 + e] = i4[e]; } }
#pragma unroll
        for (int c = 0; c < 16; ++c) { cr[c] = sp[SP_CRE + ((a * SG + g) * SC + c) * SN + n]; ci[c] = sp[SP_CIM + ((a * SG + g) * SC + c) * SN + n]; }
        const float ar = sp[SP_AR + agn], ai = sp[SP_AI + agn];
        const int cl = (lane >> 2) & 15; const float dl = sp[SP_SD + (a * SG + g) * SC + cl];
        float sr = 0.f, si = 0.f;
        for (int k = 0; k < 64; ++k) {
            { const bf16_t* src = UA + (size_t)g * UA_G + (size_t)(b * 64 + k) * UA_LD + 128 + lane * 16;
              const u32x4 p0 = *(const u32x4*)src, p1 = *(const u32x4*)(src + 8);
              LAS f32x4* d = (LAS f32x4*)(ul + lane * 16);
              d[0] = (f32x4){bf_lo(p0.x), bf_hi(p0.x), bf_lo(p0.y), bf_hi(p0.y)}; d[1] = (f32x4){bf_lo(p0.z), bf_hi(p0.z), bf_lo(p0.w), bf_hi(p0.w)};
              d[2] = (f32x4){bf_lo(p1.x), bf_hi(p1.x), bf_lo(p1.y), bf_hi(p1.y)}; d[3] = (f32x4){bf_lo(p1.z), bf_hi(p1.z), bf_lo(p1.w), bf_hi(p1.w)}; }
            asm volatile("s_waitcnt lgkmcnt(0)" ::: "memory");
#pragma unroll 2
            for (int j = 0; j < 64; ++j) {
                const LAS f32x4* up = (const LAS f32x4*)(ul + j * 16); const f32x4 u0 = up[0], u1 = up[1], u2 = up[2], u3 = up[3];
                const float uu[16] = {u0[0], u0[1], u0[2], u0[3], u1[0], u1[1], u1[2], u1[3], u2[0], u2[1], u2[2], u2[3], u3[0], u3[1], u3[2], u3[3]};
                float bur = 0.f, bui = 0.f;
#pragma unroll
                for (int c = 0; c < 16; ++c) { bur += bbr[c] * uu[c]; bui += bbi[c] * uu[c]; }
                const float nsr = ar * sr - ai * si + bur, nsi = ar * si + ai * sr + bui; sr = nsr; si = nsi;
                float v[16];
#pragma unroll
                for (int c = 0; c < 16; ++c) v[c] = sr * cr[c] - si * ci[c];
                float w8[8], w4[4], w2[2], w1;
                { const bool h = (lane & 32) != 0;
#pragma unroll
                  for (int i = 0; i < 8; ++i) { const float send = h ? v[i] : v[i + 8], keep = h ? v[i + 8] : v[i]; w8[i] = keep + __shfl_xor(send, 32); } }
                { const bool h = (lane & 16) != 0;
#pragma unroll
                  for (int i = 0; i < 4; ++i) { const float send = h ? w8[i] : w8[i + 4], keep = h ? w8[i + 4] : w8[i]; w4[i] = keep + __shfl_xor(send, 16); } }
                { const bool h = (lane & 8) != 0;
#pragma unroll
                  for (int i = 0; i < 2; ++i) { const float send = h ? w4[i] : w4[i + 2], keep = h ? w4[i + 2] : w4[i]; w2[i] = keep + __shfl_xor(send, 8); } }
                { const bool h = (lane & 4) != 0; const float send = h ? w2[0] : w2[1], keep = h ? w2[1] : w2[0]; w1 = keep + __shfl_xor(send, 4); }
                w1 += __shfl_xor(w1, 2); w1 += __shfl_xor(w1, 1);
                const float yv = gelu_tanh(w1 + dl * ul[j * 16 + cl]);
                if ((lane & 3) == 0) yl[j * 16 + cl] = yv;
            }
            asm volatile("s_waitcnt lgkmcnt(0)" ::: "memory");
            { const LAS f32x4* yp = (const LAS f32x4*)(yl + lane * 16); const f32x4 y0 = yp[0], y1 = yp[1], y2 = yp[2], y3 = yp[3];
              bf16_t* dst = Y + (size_t)(b * SEQ + k * 64 + lane) * DM + g * 16;
              st16(dst, pack8(y0, y1)); st16((dst + 8), pack8(y2, y3)); }
            asm volatile("s_waitcnt lgkmcnt(0)" ::: "memory");
        }
    }
}

__device__ __forceinline__ void attn_naive_phase(const bf16_t* Q, const bf16_t* K, const bf16_t* V, bf16_t* O) {
    for (int unit = blockIdx.x; unit < NB * NHEAD * (SEQ / 512); unit += gridDim.x) {
        const int bh = unit >> 3, tc = unit & 7, b = bh >> 4, h = bh & 15, t = tc * 512 + (int)threadIdx.x;
        const size_t row = (size_t)b * SEQ + t;
        float q[64], o[64];
        { const u32x4* qp = (const u32x4*)(Q + row * DM + h * 64);
#pragma unroll
          for (int i = 0; i < 8; ++i) { const u32x4 w = qp[i]; q[8 * i] = bf_lo(w.x); q[8 * i + 1] = bf_hi(w.x); q[8 * i + 2] = bf_lo(w.y); q[8 * i + 3] = bf_hi(w.y); q[8 * i + 4] = bf_lo(w.z); q[8 * i + 5] = bf_hi(w.z); q[8 * i + 6] = bf_lo(w.w); q[8 * i + 7] = bf_hi(w.w); } }
#pragma unroll
        for (int i = 0; i < 64; ++i) o[i] = 0.f;
        float R = 0.f;
        for (int s = t - 1; s >= 0; --s) {
            const u32x4* kp = (const u32x4*)(K + ((size_t)b * SEQ + s) * DM + h * 64);
            float z = 0.f;
#pragma unroll
            for (int i = 0; i < 8; ++i) { const u32x4 w = kp[i]; z += q[8 * i] * bf_lo(w.x) + q[8 * i + 1] * bf_hi(w.x) + q[8 * i + 2] * bf_lo(w.y) + q[8 * i + 3] * bf_hi(w.y) + q[8 * i + 4] * bf_lo(w.z) + q[8 * i + 5] * bf_hi(w.z) + q[8 * i + 6] * bf_lo(w.w) + q[8 * i + 7] * bf_hi(w.w); }
            const float sp = fmaxf(z, 0.f) + __logf(1.0f + __expf(-fabsf(z)));
            R -= sp;
            const float w = __expf(z + R);
            { const bf16_t* vt = V + (size_t)(h * 64) * MTOK + (size_t)b * SEQ + s;
#pragma unroll
              for (int i = 0; i < 64; ++i) o[i] += w * bf_lo((unsigned)vt[(size_t)i * MTOK]); }
            if (R < -40.f) break;
        }
        u32x4* op = (u32x4*)(O + row * DM + h * 64);
#pragma unroll
        for (int i = 0; i < 8; ++i) { u32x4 w; w.x = cvt_pk_bf16(o[8 * i], o[8 * i + 1]); w.y = cvt_pk_bf16(o[8 * i + 2], o[8 * i + 3]); w.z = cvt_pk_bf16(o[8 * i + 4], o[8 * i + 5]); w.w = cvt_pk_bf16(o[8 * i + 6], o[8 * i + 7]); op[i] = w; }
    }
}

typedef short bf16x8 __attribute__((ext_vector_type(8)));
typedef float f32x16 __attribute__((ext_vector_type(16)));
template <bool DIAG> __device__ __forceinline__ void sb_tile(const f32x16& st, float& R, int r32, int hi, u32x4& p0, u32x4& p1) {
    float L[16], gs[4], og[4], w[16];
#pragma unroll
    for (int r = 0; r < 16; ++r) { const float z = st[r]; const float lg = __builtin_amdgcn_logf(1.0f + __builtin_amdgcn_exp2f(-fabsf(z))); const float v = -(fmaxf(z, 0.f) + lg);
        if (DIAG) { const int kap = (r & 3) + 8 * (r >> 2) + 4 * hi; L[r] = (kap >= r32) ? 0.f : v; } else L[r] = v; }
#pragma unroll
    for (int g = 0; g < 4; ++g) { gs[g] = (L[4 * g] + L[4 * g + 1]) + (L[4 * g + 2] + L[4 * g + 3]); og[g] = __shfl_xor(gs[g], 32); }
    float above = 0.f;
#pragma unroll
    for (int g = 3; g >= 0; --g) {
        float run = R + above + (hi == 0 ? og[g] : 0.f);
#pragma unroll
        for (int e = 3; e >= 0; --e) { const int r = 4 * g + e; run += L[r]; const float wv = __builtin_amdgcn_exp2f(st[r] + run);
            if (DIAG) { const int kap = e + 8 * g + 4 * hi; w[r] = (kap >= r32) ? 0.f : wv; } else w[r] = wv; }
        above += gs[g] + og[g];
    }
    R += above;
    p0.x = cvt_pk_bf16(w[0], w[1]); p0.y = cvt_pk_bf16(w[2], w[3]); p0.z = cvt_pk_bf16(w[4], w[5]); p0.w = cvt_pk_bf16(w[6], w[7]);
    p1.x = cvt_pk_bf16(w[8], w[9]); p1.y = cvt_pk_bf16(w[10], w[11]); p1.z = cvt_pk_bf16(w[12], w[13]); p1.w = cvt_pk_bf16(w[14], w[15]);
}
__device__ __forceinline__ void attn_mfma_phase(const bf16_t* Q, const bf16_t* K, const bf16_t* VT, bf16_t* O, LAS unsigned char* lds, int gw, int NGW, int wave, int lane) {
    const int r32 = lane & 31, hi = lane >> 5;
    LAS bf16_t* stg = (LAS bf16_t*)(lds + wave * 16384);
    LAS unsigned char* kst = lds + wave * 16384 + 4096; LAS unsigned char* vst = kst + 32 * 144;
#define ATT_LOAD(KR, VR, RB, HH, S0) do { \
        _Pragma("unroll") for (int i = 0; i < 4; ++i) { KR[i] = *(const u32x4*)(K + ((RB) + (S0) + 8 * i + (lane >> 3)) * DM + (HH) * 64 + (lane & 7) * 8); \
            VR[i] = *(const u32x4*)(VT + (size_t)((HH) * 64 + 16 * i + (lane >> 2)) * MTOK + (RB) + (S0) + (lane & 3) * 8); } } while (0)
#define ATT_LOADQ(QF, RB, HH, T0) do { _Pragma("unroll") for (int d0 = 0; d0 < 4; ++d0) QF[d0] = *(const bf16x8*)(Q + ((RB) + (T0) + r32) * DM + (HH) * 64 + d0 * 16 + hi * 8); } while (0)
    const int NUNIT = NB * NHEAD * (SEQ / 32);
    bf16x8 qn[4]; u32x4 krn[4], vrn[4];
    if (gw < NUNIT) { const int bh_ = gw >> 7, t0_ = (gw & 127) * 32; const size_t rb_ = (size_t)(bh_ >> 4) * SEQ; ATT_LOADQ(qn, rb_, bh_ & 15, t0_); ATT_LOAD(krn, vrn, rb_, bh_ & 15, t0_); }
    for (int unit = gw; unit < NUNIT; unit += NGW) {
        const int qb = unit & 127, bh = unit >> 7, b = bh >> 4, h = bh & 15, t0 = qb * 32;
        const size_t rowb = (size_t)b * SEQ;
        bf16x8 qf[4]; u32x4 kr[4], vr[4];
#pragma unroll
        for (int i = 0; i < 4; ++i) { qf[i] = qn[i]; kr[i] = krn[i]; vr[i] = vrn[i]; }
        f32x16 o0, o1;
#pragma unroll
        for (int r = 0; r < 16; ++r) { o0[r] = 0.f; o1[r] = 0.f; }
        float R = 0.f;
        bool nxt_pending = (unit + NGW < NUNIT);
        for (int s0 = t0; s0 >= 0; s0 -= 32) {
            const bool more = s0 >= 32;
#pragma unroll
            for (int i = 0; i < 4; ++i) { *(LAS u32x4*)(kst + (8 * i + (lane >> 3)) * 144 + (lane & 7) * 16) = kr[i]; *(LAS u32x4*)(vst + (16 * i + (lane >> 2)) * 80 + (lane & 3) * 16) = vr[i]; }
            asm volatile("s_waitcnt lgkmcnt(0)" ::: "memory");
            if (more) ATT_LOAD(kr, vr, rowb, h, s0 - 32);
            if (nxt_pending) { nxt_pending = false; const int un_ = unit + NGW, bh_ = un_ >> 7, t0_ = (un_ & 127) * 32; const size_t rb_ = (size_t)(bh_ >> 4) * SEQ; ATT_LOADQ(qn, rb_, bh_ & 15, t0_); ATT_LOAD(krn, vrn, rb_, bh_ & 15, t0_); }
            bf16x8 kf[4], vf[2][2];
#pragma unroll
            for (int d0 = 0; d0 < 4; ++d0) kf[d0] = *(const LAS bf16x8*)(kst + r32 * 144 + d0 * 32 + hi * 16);
#pragma unroll
            for (int db = 0; db < 2; ++db)
#pragma unroll
                for (int ks = 0; ks < 2; ++ks) { const u32x2 lo_ = *(const LAS u32x2*)(vst + (r32 + 32 * db) * 80 + 32 * ks + 8 * hi), h8_ = *(const LAS u32x2*)(vst + (r32 + 32 * db) * 80 + 32 * ks + 8 * hi + 16);
                    const u32x4 v_ = {lo_.x, lo_.y, h8_.x, h8_.y}; vf[db][ks] = __builtin_bit_cast(bf16x8, v_); }
            asm volatile("s_waitcnt lgkmcnt(0)" ::: "memory");
            f32x16 st;
#pragma unroll
            for (int r = 0; r < 16; ++r) st[r] = 0.f;
#pragma unroll
            for (int d0 = 0; d0 < 4; ++d0) st = __builtin_amdgcn_mfma_f32_32x32x16_f16(__builtin_bit_cast(pg8::h16x8, kf[d0]), __builtin_bit_cast(pg8::h16x8, qf[d0]), st, 0, 0, 0);
            u32x4 p0, p1;
            if (s0 == t0) sb_tile<true>(st, R, r32, hi, p0, p1); else sb_tile<false>(st, R, r32, hi, p0, p1);
            const bf16x8 pa0 = __builtin_bit_cast(bf16x8, p0), pa1 = __builtin_bit_cast(bf16x8, p1);
            o0 = __builtin_amdgcn_mfma_f32_32x32x16_f16(__builtin_bit_cast(pg8::h16x8, pa0), __builtin_bit_cast(pg8::h16x8, vf[0][0]), o0, 0, 0, 0); o0 = __builtin_amdgcn_mfma_f32_32x32x16_f16(__builtin_bit_cast(pg8::h16x8, pa1), __builtin_bit_cast(pg8::h16x8, vf[0][1]), o0, 0, 0, 0);
            o1 = __builtin_amdgcn_mfma_f32_32x32x16_f16(__builtin_bit_cast(pg8::h16x8, pa0), __builtin_bit_cast(pg8::h16x8, vf[1][0]), o1, 0, 0, 0); o1 = __builtin_amdgcn_mfma_f32_32x32x16_f16(__builtin_bit_cast(pg8::h16x8, pa1), __builtin_bit_cast(pg8::h16x8, vf[1][1]), o1, 0, 0, 0);
            if (__all(R < -30.f)) break;
        }
#pragma unroll
        for (int r = 0; r < 16; ++r) { const int q = (r & 3) + 8 * (r >> 2) + 4 * hi; stg[q * 64 + r32] = (bf16_t)(cvt_pk_bf16(o0[r], 0.f) & 0xffffu); stg[q * 64 + 32 + r32] = (bf16_t)(cvt_pk_bf16(o1[r], 0.f) & 0xffffu); }
        asm volatile("s_waitcnt lgkmcnt(0)" ::: "memory");
#pragma unroll
        for (int i = 0; i < 4; ++i) { const int row = i * 8 + (lane >> 3), ch = lane & 7; const u32x4 v = *(const LAS u32x4*)(stg + row * 64 + ch * 8); *(u32x4*)(O + (rowb + t0 + row) * DM + h * 64 + ch * 8) = v; }
        asm volatile("s_waitcnt lgkmcnt(0)" ::: "memory");
    }
#undef ATT_LOAD
#undef ATT_LOADQ
}

__device__ __forceinline__ float bfly16(const float (&v)[16], int lane) {
    float w8[8], w4[4], w2[2], w1;
    { const bool h = (lane & 32) != 0;
#pragma unroll
      for (int i = 0; i < 8; ++i) { const float send = h ? v[i] : v[i + 8], keep = h ? v[i + 8] : v[i]; w8[i] = keep + __shfl_xor(send, 32); } }
    { const bool h = (lane & 16) != 0;
#pragma unroll
      for (int i = 0; i < 4; ++i) { const float send = h ? w8[i] : w8[i + 4], keep = h ? w8[i + 4] : w8[i]; w4[i] = keep + __shfl_xor(send, 16); } }
    { const bool h = (lane & 8) != 0;
#pragma unroll
      for (int i = 0; i < 2; ++i) { const float send = h ? w4[i] : w4[i + 2], keep = h ? w4[i + 2] : w4[i]; w2[i] = keep + __shfl_xor(send, 8); } }
    { const bool h = (lane & 4) != 0; const float send = h ? w2[0] : w2[1], keep = h ? w2[1] : w2[0]; w1 = keep + __shfl_xor(send, 4); }
    w1 += __shfl_xor(w1, 2); w1 += __shfl_xor(w1, 1); return w1;
}
__device__ __forceinline__ void ssm_expand_tables(unsigned char* ws, int a, int gt, int NGT) {
    const float* sp = (const float*)(ws + WS_SP); const float* PW = (const float*)(ws + WS_PW); const float* KD = (const float*)(ws + WS_KD);
    bf16_t* KQT = (bf16_t*)(ws + WS_KQT); bf16_t* PT = (bf16_t*)(ws + WS_PT);
#pragma unroll 4
    for (int idx = gt; idx < SG * 1024 * 128; idx += NGT) {
        const int cj = idx & 127, rowi = idx >> 7, g = rowi >> 10, n = rowi & 1023, l = n >> 4, c = n & 15, j = cj >> 1, c0 = (cj & 1) * 8, d = l - j, dc = d < 0 ? 0 : d;
        if (cj >= 32 * ((l >> 4) + 1)) continue;
        const float* kd = KD + ((size_t)((a * SG + g) * 64 + dc) * 16 + c) * 16 + c0; f32x4 v0 = *(const f32x4*)kd, v1 = *(const f32x4*)(kd + 4);
        if (d < 0) { v0 = (f32x4){0.f, 0.f, 0.f, 0.f}; v1 = v0; }
        st16((KQT + (size_t)rowi * UA_LD + 128 + cj * 8), pack8(v0, v1));
    }
#pragma unroll 2
    for (int idx = gt; idx < SG * 1024 * 16; idx += NGT) {
        const int ck = idx & 15, rowi = idx >> 4, g = rowi >> 10, n = rowi & 1023, l = n >> 4, c = n & 15, nb = (ck & 7) * 8; const bool imag = ck >= 8; f32x4 v0, v1;
        const float* cr = sp + SP_CRE + ((a * SG + g) * SC + c) * SN + nb; const float* ci = sp + SP_CIM + ((a * SG + g) * SC + c) * SN + nb; const float* pw = PW + ((size_t)((a * SG + g) * 65 + l + 1) * 64 + nb) * 2;
#pragma unroll
        for (int e = 0; e < 8; ++e) { const float Cr = cr[e], Ci = ci[e], pr = pw[2 * e], pi = pw[2 * e + 1]; const float val = imag ? -(Cr * pi + Ci * pr) : (Cr * pr - Ci * pi); if (e < 4) v0[e] = val; else v1[e - 4] = val; }
        st16((KQT + (size_t)rowi * UA_LD + ck * 8), pack8(v0, v1));
    }
#pragma unroll 2
    for (int idx = gt; idx < SG * 128 * 128; idx += NGT) {
        const int ck = idx & 127, rowi = idx >> 7, g = rowi >> 7, r = rowi & 127, np = r & 63, j = ck >> 1, c0 = (ck & 1) * 8; const bool imag = r >= 64;
        const float* pw = PW + ((size_t)((a * SG + g) * 65 + 63 - j) * 64 + np) * 2; const float pr = pw[0], pi = pw[1];
        const float* br = sp + SP_BBR + ((a * SG + g) * SN + np) * SC + c0; const float* bi = sp + SP_BBI + ((a * SG + g) * SN + np) * SC + c0; f32x4 v0, v1;
#pragma unroll
        for (int e = 0; e < 8; ++e) { const float val = imag ? (pr * bi[e] + pi * br[e]) : (pr * br[e] - pi * bi[e]); if (e < 4) v0[e] = val; else v1[e - 4] = val; }
        st16((PT + (size_t)rowi * 1024 + ck * 8), pack8(v0, v1));
    }
}
__device__ __forceinline__ void ssm_carry(unsigned char* ws, int a, int gt, int NGT) {
    const float* PW = (const float*)(ws + WS_PW); const float* SL = (const float*)(ws + WS_SLOC); bf16_t* UA = (bf16_t*)(ws + WS_UA);
    for (int idx = gt; idx < SG * NB * SN; idx += NGT) {
        const int n = idx & 63, b = (idx >> 6) & 15, g = idx >> 10;
        const float* pw = PW + ((size_t)((a * SG + g) * 65 + 64) * 64 + n) * 2; const float ar = pw[0], ai = pw[1];
        float sr = 0.f, si = 0.f;
#pragma unroll 8
        for (int k = 0; k < 64; ++k) { const int chunk = b * 64 + k; bf16_t* up = UA + (size_t)g * UA_G + (size_t)chunk * UA_LD; const float* sl = SL + ((size_t)g * 1024 + chunk) * 128;
            up[n] = (bf16_t)(cvt_pk_bf16(sr, 0.f) & 0xffffu); up[64 + n] = (bf16_t)(cvt_pk_bf16(si, 0.f) & 0xffffu);
            const float lr = sl[n], li = sl[64 + n]; const float nsr = ar * sr - ai * si + lr, nsi = ar * si + ai * sr + li; sr = nsr; si = nsi; }
    }
}
__device__ __forceinline__ void ssm_carry_unit(unsigned char* ws, int a, int g, int pm4, int t) {
    if (t >= 256) return;
    const float* PW = (const float*)(ws + WS_PW); const float* SL = (const float*)(ws + WS_SLOC); bf16_t* UA = (bf16_t*)(ws + WS_UA);
    const int n = t & 63, b = 4 * pm4 + (t >> 6);
    const float* pw = PW + ((size_t)((a * SG + g) * 65 + 64) * 64 + n) * 2; const float ar = pw[0], ai = pw[1];
    float sr = 0.f, si = 0.f;
#pragma unroll 8
    for (int k = 0; k < 64; ++k) { const int chunk = b * 64 + k; bf16_t* up = UA + (size_t)g * UA_G + (size_t)chunk * UA_LD; const float* sl = SL + ((size_t)g * 1024 + chunk) * 128;
        up[n] = (bf16_t)(cvt_pk_bf16(sr, 0.f) & 0xffffu); up[64 + n] = (bf16_t)(cvt_pk_bf16(si, 0.f) & 0xffffu);
        const float lr = sl[n], li = sl[64 + n]; const float nsr = ar * sr - ai * si + lr, nsi = ar * si + ai * sr + li; sr = nsr; si = nsi; }
}

#define GAS __attribute__((address_space(1)))
#define XB_TMO      128
#define XB_XCNT(j)  (256  + 64 * (j))
#define XB_XSUB(j)  (1280 + 64 * (j))
#define XB_XGEN(j)  (2304 + 64 * (j))
#define XB_TOP      3328
#define XB_TOPGEN   3392
#define XCD_BAR_WORDS 3456
#define XB_SPIN_CAP (1u << 18)

__device__ __forceinline__ unsigned xb_ld(unsigned* p)              { return __hip_atomic_load(p, __ATOMIC_RELAXED, __HIP_MEMORY_SCOPE_AGENT); }
__device__ __forceinline__ unsigned xb_add(unsigned* p, unsigned v) { return __hip_atomic_fetch_add(p, v, __ATOMIC_RELAXED, __HIP_MEMORY_SCOPE_AGENT); }
__device__ __forceinline__ unsigned xb_xcc_id() { return (unsigned)__builtin_amdgcn_s_getreg((3 << 11) | 20) & 0xFu; }
#define XB_SPIN(cond, bar) do { unsigned _sp = 0; while (cond) { __builtin_amdgcn_s_sleep(1); \
    if ((++_sp & 255u) == 0u) { if (xb_ld(&(bar)[XB_TMO])) break; if (_sp > XB_SPIN_CAP) { atomicAdd(&(bar)[XB_TMO], 1u); break; } } } } while (0)

struct XcdBarrier {
    unsigned* bar; unsigned x;
    volatile LAS unsigned* st;
};

__device__ __forceinline__ XcdBarrier xcd_barrier_post(unsigned* bar, volatile LAS unsigned* st) {
    XcdBarrier b; b.bar = bar; b.x = xb_xcc_id(); b.st = st;
    if (threadIdx.x == 0) (void)xb_add(&bar[XB_XCNT(b.x)], 1u);
    return b;
}
__device__ __forceinline__ void xcd_barrier_complete(unsigned* bar, unsigned x, unsigned& nloc, unsigned& nx) {
    const unsigned G = gridDim.x * gridDim.y * gridDim.z;
    unsigned sum, cnt, mine, sp = 0u;
    for (;;) {
        sum = 0u; cnt = 0u; mine = 0u;
#pragma unroll
        for (unsigned j = 0; j < 16; ++j) { const unsigned c = xb_ld(&bar[XB_XCNT(j)]); sum += c; cnt += (c > 0u) ? 1u : 0u; mine = (j == x) ? c : mine; }
        if (sum == G) break;
        __builtin_amdgcn_s_sleep(1);
        if ((++sp & 255u) == 0u) { if (xb_ld(&bar[XB_TMO])) break; if (sp > XB_SPIN_CAP) { atomicAdd(&bar[XB_TMO], 1u); break; } }
    }
    nloc = mine > 0u ? mine : 1u; nx = cnt > 0u ? cnt : 1u;
}

__device__ __forceinline__ void xcd_barrier(const XcdBarrier& b) {
    asm volatile("s_waitcnt vmcnt(0)" ::: "memory");
    __syncthreads();
    if (threadIdx.x == 0) {
        unsigned* bar = b.bar;
        __builtin_amdgcn_s_waitcnt(0);
        unsigned nloc = b.st[0], nx = b.st[1];
        if (nloc == 0u) { xcd_barrier_complete(bar, b.x, nloc, nx); b.st[0] = nloc; b.st[1] = nx; }
        const unsigned old = xb_add(&bar[XB_XSUB(b.x)], 1u);
        const unsigned gen = old / nloc;
        if (old + 1u == (gen + 1u) * nloc) {
            __builtin_amdgcn_fence(__ATOMIC_RELEASE, "agent");
            asm volatile("s_waitcnt vmcnt(0)" ::: "memory");
            const unsigned og = xb_add(&bar[XB_TOP], 1u);
            const unsigned tg = og / nx;
            if (og + 1u == (tg + 1u) * nx) xb_add(&bar[XB_TOPGEN], 1u);
            else XB_SPIN(xb_ld(&bar[XB_TOPGEN]) == tg, bar);
            __builtin_amdgcn_fence(__ATOMIC_ACQUIRE, "agent");
            xb_add(&bar[XB_XGEN(b.x)], 1u);
            asm volatile("s_waitcnt vmcnt(0)" ::: "memory");
        } else {
            XB_SPIN(xb_ld(&bar[XB_XGEN(b.x)]) == gen, bar);
            __builtin_amdgcn_fence(__ATOMIC_ACQUIRE, "agent");
            asm volatile("s_waitcnt vmcnt(0)" ::: "memory");
        }
    }
    __syncthreads();
}

constexpr int CW_GMASK = 4096, CW_GCNT = 4096 + 512;
__device__ __forceinline__ void group_barrier(unsigned* cnt) {
    asm volatile("s_waitcnt vmcnt(0)" ::: "memory");
    __syncthreads();
    if (threadIdx.x == 0) {
        const unsigned old = __hip_atomic_fetch_add(cnt, 1u, __ATOMIC_RELAXED, __HIP_MEMORY_SCOPE_AGENT), target = (old / 32u + 1u) * 32u; unsigned sp = 0u;
        while (__hip_atomic_load(cnt, __ATOMIC_RELAXED, __HIP_MEMORY_SCOPE_AGENT) < target) { __builtin_amdgcn_s_sleep(1); if (++sp > (1u << 22)) break; }
        __builtin_amdgcn_fence(__ATOMIC_ACQUIRE, "agent");
        asm volatile("s_waitcnt vmcnt(0)" ::: "memory");
    }
    __syncthreads();
}

constexpr int NS5 = 9, NMIX5 = 5, NAT = 7;
constexpr int NPH = 1 + 2 * NS5 + 2 * NAT;
template <class Op> __device__ __forceinline__ void run_gemm(LAS unsigned char* lds, const bf16_t* A, const bf16_t* Bt, int M, int N, int K, const Op& op) {
    pg8::Gemm g{A, Bt, M, N, K, K, K, 0, 0}; pg8::StaticOrder S; S.init(M, N, (int)gridDim.x, (int)blockIdx.x); EpiGen<Op> E{op, (LAS float*)(lds + RING_BYTES + 8192), -1};
    pg8::gemm_phase<EpiGen<Op>, pg8::StaticOrder, true, true>(lds, g, S, E);
}
template <class Op> __device__ __forceinline__ void run_gemm_n(LAS unsigned char* lds, const bf16_t* A, const bf16_t* Bt, int M, int N, int K, const Op& op) {
    pg8::Gemm g{A, Bt, M, N, K, K, K, 0, 0}; pg8::StaticOrder S; S.init(M, N, (int)gridDim.x, (int)blockIdx.x); EpiGen<Op> E{op, (LAS float*)(lds + RING_BYTES + 8192), -1};
    pg8::gemm_phase<EpiGen<Op>, pg8::StaticOrder, true, true>(lds, g, S, E);
}
__device__ __forceinline__ void run_gemm_fused(LAS unsigned char* lds, const bf16_t* A, const bf16_t* Bt, int K, const EpiFused& E) {
    pg8::Gemm g{A, Bt, MTOK, DM, K, K, K, 0, 0}; pg8::StaticOrder S; S.init(MTOK, DM, (int)gridDim.x, (int)blockIdx.x);
    pg8::gemm_phase<EpiFused, pg8::StaticOrder, true, true>(lds, g, S, E);
}
template <class Op> __device__ __forceinline__ void run_gemm_b(LAS unsigned char* lds, const bf16_t* A, const bf16_t* Bt, int M, int N, int K, int lda, int ldb, size_t sAz, size_t sBz, int nz, int tri, const Op& op) {
    pg8::Gemm g{A, Bt, M, N, K, lda, ldb, sAz, sBz}; pg8::BatchOrder S; S.init(M, N, nz, (int)gridDim.x, (int)blockIdx.x, tri); EpiGen<Op> E{op, (LAS float*)(lds + RING_BYTES + 8192), -1};
    pg8::gemm_phase<EpiGen<Op>, pg8::BatchOrder, true, true>(lds, g, S, E);
}
__global__ void __launch_bounds__(NWAVES * 64, 2) mk_fwd(Args A) {
    extern __shared__ __attribute__((aligned(16))) unsigned char lds_raw[];
    LAS unsigned char* lds = (LAS unsigned char*)lds_raw;
    const int tid = threadIdx.x, lane = tid & 63, wave = __builtin_amdgcn_readfirstlane(tid >> 6);
    const int gw = blockIdx.x * NWAVES + wave, NGW = gridDim.x * NWAVES;
    unsigned char* ws = A.ws;
    float* RS = (float*)(ws + WS_RS); bf16_t* Wb = (bf16_t*)(ws + WS_W); bf16_t* XB = (bf16_t*)(ws + WS_XB); bf16_t* HID = (bf16_t*)(ws + WS_HID);
    bf16_t* UA = (bf16_t*)(ws + WS_UA); bf16_t* Yb = (bf16_t*)(ws + WS_Y); bf16_t* Zb = (bf16_t*)(ws + WS_Z);
    bf16_t* Qb = (bf16_t*)A.out + (size_t)MTOK * DM; bf16_t* Ob = (bf16_t*)(ws + WS_O); bf16_t* Kb = (bf16_t*)(ws + WS_K); bf16_t* Vb = (bf16_t*)(ws + WS_V);
    float* X = A.out; const float* SP = (const float*)(ws + WS_SP); const float* NG = SP + SP_NG;
    volatile LAS unsigned* misc = (volatile LAS unsigned*)(lds + RING_BYTES + 64);
    if (tid < 4) misc[tid] = 0u;
    __syncthreads();
    if (tid == 0) __hip_atomic_fetch_or((unsigned*)A.ws + CW_GMASK + 64 * (blockIdx.x & 7), 1u << xb_xcc_id(), __ATOMIC_RELAXED, __HIP_MEMORY_SCOPE_AGENT);
    (void)xcd_barrier_post((unsigned*)A.ws, misc);
    int p0 = A.ph_lo;
    if (p0 == 0) {
        {
            LAS float* scr = (LAS float*)(lds + wave * 16384); int cstart = gw;
            const float* NGi = A.in[I_NG];
            for (int l = 0; l < 4; ++l) for (int j = 0; j < 2; ++j) { const int lj = l * 2 + j; bf16_t* wgu = Wb + WO_FFN + (size_t)lj * W_FFN; const float* gn = NGi + (l * 6 + (j ? 4 : 0)) * DM;
                CONV(A.in[I_WG] + (size_t)lj * DM * DFF, DM, DFF, gn, 1, wgu, 0); CONV(A.in[I_WU] + (size_t)lj * DM * DFF, DM, DFF, gn, 2, wgu, 0);
                CONV(A.in[I_WD] + (size_t)lj * DFF * DM, DFF, DM, (const float*)nullptr, 0, wgu + W_GU, 0); }
            for (int a = 0; a < 2; ++a) { bf16_t* w = Wb + WO_SSM + (size_t)a * 3 * W_SQ;
                CONV(A.in[I_SWIN] + (size_t)a * W_SQ, DM, DM, NGi + (a * 6 + 2) * DM, 0, w, 0); CONV(A.in[I_SWGLU] + (size_t)a * W_SQ, DM, DM, (const float*)nullptr, 0, w + W_SQ, 0);
                CONV(A.in[I_SWOUT] + (size_t)a * W_SQ, DM, DM, (const float*)nullptr, 0, w + 2 * W_SQ, 0); }
            CONV(A.in[I_WQ], DM, DM, NGi + (2 * 6 + 2) * DM, 0, Wb + WO_QKV, 0); CONV(A.in[I_WK], DM, DM, A.in[I_KVG], 0, Wb + WO_QKV, DM); CONV(A.in[I_WV], DM, DM, A.in[I_KVG], 0, Wb + WO_QKV, 2 * DM);
            CONV(A.in[I_WQ] + W_SQ, DM, DM, NGi + (3 * 6 + 2) * DM, 0, Wb + WO_Q1, 0);
            CONV(A.in[I_WO], DM, DM, (const float*)nullptr, 0, Wb + WO_O, 0); CONV(A.in[I_WO] + W_SQ, DM, DM, (const float*)nullptr, 0, Wb + WO_O + W_SQ, 0);
            float* spw = (float*)(ws + WS_SP); const int gt = blockIdx.x * (NWAVES * 64) + tid, NGT = gridDim.x * NWAVES * 64;
#define COPYP(idx, off, n) for (int i_ = gt; i_ < (n); i_ += NGT) spw[(off) + i_] = A.in[idx][i_]
            for (int i_ = gt; i_ < (int)((size_t)MTOK * 4 * 8 / 16); i_ += NGT) ((u32x4*)(ws + WS_XS1))[i_] = (u32x4){0u, 0u, 0u, 0u};
            COPYP(I_NG, SP_NG, 24576); COPYP(I_LRE, SP_LRE, 8192); COPYP(I_LIM, SP_LIM, 8192); COPYP(I_LDT, SP_LDT, 128); COPYP(I_BRE, SP_BRE, 131072); COPYP(I_BIM, SP_BIM, 131072);
            COPYP(I_CRE, SP_CRE, 131072); COPYP(I_CIM, SP_CIM, 131072); COPYP(I_SD, SP_SD, 2048);
            for (int i = gt; i < 2 * SG * SN; i += NGT) {
                const int ag = i >> 6;
                const double dt = (double)expf(A.in[I_LDT][ag]);
                const double lr = A.in[I_LRE][i], li = A.in[I_LIM][i];
                double are, aim; cpow_lam(lr * dt, li * dt, 1, are, aim);
                const double den = lr * lr + li * li, nr = are - 1.0, ni = aim;
                const double fre = (nr * lr + ni * li) / den, fim = (ni * lr - nr * li) / den;
                spw[SP_AR + i] = (float)are; spw[SP_AI + i] = (float)aim;
                for (int c = 0; c < 16; ++c) { const double br = A.in[I_BRE][(size_t)i * SC + c], bi = A.in[I_BIM][(size_t)i * SC + c];
                    spw[SP_BBR + i * SC + c] = (float)(fre * br - fim * bi); spw[SP_BBI + i * SC + c] = (float)(fre * bi + fim * br); }
            }
            {
                float* PWw = (float*)(ws + WS_PW); float* KDw = (float*)(ws + WS_KD);
                for (int i = gt; i < 2 * SG * 65 * SN; i += NGT) { const int n = i & 63, d = (i >> 6) % 65, ag = (i >> 6) / 65;
                    const double dt = (double)expf(A.in[I_LDT][ag]); const double lr = A.in[I_LRE][ag * SN + n], li = A.in[I_LIM][ag * SN + n];
                    double pr, pi; cpow_lam(lr * dt, li * dt, d, pr, pi); PWw[2 * (size_t)i] = (float)pr; PWw[2 * (size_t)i + 1] = (float)pi; }
                for (int task = gw; task < 2 * SG * 64; task += NGW) { const int ag = task >> 6, d = task & 63, n = lane, i = ag * SN + n;
                    const double dt = (double)expf(A.in[I_LDT][ag]); const double lr = A.in[I_LRE][i], li = A.in[I_LIM][i];
                    double are, aim, pr, pi; cpow_lam(lr * dt, li * dt, 1, are, aim); cpow_lam(lr * dt, li * dt, d, pr, pi);
                    const double den = lr * lr + li * li, nr = are - 1.0, ni = aim; const double fre = (nr * lr + ni * li) / den, fim = (ni * lr - nr * li) / den;
                    float tre[16], tim[16];
#pragma unroll
                    for (int c = 0; c < 16; ++c) { const double br = A.in[I_BRE][(size_t)i * SC + c], bi = A.in[I_BIM][(size_t)i * SC + c]; const double bbr = fre * br - fim * bi, bbi = fre * bi + fim * br;
                        tre[c] = (float)(pr * bbr - pi * bbi); tim[c] = (float)(pr * bbi + pi * bbr); }
                    const int cl = (lane >> 2) & 15;
                    for (int c = 0; c < 16; ++c) { const float Cr = A.in[I_CRE][((size_t)ag * SC + c) * SN + n], Ci = A.in[I_CIM][((size_t)ag * SC + c) * SN + n]; float v[16];
#pragma unroll
                        for (int e = 0; e < 16; ++e) v[e] = Cr * tre[e] - Ci * tim[e];
                        const float tot = bfly16(v, lane); if ((lane & 3) == 0) KDw[((size_t)task * 16 + c) * 16 + cl] = tot; }
                }
            }
            row_update<0, 4>(A.in[I_X], XB, nullptr, RS, nullptr, 0.f, nullptr, gw, NGW, lane); PROBE_RU_X
        }
        p0 = 1;
        if (A.ph_hi > 1) { cg::this_grid().sync(); }
        if (tid == 0) {
            unsigned ok = (gridDim.x == 256u) ? 1u : 0u;
            for (int x = 0; x < 8; ++x) { const unsigned m = __hip_atomic_load((unsigned*)A.ws + CW_GMASK + 64 * x, __ATOMIC_RELAXED, __HIP_MEMORY_SCOPE_AGENT); if (__builtin_popcount(m) != 1) ok = 0u; }
            misc[2] = ok; }
        __syncthreads();
    }
    for (int p = p0; p < A.ph_hi; ++p) {
        {
            unsigned char* ws = A.ws; asm volatile("" : "+s"(ws));
            int lane_p = lane, gw_p = gw; asm volatile("" : "+v"(lane_p)); asm volatile("" : "+s"(gw_p));
            float* RS = (float*)(ws + WS_RS); bf16_t* Wb = (bf16_t*)(ws + WS_W); bf16_t* XB = (bf16_t*)(ws + WS_XB); bf16_t* HID = (bf16_t*)(ws + WS_HID);
            bf16_t* UA = (bf16_t*)(ws + WS_UA); bf16_t* Yb = (bf16_t*)(ws + WS_Y); bf16_t* Zb = (bf16_t*)(ws + WS_Z);
            bf16_t* Qb = (bf16_t*)A.out + (size_t)MTOK * DM; bf16_t* Ob = (bf16_t*)(ws + WS_O); bf16_t* Kb = (bf16_t*)(ws + WS_K); bf16_t* Vb = (bf16_t*)(ws + WS_V);
            float* X = A.out; const float* SP = (const float*)(ws + WS_SP); const float* NG = SP + SP_NG;
            const int q = p - 1, layer = q < 2 * NS5 ? q / NS5 : 2 + (q - 2 * NS5) / NAT, s = q < 2 * NS5 ? q % NS5 : (q - 2 * NS5) % NAT;
            const int nmix = layer < 2 ? NMIX5 : 3;
            const int sub = (s < 2) ? 0 : (s < 2 + nmix ? 1 : 2);
            EpiFused EF; EF.x16 = XB; EF.g = NG + (layer * 6 + (sub == 0 ? 1 : (sub == 1 ? 3 : 5))) * DM; EF.alpha = (sub == 1) ? 1.0f : 0.5f; EF.outf = (layer == 3 && sub == 2) ? X : nullptr;
            EF.xs1 = (float*)(ws + WS_XS1); EF.ssq2 = RS; EF.cnt = (unsigned*)ws + CW_PCNT; EF.want = 32u * (unsigned)(layer * 3 + sub + 1); EF.xl = lds + RING_BYTES + 1024; EF.cpn = -1;
            if (s < 2 || s >= 2 + nmix) {
                const int j = s < 2 ? 0 : 1, st = s < 2 ? s : s - 2 - nmix; const bf16_t* wgu = Wb + WO_FFN + (size_t)(layer * 2 + j) * W_FFN;
                if (st == 0) run_gemm(lds, XB, wgu, MTOK, 2 * DFF, DM, OpSwiglu{RS, HID});
                else run_gemm_fused(lds, HID, wgu + W_GU, DFF, EF);
            } else if (layer < 2) {
                const bf16_t* w = Wb + WO_SSM + (size_t)layer * 3 * W_SQ; const int st = s - 2;
                if (st == 0) { run_gemm(lds, XB, w, MTOK, DM, DM, OpUA{UA, RS}); int tid_p = tid; asm volatile("" : "+v"(tid_p)); const int gt_l = blockIdx.x * (NWAVES * 64) + tid_p; ssm_expand_tables(ws, layer, gt_l, (int)gridDim.x * NWAVES * 64); }
                else if (st == 1) {
                    run_gemm_b(lds, UA + 128, (const bf16_t*)(ws + WS_PT), 1024, 256, 1024, UA_LD, 1024, UA_G, (size_t)128 * 1024, SG, 0, OpSloc{(float*)(ws + WS_SLOC)});
                    asm volatile("s_waitcnt vmcnt(0)" ::: "memory"); __syncthreads();
                    int tid_p = tid; asm volatile("" : "+v"(tid_p));
                    for (int L = blockIdx.x; L < SG * 4; L += gridDim.x) ssm_carry_unit(ws, layer, L >> 2, L & 3, tid_p); }
                else if (st == 2) run_gemm_b(lds, UA, (const bf16_t*)(ws + WS_KQT), 1024, 1024, UA_LD, UA_LD, UA_LD, UA_G, (size_t)1024 * UA_LD, SG, 1, OpY{UA, Yb, SP + SP_SD + layer * SG * SC});
                else if (st == 3) run_gemm(lds, Yb, w + W_SQ, MTOK, DM, DM, OpGLU{Yb, Zb});
                else run_gemm_fused(lds, Zb, w + 2 * W_SQ, DM, EF);
            } else {
                const int bl = layer - 2, st = s - 2;
                if (st == 0) { if (bl == 0) { run_gemm(lds, XB, Wb + WO_QKV, MTOK, 2 * DM, DM, OpQKV{Qb, ws, RS}); run_gemm_n(lds, Wb + WO_QKV + 2 * W_SQ, XB, DM, MTOK, DM, OpVT{Vb, RS}); } else run_gemm(lds, XB, Wb + WO_Q1, MTOK, DM, DM, OpQKV{Qb, ws, RS}); }
                else if (st == 1) { ATTN_CALL; }
                else run_gemm_fused(lds, Ob, Wb + WO_O + (size_t)bl * W_SQ, DM, EF);
            }
            (void)lane_p; (void)gw_p; (void)Kb;
        }
        if (p + 1 < A.ph_hi) {
            const int q_ = p - 1, s_ = q_ < 2 * NS5 ? q_ % NS5 : (q_ - 2 * NS5) % NAT; const bool s5_ = q_ < 2 * NS5;
            const bool seam = s5_ ? (s_ >= 2 && s_ <= 4) || s_ == 6 : (s_ >= 2 && s_ <= 4);
            const bool fast = misc[2] != 0u;
            if (seam || !fast) { XcdBarrier xb_; xb_.bar = (unsigned*)A.ws; xb_.x = xb_xcc_id(); xb_.st = (volatile LAS unsigned*)(lds + RING_BYTES + 64); xcd_barrier(xb_); }
            else group_barrier((unsigned*)A.ws + CW_GCNT + 64 * (blockIdx.x & 7));
        }
    }
}

extern "C" void kernel_launch(void* const* d_in, const int* in_sizes, int n_in, void* d_out, int out_size, void* d_ws, size_t ws_size, hipStream_t stream) {
    static int grid = 0;
    if (grid == 0) {
        if (n_in != 21 || out_size != MTOK * DM || ws_size < WS_END) { fprintf(stderr, "kernel_launch: unexpected shapes (n_in %d out %d ws %zu)\n", n_in, out_size, ws_size); grid = -1; return; }
        int dev = 0, cus = 0, per_cu = 0;
        hipGetDevice(&dev); hipDeviceGetAttribute(&cus, hipDeviceAttributeMultiprocessorCount, dev);
        if (hipFuncSetAttribute((const void*)mk_fwd, hipFuncAttributeMaxDynamicSharedMemorySize, LDS_BYTES) != hipSuccess) { fprintf(stderr, "kernel_launch: hipFuncSetAttribute failed\n"); grid = -1; return; }
        hipOccupancyMaxActiveBlocksPerMultiprocessor(&per_cu, (const void*)mk_fwd, NWAVES * 64, LDS_BYTES);
        (void)hipGetLastError();
        if (per_cu < 1) per_cu = 1;
        grid = cus * 1;
        if (grid <= 0) grid = 256;
    }
    if (grid < 0) return;
    if (hipMemsetAsync(d_ws, 0, 24576, stream) != hipSuccess) { fprintf(stderr, "kernel_launch: memset of the barrier words failed\n"); return; }
    Args a{};
    for (int i = 0; i < 21; ++i) a.in[i] = (const float*)d_in[i];
    a.out = (float*)d_out; a.ws = (unsigned char*)d_ws;
#if MK_MULTI
    for (int p = 0; p < NPH; ++p) { a.ph_lo = p; a.ph_hi = p + 1; hipLaunchKernelGGL(mk_fwd, dim3(grid), dim3(NWAVES * 64), LDS_BYTES, stream, a); }
#else
    a.ph_lo = 0; a.ph_hi = NPH;
    void* args[] = {&a};
    hipError_t e = hipLaunchCooperativeKernel((const void*)mk_fwd, dim3(grid), dim3(NWAVES * 64), args, LDS_BYTES, stream);
    if (e != hipSuccess) fprintf(stderr, "cooperative launch failed: %s (grid %d)\n", hipGetErrorString(e), grid);
#endif
}
```
